# Optimizing an MI355X kernel written in HIP

```python
import jax
import jax.numpy as jnp
from jax import lax
import numpy as np

D_MODEL = 2048
BATCH = 1
SEQ = 8192
DEPTH = 1

HEAD_DIM = 128
SB_HEADS = 8
NSA_HEADS = 8
NSA_KV_GROUPS = 2
SB_WIDTH = SB_HEADS * HEAD_DIM
NSA_WIDTH = NSA_HEADS * HEAD_DIM
MIX_WIDTH = SB_WIDTH + NSA_WIDTH
KV_WIDTH = NSA_KV_GROUPS * HEAD_DIM
N_GATES = 3
CMP_BLOCK = 32
CMP_STRIDE = 16
CMP_HIDDEN = 256
SEL_BLOCK = 64
SEL_TOPK = 16
WINDOW = 512
Q_BLOCK = 128
MEM_TOKENS = 256
MEM_HEADS = 4
D_FF = 5504
ROPE_THETA = 10000.0
LN_EPS = 1e-5
RMS_EPS = 1e-6
MASK_FILL = -1e30
DEEPNORM_ALPHA = (2 * DEPTH) ** 0.25
DEEPNORM_BETA = (8 * DEPTH) ** -0.25
IN_SPLITS = (SB_WIDTH, SB_WIDTH, SB_WIDTH, NSA_WIDTH, KV_WIDTH, KV_WIDTH, KV_WIDTH, KV_WIDTH, KV_WIDTH, KV_WIDTH, NSA_HEADS * N_GATES)
VALUE_SEGMENTS = (2, 5, 7, 9)
IN_COLS = sum(IN_SPLITS)

kernel_name = 'hybrid_sb_nsa_macaron_deepnorm'


def layer_norm(x, g, b):
    xf = x.astype(jnp.float32)
    mu = jnp.mean(xf, axis=-1, keepdims=True)
    var = jnp.mean(jnp.square(xf - mu), axis=-1, keepdims=True)
    return ((xf - mu) * lax.rsqrt(var + LN_EPS) * g + b).astype(x.dtype)


def swiglu(x, w_gate, w_up, w_down):
    return (jax.nn.silu(x @ w_gate) * (x @ w_up)) @ w_down


def split_heads(t, n_heads):
    B, T, _ = t.shape
    return t.reshape(B, T, n_heads, HEAD_DIM).transpose(0, 2, 1, 3)


def rope(x, pos):
    half = HEAD_DIM // 2
    inv_freq = ROPE_THETA ** (-jnp.arange(half, dtype=jnp.float32) / half)
    ang = pos.astype(jnp.float32)[:, None] * inv_freq[None, :]
    cos = jnp.cos(ang).astype(x.dtype)
    sin = jnp.sin(ang).astype(x.dtype)
    x1, x2 = x[..., :half], x[..., half:]
    return jnp.concatenate([x1 * cos - x2 * sin, x1 * sin + x2 * cos], axis=-1)


def masked_softmax(s, mask, axes):
    s = jnp.where(mask, s.astype(jnp.float32), MASK_FILL)
    m = jnp.max(s, axis=axes, keepdims=True)
    p = jnp.where(mask, jnp.exp(s - m), 0.0)
    return p / jnp.maximum(jnp.sum(p, axis=axes, keepdims=True), 1e-30)


def stick_breaking_attention(q, k, v):
    B, H, T, Dh = q.shape
    nb = T // Q_BLOCK
    scale = Dh ** -0.5
    key_pos = jnp.arange(T)
    qb = jnp.moveaxis(q.reshape(B, H, nb, Q_BLOCK, Dh), 2, 0)

    def block(args):
        i, q_i = args
        q_pos = i * Q_BLOCK + jnp.arange(Q_BLOCK)
        z = jnp.einsum('bhqd,bhkd->bhqk', q_i, k).astype(jnp.float32) * scale
        strict = key_pos[None, :] < q_pos[:, None]
        log_beta = jax.nn.log_sigmoid(z)
        log_1m_beta = jnp.where(strict, jax.nn.log_sigmoid(-z), 0.0)
        log_stay = lax.cumsum(log_1m_beta, axis=3, reverse=True) - log_1m_beta
        w = jnp.where(strict, jnp.exp(log_beta + log_stay), 0.0)
        return jnp.einsum('bhqk,bhkd->bhqd', w.astype(v.dtype), v)

    out = lax.map(block, (jnp.arange(nb), qb))
    return jnp.moveaxis(out, 0, 2).reshape(B, H, T, Dh)


def compress(x_tok, pos_emb, w1, w2):
    B, G, T, Dh = x_tok.shape
    n_cmp = (T - CMP_BLOCK) // CMP_STRIDE + 1
    idx = jnp.arange(n_cmp)[:, None] * CMP_STRIDE + jnp.arange(CMP_BLOCK)[None, :]
    blocks = x_tok[:, :, idx, :] + pos_emb
    flat = blocks.reshape(B, G, n_cmp, CMP_BLOCK * Dh)
    return jax.nn.gelu(flat @ w1) @ w2


def native_sparse_attention(q, k_cmp, v_cmp, k_slc, v_slc, k_win, v_win, gates):
    B, H, T, Dh = q.shape
    G = NSA_KV_GROUPS
    R = H // G
    scale = Dh ** -0.5
    nb = T // Q_BLOCK
    n_cmp = k_cmp.shape[2]
    n_sel = T // SEL_BLOCK
    k_top = min(SEL_TOPK, n_sel)
    cmp_start = jnp.arange(n_cmp) * CMP_STRIDE
    cmp_end = cmp_start + CMP_BLOCK - 1
    sel_start = jnp.arange(n_sel) * SEL_BLOCK
    blk_ids = jnp.arange(n_sel)
    overlap = jnp.clip(jnp.minimum(cmp_start[:, None] + CMP_BLOCK, sel_start[None, :] + SEL_BLOCK)
                       - jnp.maximum(cmp_start[:, None], sel_start[None, :]), 0, None)
    cmp_to_sel = overlap.astype(jnp.float32) / CMP_BLOCK
    ks_blocks = k_slc.reshape(B, G, n_sel, SEL_BLOCK, Dh)
    vs_blocks = v_slc.reshape(B, G, n_sel, SEL_BLOCK, Dh)
    pad = ((0, 0), (0, 0), (WINDOW, 0), (0, 0))
    kw_pad = jnp.pad(k_win, pad)
    vw_pad = jnp.pad(v_win, pad)
    b_idx = jnp.arange(B)[:, None, None, None]
    g_idx = jnp.arange(G)[None, :, None, None]
    qb = jnp.moveaxis(q.reshape(B, G, R, nb, Q_BLOCK, Dh), 3, 0)
    gb = jnp.moveaxis(gates.reshape(B, G, R, nb, Q_BLOCK, N_GATES), 3, 0)

    def block(args):
        i, q_i, g_i = args
        q0 = i * Q_BLOCK
        q_pos = q0 + jnp.arange(Q_BLOCK)
        s_c = jnp.einsum('bgrqd,bgcd->bgrqc', q_i, k_cmp).astype(jnp.float32) * scale
        p_c = masked_softmax(s_c, cmp_end[None, :] <= q_pos[:, None], (-1,))
        o_c = jnp.einsum('bgrqc,bgcd->bgrqd', p_c.astype(v_cmp.dtype), v_cmp)
        imp = jnp.einsum('bgrqc,cn->bgqn', p_c, cmp_to_sel)
        forced = (blk_ids[None, :] == 0) | (blk_ids[None, :] == q_pos[:, None] // SEL_BLOCK)
        valid = sel_start[None, :] <= q_pos[:, None]
        imp = jnp.where(forced, jnp.inf, jnp.where(valid, imp, -jnp.inf))
        _, sel = lax.top_k(imp, k_top)
        k_g = ks_blocks[b_idx, g_idx, sel]
        v_g = vs_blocks[b_idx, g_idx, sel]
        tok_pos = sel[..., None] * SEL_BLOCK + jnp.arange(SEL_BLOCK)
        m_s = (tok_pos <= q_pos[:, None, None])[:, :, None]
        s_s = jnp.einsum('bgrqd,bgqnsd->bgrqns', q_i, k_g).astype(jnp.float32) * scale
        p_s = masked_softmax(s_s, m_s, (-2, -1))
        o_s = jnp.einsum('bgrqns,bgqnsd->bgrqd', p_s.astype(v_g.dtype), v_g)
        k_w = lax.dynamic_slice_in_dim(kw_pad, q0, WINDOW + Q_BLOCK, axis=2)
        v_w = lax.dynamic_slice_in_dim(vw_pad, q0, WINDOW + Q_BLOCK, axis=2)
        kv_pos = q0 - WINDOW + jnp.arange(WINDOW + Q_BLOCK)
        dist = q_pos[:, None] - kv_pos[None, :]
        m_w = (dist >= 0) & (dist < WINDOW) & (kv_pos[None, :] >= 0)
        s_w = jnp.einsum('bgrqd,bgkd->bgrqk', q_i, k_w).astype(jnp.float32) * scale
        p_w = masked_softmax(s_w, m_w, (-1,))
        o_w = jnp.einsum('bgrqk,bgkd->bgrqd', p_w.astype(v_w.dtype), v_w)
        out = g_i[..., 0:1] * o_c + g_i[..., 1:2] * o_s + g_i[..., 2:3] * o_w
        return out.astype(q_i.dtype)

    out = lax.map(block, (jnp.arange(nb), qb, gb))
    return jnp.moveaxis(out, 0, 3).reshape(B, H, T, Dh)


def group_rms(o, g):
    B, H, T, Dh = o.shape
    o = o.transpose(0, 2, 1, 3).reshape(B, T, H * Dh).astype(jnp.float32)
    return o * lax.rsqrt(jnp.mean(o * o, axis=-1, keepdims=True) + RMS_EPS) * g


def hybrid_mixer(h, w_in, cmp_pos_k, cmp_w1_k, cmp_w2_k, cmp_pos_v, cmp_w1_v, cmp_w2_v, mix_norm_g, w_out):
    B, T, _ = h.shape
    bounds = [int(b) for b in np.cumsum(IN_SPLITS)[:-1]]
    (sb_q, sb_k, sb_v, nsa_q, kc, vc, ksl, vsl, kwn, vwn, gate_logits) = jnp.split(h @ w_in, bounds, axis=-1)
    pos = jnp.arange(T)
    o_sb = stick_breaking_attention(split_heads(sb_q, SB_HEADS), split_heads(sb_k, SB_HEADS), split_heads(sb_v, SB_HEADS))
    q = rope(split_heads(nsa_q, NSA_HEADS), pos)
    k_cmp = compress(rope(split_heads(kc, NSA_KV_GROUPS), pos), cmp_pos_k, cmp_w1_k, cmp_w2_k)
    v_cmp = compress(split_heads(vc, NSA_KV_GROUPS), cmp_pos_v, cmp_w1_v, cmp_w2_v)
    k_slc = rope(split_heads(ksl, NSA_KV_GROUPS), pos)
    v_slc = split_heads(vsl, NSA_KV_GROUPS)
    k_win = rope(split_heads(kwn, NSA_KV_GROUPS), pos)
    v_win = split_heads(vwn, NSA_KV_GROUPS)
    gates = jax.nn.sigmoid(gate_logits.astype(jnp.float32)).reshape(B, T, NSA_HEADS, N_GATES).transpose(0, 2, 1, 3)
    o_nsa = native_sparse_attention(q, k_cmp, v_cmp, k_slc, v_slc, k_win, v_win, gates)
    y = jnp.concatenate([group_rms(o_sb, mix_norm_g[:SB_WIDTH]), group_rms(o_nsa, mix_norm_g[SB_WIDTH:])], axis=-1)
    return y.astype(h.dtype) @ w_out


def memory_cross_attention(x, mem, w_q, w_k, w_v, w_o):
    B, T, D = x.shape
    M = mem.shape[1]
    dh = D // MEM_HEADS
    q = (x @ w_q).reshape(B, T, MEM_HEADS, dh)
    k = (mem @ w_k).reshape(B, M, MEM_HEADS, dh)
    v = (mem @ w_v).reshape(B, M, MEM_HEADS, dh)
    s = jnp.einsum('bthd,bmhd->bhtm', q, k).astype(jnp.float32) * dh ** -0.5
    p = jax.nn.softmax(s, axis=-1).astype(v.dtype)
    o = jnp.einsum('bhtm,bmhd->bthd', p, v).reshape(B, T, D)
    return o @ w_o


def setup_inputs(seed: int = 0) -> dict:
    key = jax.random.key(seed)
    keys = iter(jax.random.split(key, 48))
    D = D_MODEL
    beta = DEEPNORM_BETA

    def nrm(shape, scale):
        return jax.random.normal(next(keys), shape, jnp.float32) * scale

    def gain(n):
        return 1.0 + nrm((DEPTH, n), 0.02)

    def bias(n):
        return nrm((DEPTH, n), 0.02)

    in_scale = jnp.asarray(np.concatenate([np.full((n,), beta if i in VALUE_SEGMENTS else 1.0, np.float32)
                                           for i, n in enumerate(IN_SPLITS)]))
    return {
        'x': nrm((BATCH, SEQ, D), 1.0),
        'mem': nrm((BATCH, MEM_TOKENS, D), 1.0),
        'ln1_g': gain(D), 'ln1_b': bias(D),
        'ffn1_gate': nrm((DEPTH, D, D_FF), D ** -0.5),
        'ffn1_up': nrm((DEPTH, D, D_FF), D ** -0.5 * beta),
        'ffn1_down': nrm((DEPTH, D_FF, D), D_FF ** -0.5 * beta),
        'w_in': nrm((DEPTH, D, IN_COLS), D ** -0.5) * in_scale,
        'cmp_pos_k': nrm((DEPTH, CMP_BLOCK, HEAD_DIM), 0.02),
        'cmp_w1_k': nrm((DEPTH, CMP_BLOCK * HEAD_DIM, CMP_HIDDEN), (CMP_BLOCK * HEAD_DIM) ** -0.5),
        'cmp_w2_k': nrm((DEPTH, CMP_HIDDEN, HEAD_DIM), CMP_HIDDEN ** -0.5),
        'cmp_pos_v': nrm((DEPTH, CMP_BLOCK, HEAD_DIM), 0.02),
        'cmp_w1_v': nrm((DEPTH, CMP_BLOCK * HEAD_DIM, CMP_HIDDEN), (CMP_BLOCK * HEAD_DIM) ** -0.5),
        'cmp_w2_v': nrm((DEPTH, CMP_HIDDEN, HEAD_DIM), CMP_HIDDEN ** -0.5),
        'mix_norm_g': gain(MIX_WIDTH),
        'w_out': nrm((DEPTH, MIX_WIDTH, D), MIX_WIDTH ** -0.5 * beta),
        'ln2_g': gain(D), 'ln2_b': bias(D),
        'mem_wq': nrm((DEPTH, D, D), D ** -0.5),
        'mem_wk': nrm((DEPTH, D, D), D ** -0.5),
        'mem_wv': nrm((DEPTH, D, D), D ** -0.5 * beta),
        'mem_wo': nrm((DEPTH, D, D), D ** -0.5 * beta),
        'ln3_g': gain(D), 'ln3_b': bias(D),
        'ffn2_gate': nrm((DEPTH, D, D_FF), D ** -0.5),
        'ffn2_up': nrm((DEPTH, D, D_FF), D ** -0.5 * beta),
        'ffn2_down': nrm((DEPTH, D_FF, D), D_FF ** -0.5 * beta),
        'ln4_g': gain(D), 'ln4_b': bias(D),
    }


def reference(x, mem, ln1_g, ln1_b, ffn1_gate, ffn1_up, ffn1_down, w_in, cmp_pos_k, cmp_w1_k, cmp_w2_k,
              cmp_pos_v, cmp_w1_v, cmp_w2_v, mix_norm_g, w_out, ln2_g, ln2_b, mem_wq, mem_wk, mem_wv, mem_wo,
              ln3_g, ln3_b, ffn2_gate, ffn2_up, ffn2_down, ln4_g, ln4_b):
    a = DEEPNORM_ALPHA
    for l in range(DEPTH):
        x = layer_norm(a * x + 0.5 * swiglu(x, ffn1_gate[l], ffn1_up[l], ffn1_down[l]), ln1_g[l], ln1_b[l])
        x = layer_norm(a * x + hybrid_mixer(x, w_in[l], cmp_pos_k[l], cmp_w1_k[l], cmp_w2_k[l], cmp_pos_v[l],
                                            cmp_w1_v[l], cmp_w2_v[l], mix_norm_g[l], w_out[l]), ln2_g[l], ln2_b[l])
        x = layer_norm(a * x + memory_cross_attention(x, mem, mem_wq[l], mem_wk[l], mem_wv[l], mem_wo[l]), ln3_g[l], ln3_b[l])
        x = layer_norm(a * x + 0.5 * swiglu(x, ffn2_gate[l], ffn2_up[l], ffn2_down[l]), ln4_g[l], ln4_b[l])
    return x
```

```cpp
#include <hip/hip_runtime.h>
#include <cstdio>
#include <cstdint>
#include <cmath>

namespace pg8 {
#define PG8_LAS __attribute__((address_space(3)))
typedef unsigned short bf16_t;
typedef short bf16x8 __attribute__((ext_vector_type(8)));
typedef float f32x4 __attribute__((ext_vector_type(4)));
typedef unsigned u32x4 __attribute__((ext_vector_type(4)));
typedef unsigned u32x2 __attribute__((ext_vector_type(2)));
constexpr int BM = 256, BK = 64, HALF = 128, HTB = HALF * BK * 2  , STAGE_BYTES = 8 * HTB, NXCD = 8, WGM = 8;

__host__ __device__ __forceinline__ int lds_byte(int r, int c) { const int st = (r >> 4) * 2 + (c >> 5), rr = r & 15, cc = c & 31, ob = rr * 64 + cc * 2; return st * 1024 + (ob ^ (((ob >> 9) & 1) << 5)); }
__host__ __device__ __forceinline__ void stage_rc(int b, int& R, int& C) { const int st = b / 1024, sb = b % 1024, swz = sb ^ (((sb >> 9) & 1) << 5); R = (st >> 1) * 16 + swz / 64; C = (st & 1) * 32 + (swz % 64) / 2; }
__host__ __device__ __forceinline__ int perm32(int rho) { const int n = rho >> 4, i = rho & 15; return 8 * (i >> 2) + 4 * n + (i & 3); }

struct Unit { int pm, pn, z; size_t offA, offB; };
struct Gemm { const bf16_t* A; const bf16_t* Bt; int lda, ldb, K; };

struct StaticOrder {
    int nM, nN, nwg, G, c;
    __host__ __device__ void init(int M, int N, int G_, int c_) { nM = M / BM; nN = N / BM; nwg = nM * nN; G = G_; c = c_; }
    __host__ __device__ bool next(int i, Unit& u) const {
        const long L = (long)i * G + c; if (L >= nwg) return false;
        int wgid = (int)L; { const int q = nwg / NXCD, r = nwg % NXCD, xcd = wgid % NXCD, off = wgid / NXCD; wgid = (xcd < r ? xcd * (q + 1) : r * (q + 1) + (xcd - r) * q) + off; }
        const int nig = WGM * nN, gid = wgid / nig, fm = gid * WGM, gsz = (nM - fm) < WGM ? (nM - fm) : WGM;
        u.pm = fm + ((wgid % nig) % gsz); u.pn = (wgid % nig) / gsz; u.z = 0; u.offA = 0; u.offB = 0; return true;
    }
    __device__ __forceinline__ void a_ready(const Unit&) const {}
    __device__ __forceinline__ void done(const Unit&) const {}
};
struct ListOrder {
    int nM, nN, nwg, G, c; size_t zA, zB;
    __host__ __device__ void init(int nZ, int nM_, int nN_, int G_, int c_, int c0, size_t zA_, size_t zB_) { nM = nM_; nN = nN_; nwg = nZ * nM_ * nN_; G = G_; c = (c_ - c0 + G_) % G_; zA = zA_; zB = zB_; }
    __host__ __device__ bool next(int i, Unit& u) const {
        const long L = (long)i * G + c; if (L >= nwg) return false;
        const int l = (int)L; u.pn = l % nN; u.pm = (l / nN) % nM; u.z = l / (nN * nM); u.offA = (size_t)u.z * zA; u.offB = (size_t)u.z * zB; return true;
    }
    __device__ __forceinline__ void a_ready(const Unit&) const {}
    __device__ __forceinline__ void done(const Unit&) const {}
};

typedef float f32x2_t __attribute__((ext_vector_type(2))); typedef __bf16 bf16x2_t __attribute__((ext_vector_type(2)));
struct CmpOrder {
    int G, c; size_t grpA, kvB;
    __host__ __device__ bool next(int i, Unit& u) const {
        const long L = (long)i * G + c; if (L >= 64) return false;
        const int l = (int)L, kc = l & 7, pm = (l >> 3) & 1, g = (l >> 4) & 1, kv = l >> 5;
        u.pm = pm; u.pn = 0; u.z = (kc * 2 + kv) * 2 + g; u.offA = (size_t)(kv * 2 + g) * grpA + (size_t)kc * 1024; u.offB = (size_t)kv * kvB + (size_t)kc * 1024; return true;
    }
    __device__ __forceinline__ void a_ready(const Unit&) const {}
    __device__ __forceinline__ void done(const Unit&) const {}
};
__device__ __forceinline__ unsigned cvt_pk_bf16(float lo, float hi) { f32x2_t v = {lo, hi}; bf16x2_t b = __builtin_convertvector(v, bf16x2_t); return __builtin_bit_cast(unsigned, b); }
__device__ __forceinline__ u32x2 pack4(f32x4 v) { u32x2 w; w.x = cvt_pk_bf16(v[0], v[1]); w.y = cvt_pk_bf16(v[2], v[3]); return w; }

struct EpiSwiGLU {
    static constexpr bool PERM = false, AFTER_DRAIN = false;
    bf16_t* H; int ldh;
    __device__ __forceinline__ void operator()(const f32x4 (&acc)[2][2][4][2], const Unit& u, int wr, int wc, int fr, int fq) const {
        const int row0 = u.pm * BM + wr * 64 + fr, col0 = u.pn * HALF + wc * 32 + 4 * fq;
#pragma unroll
        for (int ai = 0; ai < 2; ++ai)
#pragma unroll
            for (int m = 0; m < 4; ++m) { bf16_t* rowp = H + (size_t)(row0 + ai * HALF + m * 16) * ldh + col0;
#pragma unroll
                for (int n = 0; n < 2; ++n) { const f32x4 g = acc[ai][0][m][n], up = acc[ai][1][m][n]; f32x4 h;
#pragma unroll
                    for (int j = 0; j < 4; ++j) { const float e = __builtin_amdgcn_exp2f(-1.4426950408889634f * g[j]); h[j] = g[j] * __builtin_amdgcn_rcpf(1.0f + e) * up[j]; }
                    *(u32x2*)(rowp + 16 * n) = pack4(h); } }
    }
};
struct EpiF32 {
    static constexpr bool PERM = false, AFTER_DRAIN = false;
    float* O; int ldc; const float* R; float alpha, beta; size_t zO;
    __device__ __forceinline__ void operator()(const f32x4 (&acc)[2][2][4][2], const Unit& u, int wr, int wc, int fr, int fq) const {
        const int row0 = u.pm * BM + wr * 64 + fr, col0 = u.pn * BM + wc * 32 + 4 * fq;
        float* base = O + (size_t)u.z * zO;
#pragma unroll
        for (int ai = 0; ai < 2; ++ai)
#pragma unroll
            for (int m = 0; m < 4; ++m) { const size_t off = (size_t)(row0 + ai * HALF + m * 16) * ldc + col0;
#pragma unroll
                for (int bj = 0; bj < 2; ++bj)
#pragma unroll
                    for (int n = 0; n < 2; ++n) { f32x4 v = acc[ai][bj][m][n] * beta; if (R) { const f32x4 r = *(const f32x4*)(R + off + bj * HALF + n * 16); v = v + r * alpha; }
                        *(f32x4*)(base + off + bj * HALF + n * 16) = v; } }
    }
};
struct EpiBf16S {
    static constexpr bool PERM = false, AFTER_DRAIN = false;
    bf16_t* O; int ldc; float scale; int zcol;
    __device__ __forceinline__ void operator()(const f32x4 (&acc)[2][2][4][2], const Unit& u, int wr, int wc, int fr, int fq) const {
        const int row0 = u.pm * BM + wr * 64 + fr, col0 = u.z * zcol + u.pn * BM + wc * 32 + 4 * fq;
#pragma unroll
        for (int ai = 0; ai < 2; ++ai)
#pragma unroll
            for (int m = 0; m < 4; ++m) { bf16_t* rowp = O + (size_t)(row0 + ai * HALF + m * 16) * ldc + col0;
#pragma unroll
                for (int bj = 0; bj < 2; ++bj)
#pragma unroll
                    for (int n = 0; n < 2; ++n) *(u32x2*)(rowp + bj * HALF + n * 16) = pack4(acc[ai][bj][m][n] * scale); }
    }
};
struct EpiWin {
    static constexpr bool PERM = false, AFTER_DRAIN = false;
    bf16_t *SBQ, *SBK, *SBVT, *NQ, *CMPIN, *KSL, *VSLT, *KWN, *VWNT; float* GATES; const float* ROPE; int T; float qscale;
    __device__ __forceinline__ void st_plain(bf16_t* dst, int head0, const f32x4 (&acc)[2][2][4][2], const Unit& u, int wr, int wc, int fr, int fq, float sc) const {
        const int row0 = u.pm * BM + wr * 64 + fr, c0 = wc * 32 + 4 * fq;
#pragma unroll
        for (int bj = 0; bj < 2; ++bj)
#pragma unroll
            for (int ai = 0; ai < 2; ++ai)
#pragma unroll
                for (int m = 0; m < 4; ++m) { bf16_t* rowp = dst + ((size_t)(head0 + bj) * T + row0 + ai * HALF + m * 16) * 128 + c0;
#pragma unroll
                    for (int n = 0; n < 2; ++n) *(u32x2*)(rowp + 16 * n) = pack4(acc[ai][bj][m][n] * sc); }
    }
    __device__ __forceinline__ void st_rope(bf16_t* dst, int head0, const f32x4 (&acc)[2][2][4][2], const Unit& u, int wr, int wc, int fr, int fq, float sc) const {
        const int row0 = u.pm * BM + wr * 64 + fr, i0 = wc * 16 + 4 * fq;
#pragma unroll
        for (int ai = 0; ai < 2; ++ai)
#pragma unroll
            for (int m = 0; m < 4; ++m) { const int tok = row0 + ai * HALF + m * 16;
                const f32x4 cs0 = *(const f32x4*)(ROPE + ((size_t)tok * 64 + i0) * 2), cs1 = *(const f32x4*)(ROPE + ((size_t)tok * 64 + i0) * 2 + 4);
                const f32x4 co = {cs0[0], cs0[2], cs1[0], cs1[2]}, si = {cs0[1], cs0[3], cs1[1], cs1[3]};
#pragma unroll
                for (int bj = 0; bj < 2; ++bj) { const f32x4 lo = acc[ai][bj][m][0], hi = acc[ai][bj][m][1];
                    const f32x4 olo = (lo * co - hi * si) * sc, ohi = (lo * si + hi * co) * sc;
                    bf16_t* rowp = dst + ((size_t)(head0 + bj) * T + tok) * 128 + i0;
                    *(u32x2*)(rowp) = pack4(olo); *(u32x2*)(rowp + 64) = pack4(ohi); } }
    }
    __device__ __forceinline__ void st_vt(bf16_t* dst, int head0, const f32x4 (&acc)[2][2][4][2], const Unit& u, int wr, int wc, int fr, int fq) const {
        const int row0 = u.pm * BM + wr * 64 + fr, c0 = wc * 32 + 4 * fq;
#pragma unroll
        for (int bj = 0; bj < 2; ++bj)
#pragma unroll
            for (int ai = 0; ai < 2; ++ai)
#pragma unroll
                for (int m = 0; m < 4; ++m) { const int tok = row0 + ai * HALF + m * 16; bf16_t* tb = dst + ((size_t)(head0 + bj) * T + (tok & ~31)) * 128 + (tok & 31);
#pragma unroll
                    for (int n = 0; n < 2; ++n) { const u32x2 w = pack4(acc[ai][bj][m][n]); const int d = c0 + 16 * n;
                        tb[(d + 0) * 32] = (bf16_t)(w.x & 0xffffu); tb[(d + 1) * 32] = (bf16_t)(w.x >> 16); tb[(d + 2) * 32] = (bf16_t)(w.y & 0xffffu); tb[(d + 3) * 32] = (bf16_t)(w.y >> 16); } }
    }
    __device__ __forceinline__ void operator()(const f32x4 (&acc)[2][2][4][2], const Unit& u, int wr, int wc, int fr, int fq) const {
        const int pn = u.pn;
        if (pn < 4) st_plain(SBQ, 2 * pn, acc, u, wr, wc, fr, fq, qscale);
        else if (pn < 8) st_plain(SBK, 2 * (pn - 4), acc, u, wr, wc, fr, fq, 1.f);
        else if (pn < 12) st_vt(SBVT, 2 * (pn - 8), acc, u, wr, wc, fr, fq);
        else if (pn < 16) st_rope(NQ, 2 * (pn - 12), acc, u, wr, wc, fr, fq, qscale);
        else if (pn == 16) st_rope(CMPIN, 0, acc, u, wr, wc, fr, fq, 1.f);
        else if (pn == 17) st_plain(CMPIN, 2, acc, u, wr, wc, fr, fq, 1.f);
        else if (pn == 18) st_rope(KSL, 0, acc, u, wr, wc, fr, fq, 1.f);
        else if (pn == 19) st_vt(VSLT, 0, acc, u, wr, wc, fr, fq);
        else if (pn == 20) st_rope(KWN, 0, acc, u, wr, wc, fr, fq, 1.f);
        else if (pn == 21) st_vt(VWNT, 0, acc, u, wr, wc, fr, fq);
        else {
            if (wc == 0) { const int row0 = u.pm * BM + wr * 64 + fr;
#pragma unroll
                for (int ai = 0; ai < 2; ++ai)
#pragma unroll
                    for (int m = 0; m < 4; ++m) { float* gp = GATES + (size_t)(row0 + ai * HALF + m * 16) * 24;
#pragma unroll
                        for (int n = 0; n < 2; ++n) { const int c = 16 * n + 4 * fq; if (c < 24) { const f32x4 v = acc[ai][0][m][n]; f32x4 s;
#pragma unroll
                                for (int j = 0; j < 4; ++j) s[j] = __builtin_amdgcn_rcpf(1.0f + __builtin_amdgcn_exp2f(-1.4426950408889634f * v[j]));
                                *(f32x4*)(gp + c) = s; } } } }
        }
    }
};

template <class Epi, class Sched, bool ALIGN_EPI = false, bool SP2 = false>
__device__ __forceinline__ void gemm_phase(PG8_LAS unsigned char* lds, const Gemm g, const Sched& S, const Epi& E) {
    const int tid = threadIdx.x, wid = __builtin_amdgcn_readfirstlane(tid >> 6), lane = tid & 63, wr = wid >> 2, wc = wid & 3, fr = lane & 15, fq = lane >> 4;
    const int K = g.K, nt = K / BK, lda = g.lda, ldb = g.ldb;
    unsigned voffA[2], voffB[2];
#pragma unroll
    for (int i = 0; i < 2; ++i) { int R, C; stage_rc(tid * 16 + i * 8192, R, C); const int Rb = Epi::PERM ? ((R & ~31) + perm32(R & 31)) : R;
        voffA[i] = (unsigned)(R * lda + C) * 2u; voffB[i] = (unsigned)(Rb * ldb + C) * 2u; }
    const size_t kstep = (size_t)(BK * 2);
    const size_t hstepA = (size_t)HALF * lda * 2, hstepB = (size_t)HALF * ldb * 2;
    const size_t tstepA = 2 * hstepA, tstepB = 2 * hstepB;
    const unsigned ldsw = (unsigned)wid * 1024u;
    const int aoff = lds_byte(wr * 64 + fr, fq * 8), boff = lds_byte(wc * 32 + fr, fq * 8);
#define PG8_SA(b, h) (((b) * 2 + (h)) * HTB)
#define PG8_SB(b, h) ((4 + (b) * 2 + (h)) * HTB)
#define PG8_STAGE(bufoff, gbase, voff) do { _Pragma("unroll") for (int _i = 0; _i < 2; ++_i) \
        __builtin_amdgcn_global_load_lds((const unsigned*)((const char*)(gbase) + (voff)[_i]), (PG8_LAS unsigned*)(lds + (bufoff) + ldsw + _i * 8192), 16, 0, 0); } while (0)
#define PG8_LDA(dst, b, h) do { _Pragma("unroll") for (int m = 0; m < 4; ++m) _Pragma("unroll") for (int k = 0; k < 2; ++k) dst[m][k] = *(const PG8_LAS bf16x8*)(lds + PG8_SA(b, h) + aoff + m * 2048 + k * 1024); } while (0)
#define PG8_LDB(dst, b, h) do { _Pragma("unroll") for (int n = 0; n < 2; ++n) _Pragma("unroll") for (int k = 0; k < 2; ++k) dst[n][k] = *(const PG8_LAS bf16x8*)(lds + PG8_SB(b, h) + boff + n * 2048 + k * 1024); } while (0)
#define PG8_MMA(ai, bj, At, Bt) do { __builtin_amdgcn_s_setprio(1); _Pragma("unroll") for (int m = 0; m < 4; ++m) _Pragma("unroll") for (int n = 0; n < 2; ++n) _Pragma("unroll") for (int k = 0; k < 2; ++k) \
        acc[ai][bj][m][n] = __builtin_amdgcn_mfma_f32_16x16x32_bf16(Bt[n][k], At[m][k], acc[ai][bj][m][n], 0, 0, 0); __builtin_amdgcn_s_setprio(0); } while (0)
#define PG8_WAIT_V(n) asm volatile("s_waitcnt vmcnt(" #n ")" ::: "memory")
#define PG8_WAIT_L(n) asm volatile("s_waitcnt lgkmcnt(" #n ")" ::: "memory")
#define PG8_BAR __builtin_amdgcn_s_barrier()
#define PG8_SCHED __builtin_amdgcn_sched_barrier(0)
    Unit cur, nxt; int ui = 0;
    if (!S.next(0, cur)) return;
    f32x4 acc[2][2][4][2];
#pragma unroll
    for (int a = 0; a < 2; ++a)
#pragma unroll
        for (int b = 0; b < 2; ++b)
#pragma unroll
            for (int m = 0; m < 4; ++m)
#pragma unroll
                for (int n = 0; n < 2; ++n) acc[a][b][m][n] = (f32x4){0.f, 0.f, 0.f, 0.f};
    bf16x8 At[4][2], B0[2][2], B1[2][2];
    const char* cA = (const char*)g.A + (size_t)cur.pm * tstepA + cur.offA; const char* cB = (const char*)g.Bt + (size_t)cur.pn * tstepB + cur.offB;
    S.a_ready(cur);
    if constexpr (SP2) {
        PG8_STAGE(PG8_SB(0, 0), cB, voffB); PG8_STAGE(PG8_SB(0, 1), cB + hstepB, voffB); PG8_STAGE(PG8_SA(0, 0), cA, voffA); PG8_STAGE(PG8_SA(0, 1), cA + hstepA, voffA);
        if (wr == 1) PG8_BAR;
        PG8_WAIT_V(2); PG8_BAR;
        PG8_STAGE(PG8_SB(1, 0), cB + kstep, voffB); PG8_STAGE(PG8_SA(1, 0), cA + kstep, voffA); PG8_STAGE(PG8_SB(1, 1), cB + hstepB + kstep, voffB);
        PG8_WAIT_V(6); PG8_BAR;
    } else {
        PG8_STAGE(PG8_SB(0, 0), cB, voffB); PG8_STAGE(PG8_SA(0, 0), cA, voffA); PG8_STAGE(PG8_SB(0, 1), cB + hstepB, voffB); PG8_STAGE(PG8_SA(0, 1), cA + hstepA, voffA);
        if (wr == 1) PG8_BAR;
        PG8_WAIT_V(4); PG8_BAR;
        PG8_STAGE(PG8_SB(1, 0), cB + kstep, voffB); PG8_STAGE(PG8_SA(1, 0), cA + kstep, voffA); PG8_STAGE(PG8_SB(1, 1), cB + hstepB + kstep, voffB);
        PG8_WAIT_V(6); PG8_BAR;
    }
    for (;;) {
        const bool has_next = S.next(ui + 1, nxt);
        const char* nA = has_next ? (const char*)g.A + (size_t)nxt.pm * tstepA + nxt.offA : cA; const char* nB = has_next ? (const char*)g.Bt + (size_t)nxt.pn * tstepB + nxt.offB : cB;
        for (int t = 0; t < nt; t += 2) {
            const bool last = (t == nt - 2);
            const char* a1 = cA + (size_t)(t + 1) * kstep;
            const char* a2 = last ? nA : cA + (size_t)(t + 2) * kstep; const char* b2 = last ? nB : cB + (size_t)(t + 2) * kstep;
            const char* a3 = a2 + kstep; const char* b3 = b2 + kstep;
            if (last && has_next) S.a_ready(nxt);
            if constexpr (SP2) {
            PG8_LDB(B0, 0, 0); PG8_LDB(B1, 0, 1); PG8_SCHED; PG8_LDA(At, 0, 0); PG8_STAGE(PG8_SA(1, 1), a1 + hstepA, voffA);
            PG8_WAIT_V(8); PG8_WAIT_L(0); PG8_BAR; PG8_MMA(0, 0, At, B0); PG8_MMA(0, 1, At, B1); PG8_BAR; PG8_SCHED;
            PG8_LDA(At, 0, 1); PG8_STAGE(PG8_SB(0, 0), b2, voffB); PG8_STAGE(PG8_SB(0, 1), b2 + hstepB, voffB); PG8_STAGE(PG8_SA(0, 0), a2, voffA);
            PG8_WAIT_V(8); PG8_WAIT_L(0); PG8_BAR; PG8_MMA(1, 0, At, B0); PG8_MMA(1, 1, At, B1); PG8_BAR; PG8_SCHED;
            PG8_LDB(B0, 1, 0); PG8_LDB(B1, 1, 1); PG8_SCHED; PG8_LDA(At, 1, 0); PG8_STAGE(PG8_SA(0, 1), a2 + hstepA, voffA);
            PG8_WAIT_V(8); PG8_WAIT_L(0); PG8_BAR; PG8_MMA(0, 0, At, B0); PG8_MMA(0, 1, At, B1); PG8_BAR; PG8_SCHED;
            PG8_LDA(At, 1, 1); PG8_STAGE(PG8_SB(1, 0), b3, voffB); PG8_STAGE(PG8_SB(1, 1), b3 + hstepB, voffB); PG8_STAGE(PG8_SA(1, 0), a3, voffA);
            PG8_WAIT_V(8); PG8_WAIT_L(0); PG8_BAR; PG8_MMA(1, 0, At, B0); PG8_MMA(1, 1, At, B1); PG8_BAR; PG8_SCHED;
            } else {
            PG8_LDB(B0, 0, 0); PG8_SCHED; PG8_LDA(At, 0, 0); PG8_STAGE(PG8_SA(1, 1), a1 + hstepA, voffA);
            PG8_WAIT_L(8); PG8_BAR; PG8_WAIT_L(0); PG8_MMA(0, 0, At, B0); PG8_BAR; PG8_SCHED;
            PG8_LDB(B1, 0, 1); PG8_STAGE(PG8_SB(0, 0), b2, voffB);
            PG8_BAR; PG8_WAIT_L(0); PG8_MMA(0, 1, At, B1); PG8_BAR;
            PG8_LDA(At, 0, 1); PG8_STAGE(PG8_SA(0, 0), a2, voffA);
            PG8_BAR; PG8_WAIT_L(0); PG8_MMA(1, 0, At, B0); PG8_BAR; PG8_SCHED;
            PG8_STAGE(PG8_SB(0, 1), b2 + hstepB, voffB);
            PG8_WAIT_V(6); PG8_BAR; PG8_MMA(1, 1, At, B1); PG8_BAR;
            PG8_LDB(B0, 1, 0); PG8_SCHED; PG8_LDA(At, 1, 0); PG8_STAGE(PG8_SA(0, 1), a2 + hstepA, voffA);
            PG8_WAIT_L(8); PG8_BAR; PG8_WAIT_L(0); PG8_MMA(0, 0, At, B0); PG8_BAR; PG8_SCHED;
            PG8_LDB(B1, 1, 1); PG8_STAGE(PG8_SB(1, 0), b3, voffB);
            PG8_BAR; PG8_WAIT_L(0); PG8_MMA(0, 1, At, B1); PG8_BAR;
            PG8_LDA(At, 1, 1); PG8_STAGE(PG8_SA(1, 0), a3, voffA);
            PG8_BAR; PG8_WAIT_L(0); PG8_MMA(1, 0, At, B0); PG8_BAR; PG8_SCHED;
            PG8_STAGE(PG8_SB(1, 1), b3 + hstepB, voffB);
            PG8_WAIT_V(6); PG8_BAR; PG8_MMA(1, 1, At, B1); PG8_BAR;
            }
        }
        if constexpr (ALIGN_EPI) { if (wr == 0) PG8_BAR; }
        if constexpr (!Epi::AFTER_DRAIN) { E(acc, cur, wr, wc, fr, fq); S.done(cur); }
        if (!has_next) break;
#pragma unroll
        for (int a = 0; a < 2; ++a)
#pragma unroll
            for (int b = 0; b < 2; ++b)
#pragma unroll
                for (int m = 0; m < 4; ++m)
#pragma unroll
                    for (int n = 0; n < 2; ++n) acc[a][b][m][n] = (f32x4){0.f, 0.f, 0.f, 0.f};
        cur = nxt; cA = nA; cB = nB; ++ui;
        if constexpr (ALIGN_EPI) { if (wr == 1) PG8_BAR; }
    }
    PG8_WAIT_V(0);
    if constexpr (!ALIGN_EPI) { if (wr == 0) PG8_BAR; }
    PG8_BAR;
    if constexpr (Epi::AFTER_DRAIN) { E.fused(acc, cur, wr, wc, fr, fq, lds, wid, lane); S.done(cur); }
#undef PG8_SA
#undef PG8_SB
#undef PG8_STAGE
#undef PG8_LDA
#undef PG8_LDB
#undef PG8_MMA
#undef PG8_WAIT_V
#undef PG8_WAIT_L
#undef PG8_BAR
#undef PG8_SCHED
}
}

constexpr int T = 8192, D = 2048, FF = 5504, NGU = 2 * FF, HD = 128, NSEL = 128, NCMP = 511;
constexpr int IN_COLS = 5656, INP = 5888;
constexpr int MEMT = 256, MEMH = 4, MEMD = 512;
constexpr float LN_EPS = 1e-5f, RMS_EPS = 1e-6f;
constexpr float ALPHA = 1.189207115002721f;
constexpr float LOG2E = 1.4426950408889634f;
constexpr float QSCALE = 0.08838834764831845f * LOG2E;
constexpr float MEMQSCALE = 0.04419417382415922f;
constexpr int NWAVES = 8, NTHREADS = 512;

constexpr size_t MiB = 1u << 20;
constexpr size_t WS_CTL = 0, CTL_ZERO_BYTES = 1 * MiB;
constexpr size_t CTL_BIAS1 = 512 * 1024;
constexpr size_t WS_ROPE = 1 * MiB;
constexpr size_t WS_GATES = 5 * MiB;
constexpr size_t WS_KCMP = 6 * MiB;
constexpr size_t WS_VCMPT = 6 * MiB + 256 * 1024;
constexpr size_t WS_W2T = 6 * MiB + 512 * 1024;
constexpr size_t WS_MEMB = 7 * MiB, WS_KMEM = 8 * MiB, WS_VT = 9 * MiB;
constexpr size_t WS_W1T = 10 * MiB;
constexpr size_t WS_PC = 14 * MiB;
constexpr size_t WS_WGU1 = 30 * MiB, WS_WD1 = 73 * MiB, WS_WGU2 = 95 * MiB, WS_WD2 = 138 * MiB, WS_WIN = 160 * MiB, WS_WOUT = 183 * MiB;
constexpr size_t WS_WQ = 191 * MiB, WS_WK = 199 * MiB, WS_WV = 207 * MiB, WS_WO = 215 * MiB;
constexpr size_t WS_X = 224 * MiB;
constexpr size_t WS_XB = 288 * MiB;
constexpr size_t WS_BIG = 320 * MiB, WS_END = 416 * MiB;
constexpr size_t BG_SBQ = 0, BG_SBK = 16 * MiB, BG_SBVT = 32 * MiB, BG_NQ = 48 * MiB, BG_CMPIN = 64 * MiB, BG_KSL = 72 * MiB, BG_VSLT = 76 * MiB, BG_KWN = 80 * MiB, BG_VWNT = 84 * MiB;
constexpr size_t BG_QC = 0, BG_S = 32 * MiB, BG_P = 64 * MiB;
static_assert((size_t)NGU * D * 2 <= WS_WD1 - WS_WGU1 && (size_t)D * FF * 2 <= WS_WGU2 - WS_WD1 && (size_t)INP * D * 2 <= WS_WOUT - WS_WIN && (size_t)T * FF * 2 <= WS_END - WS_BIG, "ws map");
constexpr int CW_TMO = 0, CW_BAR = 4096;

#define GAS __attribute__((address_space(1)))
#define LAS __attribute__((address_space(3)))
typedef unsigned short bf16;
typedef unsigned v4u __attribute__((ext_vector_type(4)));
typedef unsigned v2u __attribute__((ext_vector_type(2)));
typedef float f32x4 __attribute__((ext_vector_type(4)));
typedef float f32x16 __attribute__((ext_vector_type(16)));
typedef short bf16x8 __attribute__((ext_vector_type(8)));
typedef short s16x4 __attribute__((ext_vector_type(4)));
#define LDS_WAIT() asm volatile("s_waitcnt lgkmcnt(0)" ::: "memory")
using pg8::cvt_pk_bf16;
__device__ __forceinline__ int crow(int r, int h) { return (r & 3) + 8 * (r >> 2) + 4 * h; }
__device__ __forceinline__ float ex2(float x) { return __builtin_amdgcn_exp2f(x); }
__device__ __forceinline__ float lg2(float x) { return __builtin_amdgcn_logf(x); }

#define XB_TMO      128
#define XB_XCNT(j)  (256  + 64 * (j))
#define XB_XSUB(j)  (1280 + 64 * (j))
#define XB_XGEN(j)  (2304 + 64 * (j))
#define XB_TOP      3328
#define XB_TOPGEN   3392
#define XCD_BAR_WORDS 3456
#define XB_SPIN_CAP (1u << 20)
__device__ __forceinline__ unsigned xb_ld(unsigned* p)              { return __hip_atomic_load(p, __ATOMIC_RELAXED, __HIP_MEMORY_SCOPE_AGENT); }
__device__ __forceinline__ unsigned xb_add(unsigned* p, unsigned v) { return __hip_atomic_fetch_add(p, v, __ATOMIC_RELAXED, __HIP_MEMORY_SCOPE_AGENT); }
__device__ __forceinline__ unsigned xb_xcc_id() { return (unsigned)__builtin_amdgcn_s_getreg((3 << 11) | 20) & 0xFu; }
#define XB_SPIN(cond, bar) do { unsigned _sp = 0; while (cond) { __builtin_amdgcn_s_sleep(1); \
    if ((++_sp & 255u) == 0u) { if (xb_ld(&(bar)[XB_TMO])) break; if (_sp > XB_SPIN_CAP) { atomicAdd(&(bar)[XB_TMO], 1u); break; } } } } while (0)
struct XcdBarrier { unsigned* bar; unsigned x; volatile LAS unsigned* st; };
__device__ __forceinline__ XcdBarrier xcd_barrier_post(unsigned* bar, volatile LAS unsigned* st) {
    XcdBarrier b; b.bar = bar; b.x = xb_xcc_id(); b.st = st;
    if (threadIdx.x == 0) (void)xb_add(&bar[XB_XCNT(b.x)], 1u);
    return b;
}
__device__ __forceinline__ void xcd_barrier_complete(unsigned* bar, unsigned x, unsigned& nloc, unsigned& nx) {
    const unsigned G = gridDim.x * gridDim.y * gridDim.z;
    unsigned sum, cnt, mine, sp = 0u;
    for (;;) {
        sum = 0u; cnt = 0u; mine = 0u;
#pragma unroll
        for (unsigned j = 0; j < 16; ++j) { const unsigned c = xb_ld(&bar[XB_XCNT(j)]); sum += c; cnt += (c > 0u) ? 1u : 0u; mine = (j == x) ? c : mine; }
        if (sum == G) break;
        __builtin_amdgcn_s_sleep(1);
        if ((++sp & 255u) == 0u) { if (xb_ld(&bar[XB_TMO])) break; if (sp > XB_SPIN_CAP) { atomicAdd(&bar[XB_TMO], 1u); break; } }
    }
    nloc = mine > 0u ? mine : 1u; nx = cnt > 0u ? cnt : 1u;
}
__device__ __forceinline__ void xcd_barrier(const XcdBarrier& b) {
    asm volatile("s_waitcnt vmcnt(0)" ::: "memory");
    __syncthreads();
    if (threadIdx.x == 0) {
        unsigned* bar = b.bar;
        __builtin_amdgcn_s_waitcnt(0);
        unsigned nloc = b.st[0], nx = b.st[1];
        if (nloc == 0u) { xcd_barrier_complete(bar, b.x, nloc, nx); b.st[0] = nloc; b.st[1] = nx; }
        const unsigned old = xb_add(&bar[XB_XSUB(b.x)], 1u);
        const unsigned gen = old / nloc;
        if (old + 1u == (gen + 1u) * nloc) {
            __builtin_amdgcn_fence(__ATOMIC_RELEASE, "agent");
            asm volatile("s_waitcnt vmcnt(0)" ::: "memory");
            const unsigned og = xb_add(&bar[XB_TOP], 1u);
            const unsigned tg = og / nx;
            if (og + 1u == (tg + 1u) * nx) xb_add(&bar[XB_TOPGEN], 1u);
            else XB_SPIN(xb_ld(&bar[XB_TOPGEN]) == tg, bar);
            __builtin_amdgcn_fence(__ATOMIC_ACQUIRE, "agent");
            xb_add(&bar[XB_XGEN(b.x)], 1u);
            asm volatile("s_waitcnt vmcnt(0)" ::: "memory");
        } else {
            XB_SPIN(xb_ld(&bar[XB_XGEN(b.x)]) == gen, bar);
            __builtin_amdgcn_fence(__ATOMIC_ACQUIRE, "agent");
            asm volatile("s_waitcnt vmcnt(0)" ::: "memory");
        }
    }
    __syncthreads();
}

struct Args { const float* in[29]; float* out; unsigned char* ws; double invf[64]; int ph_lo, ph_hi; };
struct Ctx {
    const float* const* in; float* out; unsigned char* ws; LAS unsigned char* lds;
    int tid, lane, wave, G, bid, gw, NGW;
};
__device__ __forceinline__ bf16* wsb(const Ctx& C, size_t off) { return (bf16*)(C.ws + off); }
__device__ __forceinline__ float* wsf(const Ctx& C, size_t off) { return (float*)(C.ws + off); }

__device__ __forceinline__ float wave_sum(float v) {
#pragma unroll
    for (int o = 1; o < 64; o <<= 1) v += __shfl_xor(v, o);
    return v;
}
__device__ __forceinline__ float wave_max(float v) {
#pragma unroll
    for (int o = 1; o < 64; o <<= 1) v = fmaxf(v, __shfl_xor(v, o));
    return v;
}

__device__ __forceinline__ void conv_item(const float* __restrict__ src, int ldsrc, int srccol, int k0, bf16* dst, int ldd, int drow0, LAS float* scr, int lane) {
#pragma unroll 8
    for (int i = 0; i < 32; ++i) { const int kk = 2 * i + (lane >> 5); scr[kk * 33 + (lane & 31)] = srccol >= 0 ? src[(size_t)(k0 + kk) * ldsrc + srccol] : 0.f; }
    LDS_WAIT(); asm volatile("" ::: "memory");
    const int c = lane & 7;
#pragma unroll
    for (int j = 0; j < 4; ++j) { const int n = (lane >> 3) + 8 * j; const LAS float* s = scr + (8 * c) * 33 + n;
        v4u o; o.x = cvt_pk_bf16(s[0 * 33], s[1 * 33]); o.y = cvt_pk_bf16(s[2 * 33], s[3 * 33]); o.z = cvt_pk_bf16(s[4 * 33], s[5 * 33]); o.w = cvt_pk_bf16(s[6 * 33], s[7 * 33]);
        *(v4u*)(dst + (size_t)(drow0 + n) * ldd + k0 + 8 * c) = o; }
    LDS_WAIT(); asm volatile("" ::: "memory");
}
__device__ __forceinline__ int win_srccol(int p) {
    if (p >= IN_COLS) return -1;
    const bool rope = (p >= 3072 && p < 4352) || (p >= 4608 && p < 4864) || (p >= 5120 && p < 5376);
    if (!rope) return p;
    const int hb = p & ~127, pp = p & 127, wc = pp >> 5, n = (pp >> 4) & 1, r = pp & 15;
    return hb + 64 * n + 16 * wc + r;
}
__device__ __forceinline__ void sincos_d(double r, float& c, float& s) {
    const double x = 0.25 * r, x2 = x * x;
    double sn = x * (1.0 + x2 * (-1.0 / 6 + x2 * (1.0 / 120 + x2 * (-1.0 / 5040 + x2 * (1.0 / 362880 + x2 * (-1.0 / 39916800 + x2 * (1.0 / 6227020800.0)))))));
    double cs = 1.0 + x2 * (-0.5 + x2 * (1.0 / 24 + x2 * (-1.0 / 720 + x2 * (1.0 / 40320 + x2 * (-1.0 / 3628800 + x2 * (1.0 / 479001600.0))))));
    double s2 = 2.0 * sn * cs, c2 = 1.0 - 2.0 * sn * sn;
    double s4 = 2.0 * s2 * c2, c4 = 1.0 - 2.0 * s2 * s2;
    c = (float)c4; s = (float)s4;
}
__device__ __forceinline__ void p0_prologue(const Ctx& C, const double* invf) {
    LAS float* scr = (LAS float*)(C.lds + C.wave * 16384);
    const int lane = C.lane;
    constexpr int I_GU = 32 * (NGU / 32), I_D = (FF / 64) * (D / 32), I_WIN = 32 * (INP / 32), I_SQ = 32 * 64, I_W1 = 64 * 8, I_W2 = 4 * 4;
    constexpr int NITEMS = 2 * (I_GU + I_D) + I_WIN + 5 * I_SQ + 2 * I_W1 + 2 * I_W2;
    for (int it = C.gw; it < NITEMS; it += C.NGW) {
        int r = it;
        if (r < 2 * (I_GU + I_D)) {
            const int f = r >= (I_GU + I_D); if (f) r -= I_GU + I_D;
            const float* gate = C.in[f ? 24 : 4]; const float* up = C.in[f ? 25 : 5]; const float* down = C.in[f ? 26 : 6];
            if (r < I_GU) { const int ndb = NGU / 32, db = r % ndb, kb = r / ndb, p0 = db * 32, tile = p0 >> 8, rr = p0 & 255;
                const float* src = rr < 128 ? gate : up; const int col = tile * 128 + (rr & 127) + (lane & 31);
                conv_item(src, FF, col, kb * 64, wsb(C, f ? WS_WGU2 : WS_WGU1), D, p0, scr, lane); }
            else { r -= I_GU; const int ndb = D / 32, db = r % ndb, kb = r / ndb;
                conv_item(down, D, db * 32 + (lane & 31), kb * 64, wsb(C, f ? WS_WD2 : WS_WD1), FF, db * 32, scr, lane); }
            continue; }
        r -= 2 * (I_GU + I_D);
        if (r < I_WIN) { const int ndb = INP / 32, db = r % ndb, kb = r / ndb;
            conv_item(C.in[7], IN_COLS, win_srccol(db * 32 + (lane & 31)), kb * 64, wsb(C, WS_WIN), D, db * 32, scr, lane); continue; }
        r -= I_WIN;
        if (r < 5 * I_SQ) { const int w = r / I_SQ; r -= w * I_SQ; const int db = r % 64, kb = r / 64;
            const float* src = C.in[w == 0 ? 15 : 17 + w];
            const size_t dst = w == 0 ? WS_WOUT : (w == 1 ? WS_WQ : (w == 2 ? WS_WK : (w == 3 ? WS_WV : WS_WO)));
            conv_item(src, D, db * 32 + (lane & 31), kb * 64, wsb(C, dst), D, db * 32, scr, lane); continue; }
        r -= 5 * I_SQ;
        if (r < 2 * I_W1) { const int kv = r / I_W1; r -= kv * I_W1; const int db = r % 8, kb = r / 8;
            conv_item(C.in[kv ? 12 : 9], 256, db * 32 + (lane & 31), kb * 64, wsb(C, WS_W1T) + (size_t)kv * 256 * 4096, 4096, db * 32, scr, lane); continue; }
        r -= 2 * I_W1;
        { const int kv = r / I_W2; r -= kv * I_W2; const int db = r % 4, kb = r / 4;
            conv_item(C.in[kv ? 13 : 10], 128, db * 32 + (lane & 31), kb * 64, wsb(C, WS_W2T) + (size_t)kv * 128 * 256, 256, db * 32, scr, lane); }
    }
    { const int gt = C.gw * 64 + lane, NT = C.NGW * 64;
      const float* x = C.in[0]; bf16* xb = wsb(C, WS_XB);
      for (int i = gt; i < T * D / 8; i += NT) { const f32x4 a = *(const f32x4*)(x + (size_t)i * 8), b = *(const f32x4*)(x + (size_t)i * 8 + 4);
          v4u o; o.x = cvt_pk_bf16(a[0], a[1]); o.y = cvt_pk_bf16(a[2], a[3]); o.z = cvt_pk_bf16(b[0], b[1]); o.w = cvt_pk_bf16(b[2], b[3]); *(v4u*)(xb + (size_t)i * 8) = o; }
      const float* mem = C.in[1]; bf16* mb = wsb(C, WS_MEMB);
      for (int i = gt; i < MEMT * D / 8; i += NT) { const f32x4 a = *(const f32x4*)(mem + (size_t)i * 8), b = *(const f32x4*)(mem + (size_t)i * 8 + 4);
          v4u o; o.x = cvt_pk_bf16(a[0], a[1]); o.y = cvt_pk_bf16(a[2], a[3]); o.z = cvt_pk_bf16(b[0], b[1]); o.w = cvt_pk_bf16(b[2], b[3]); *(v4u*)(mb + (size_t)i * 8) = o; }
      float* rope = wsf(C, WS_ROPE);
      for (int i = gt; i < T * 64; i += NT) { const int pos = i >> 6, fi = i & 63; const double ang = (double)pos * invf[fi];
          const double n = rint(ang * 0.15915494309189535); const double rr = fma(-n, 6.283185307179586, ang) - n * 2.4492935982947064e-16;
          float c, s; sincos_d(rr, c, s); rope[2 * (size_t)i] = c; rope[2 * (size_t)i + 1] = s; }
    }
    for (int task = C.gw; task < 2 * 4 * 32; task += C.NGW) { const int kv = task >> 7, nch = (task >> 5) & 3, kch = task & 31, n = nch * 64 + lane;
        const float* pos = C.in[kv ? 11 : 8]; const float* w1 = C.in[kv ? 12 : 9]; float acc = 0.f;
#pragma unroll 8
        for (int k = kch * 128; k < kch * 128 + 128; ++k) acc += pos[k] * w1[(size_t)k * 256 + n];
        atomicAdd((float*)(C.ws + CTL_BIAS1) + kv * 256 + n, acc); }
}

__device__ __forceinline__ void ln_rows(const Ctx& C, const float* Y, const float* g, const float* b, float* X, bf16* Xb) {
    for (int row = C.gw; row < T; row += C.NGW) {
        const f32x4* yr = (const f32x4*)(Y + (size_t)row * D) + C.lane;
        f32x4 v[8]; float s = 0.f;
#pragma unroll
        for (int j = 0; j < 8; ++j) { v[j] = yr[64 * j]; s += (v[j][0] + v[j][1]) + (v[j][2] + v[j][3]); }
        const float mean = wave_sum(s) * (1.f / D); float s2 = 0.f;
#pragma unroll
        for (int j = 0; j < 8; ++j) { v[j] = v[j] - mean; s2 += (v[j][0] * v[j][0] + v[j][1] * v[j][1]) + (v[j][2] * v[j][2] + v[j][3] * v[j][3]); }
        const float rstd = 1.f / sqrtf(wave_sum(s2) * (1.f / D) + LN_EPS);
#pragma unroll
        for (int j = 0; j < 8; ++j) { const f32x4 gg = *((const f32x4*)g + C.lane + 64 * j), bb = *((const f32x4*)b + C.lane + 64 * j);
            const f32x4 o = v[j] * rstd * gg + bb;
            *((f32x4*)(X + (size_t)row * D) + C.lane + 64 * j) = o;
            if (Xb) *((v2u*)(Xb + (size_t)row * D) + C.lane + 64 * j) = pg8::pack4(o); }
    }
}
__device__ __forceinline__ void rms_rows(const Ctx& C, const float* O, const float* g, bf16* Yb) {
    const int half = C.lane >> 5, l5 = C.lane & 31;
    for (int row = C.gw; row < T; row += C.NGW) {
        const f32x4* orow = (const f32x4*)(O + (size_t)row * D + half * 1024) + l5;
        f32x4 v[8]; float s2 = 0.f;
#pragma unroll
        for (int j = 0; j < 8; ++j) { v[j] = orow[32 * j]; s2 += (v[j][0] * v[j][0] + v[j][1] * v[j][1]) + (v[j][2] * v[j][2] + v[j][3] * v[j][3]); }
#pragma unroll
        for (int o = 1; o < 32; o <<= 1) s2 += __shfl_xor(s2, o);
        const float rstd = 1.f / sqrtf(s2 * (1.f / 1024.f) + RMS_EPS);
#pragma unroll
        for (int j = 0; j < 8; ++j) { const f32x4 gg = *((const f32x4*)(g + half * 1024) + l5 + 32 * j);
            *((v2u*)(Yb + (size_t)row * D + half * 1024) + l5 + 32 * j) = pg8::pack4(v[j] * rstd * gg); }
    }
}
__device__ __forceinline__ void softmax_rows(const Ctx& C, const float* S, bf16* P) {
    for (int row = C.gw; row < MEMH * T; row += C.NGW) {
        const f32x4 v = *((const f32x4*)(S + (size_t)row * MEMT) + C.lane);
        const float m = wave_max(fmaxf(fmaxf(v[0], v[1]), fmaxf(v[2], v[3])));
        f32x4 e; float s = 0.f;
#pragma unroll
        for (int j = 0; j < 4; ++j) { e[j] = ex2((v[j] - m) * LOG2E); s += e[j]; }
        const float inv = 1.f / wave_sum(s);
        *((v2u*)(P + (size_t)row * MEMT) + C.lane) = pg8::pack4(e * inv);
    }
}

__device__ __forceinline__ float gelu_tanh(float x) {
    const float u = 0.7978845608028654f * (x + 0.044715f * x * x * x);
    const float th = 1.f - 2.f * __builtin_amdgcn_rcpf(1.f + ex2(2.f * LOG2E * u));
    return 0.5f * x * (1.f + th);
}
__device__ __forceinline__ void compress_l2(const Ctx& C) {
    const int lane = C.lane, r32 = lane & 31, h = lane >> 5;
    const float* PC = wsf(C, WS_PC); const float* bias1 = (const float*)(C.ws + CTL_BIAS1);
    for (int task = C.gw; task < 2 * 2 * 16 * 4; task += C.NGW) {
        const int nt = task & 3, rt = (task >> 2) & 15, g = (task >> 6) & 1, kv = task >> 7;
        const bf16* w2 = wsb(C, WS_W2T) + (size_t)kv * 128 * 256 + (size_t)(nt * 32 + r32) * 256 + 8 * h;
        f32x16 acc = {};
#pragma unroll 2
        for (int s = 0; s < 16; ++s) {
            const int k0 = 16 * s + 8 * h; f32x4 a0 = *(const f32x4*)(bias1 + kv * 256 + k0), a1 = *(const f32x4*)(bias1 + kv * 256 + k0 + 4);
#pragma unroll
            for (int kc = 0; kc < 8; ++kc) { const float* p = PC + ((((size_t)kc * 2 + kv) * 2 + g) * 512 + rt * 32 + r32) * 256 + k0;
                a0 = a0 + *(const f32x4*)p; a1 = a1 + *(const f32x4*)(p + 4); }
            v4u aw; aw.x = cvt_pk_bf16(gelu_tanh(a0[0]), gelu_tanh(a0[1])); aw.y = cvt_pk_bf16(gelu_tanh(a0[2]), gelu_tanh(a0[3]));
            aw.z = cvt_pk_bf16(gelu_tanh(a1[0]), gelu_tanh(a1[1])); aw.w = cvt_pk_bf16(gelu_tanh(a1[2]), gelu_tanh(a1[3]));
            const bf16x8 bw = *(const bf16x8*)(w2 + 16 * s);
            acc = __builtin_amdgcn_mfma_f32_32x32x16_bf16(__builtin_bit_cast(bf16x8, aw), bw, acc, 0, 0, 0);
        }
        if (kv == 0) { bf16* o = wsb(C, WS_KCMP) + (size_t)g * 512 * 128;
#pragma unroll
            for (int r = 0; r < 16; ++r) { const int row = rt * 32 + crow(r, h); o[(size_t)row * 128 + nt * 32 + r32] = row < NCMP ? (bf16)(cvt_pk_bf16(acc[r], 0.f) & 0xffffu) : (bf16)0; } }
        else { bf16* o = wsb(C, WS_VCMPT) + ((size_t)g * 16 + rt) * 128 * 32 + (size_t)(nt * 32 + r32) * 32;
#pragma unroll
            for (int gq = 0; gq < 4; ++gq) { const int rl = 8 * gq + 4 * h; f32x4 v = {acc[4 * gq], acc[4 * gq + 1], acc[4 * gq + 2], acc[4 * gq + 3]};
#pragma unroll
                for (int i = 0; i < 4; ++i) if (rt * 32 + rl + i >= NCMP) v[i] = 0.f;
                *(v2u*)(o + rl) = pg8::pack4(v); } }
    }
}

__device__ __forceinline__ f32x16 qk_tile(const bf16* Krow  , const bf16x8 (&qf)[8]) {
    f32x16 st = {};
#pragma unroll
    for (int s = 0; s < 8; ++s) st = __builtin_amdgcn_mfma_f32_32x32x16_bf16(*(const bf16x8*)(Krow + 16 * s), qf[s], st, 0, 0, 0);
    return st;
}
__device__ __forceinline__ void pv_tile(f32x16 (&o)[4], const bf16* Vtile  , const float (&w)[16], int r32, int h) {
    v4u p0, p1;
    p0.x = cvt_pk_bf16(w[0], w[1]); p0.y = cvt_pk_bf16(w[2], w[3]); p0.z = cvt_pk_bf16(w[4], w[5]); p0.w = cvt_pk_bf16(w[6], w[7]);
    p1.x = cvt_pk_bf16(w[8], w[9]); p1.y = cvt_pk_bf16(w[10], w[11]); p1.z = cvt_pk_bf16(w[12], w[13]); p1.w = cvt_pk_bf16(w[14], w[15]);
    const bf16x8 b0 = __builtin_bit_cast(bf16x8, p0), b1 = __builtin_bit_cast(bf16x8, p1);
#pragma unroll
    for (int db = 0; db < 4; ++db) { const bf16* vr = Vtile + (size_t)(32 * db + r32) * 32 + 4 * h;
        const v2u a0 = *(const v2u*)(vr), a1 = *(const v2u*)(vr + 8), a2 = *(const v2u*)(vr + 16), a3 = *(const v2u*)(vr + 24);
        const v4u f0 = {a0.x, a0.y, a1.x, a1.y}, f1 = {a2.x, a2.y, a3.x, a3.y};
        o[db] = __builtin_amdgcn_mfma_f32_32x32x16_bf16(__builtin_bit_cast(bf16x8, f0), b0, o[db], 0, 0, 0);
        o[db] = __builtin_amdgcn_mfma_f32_32x32x16_bf16(__builtin_bit_cast(bf16x8, f1), b1, o[db], 0, 0, 0); }
}

__device__ __forceinline__ void sb_item(const Ctx& C, int hd, int qt, float* Oatt) {
    const int lane = C.lane, c = lane & 31, h = lane >> 5, t = 32 * qt + c;
    const bf16* Qp = wsb(C, WS_BIG + BG_SBQ) + ((size_t)hd * T + t) * 128 + 8 * h;
    bf16x8 qf[8];
#pragma unroll
    for (int s = 0; s < 8; ++s) qf[s] = *(const bf16x8*)(Qp + 16 * s);
    const bf16* Kh = wsb(C, WS_BIG + BG_SBK) + (size_t)hd * T * 128; const bf16* Vh = wsb(C, WS_BIG + BG_SBVT) + (size_t)hd * T * 128;
    f32x16 o[4] = {}; float carry = 0.f;
    for (int kt = qt; kt >= 0; --kt) {
        const f32x16 st = qk_tile(Kh + (size_t)(32 * kt + c) * 128 + 8 * h, qf);
        float l1m[16], lb[16], w[16];
#pragma unroll
        for (int r = 0; r < 16; ++r) { const int key = 32 * kt + crow(r, h); const float z = st[r];
            const float sp = fmaxf(z, 0.f) + lg2(1.f + ex2(-fabsf(z)));
            const bool valid = key < t; l1m[r] = valid ? -sp : 0.f; lb[r] = z - sp; }
        float G[4], PG[4], TT[4];
#pragma unroll
        for (int q = 0; q < 4; ++q) { G[q] = (l1m[4 * q] + l1m[4 * q + 1]) + (l1m[4 * q + 2] + l1m[4 * q + 3]); PG[q] = __shfl_xor(G[q], 32); TT[q] = G[q] + PG[q]; }
        const float SS[4] = {TT[3] + TT[2] + TT[1], TT[3] + TT[2], TT[3], 0.f};
#pragma unroll
        for (int q = 0; q < 4; ++q) { const float before = carry + SS[q] + (h == 0 ? PG[q] : 0.f);
            const float l3 = before, l2 = l3 + l1m[4 * q + 3], l1 = l2 + l1m[4 * q + 2], l0 = l1 + l1m[4 * q + 1];
            const float ls[4] = {l0, l1, l2, l3};
#pragma unroll
            for (int i = 0; i < 4; ++i) { const int r = 4 * q + i; const int key = 32 * kt + crow(r, h); w[r] = key < t ? ex2(lb[r] + ls[i]) : 0.f; } }
        carry += (TT[0] + TT[1]) + (TT[2] + TT[3]);
        pv_tile(o, Vh + (size_t)kt * 32 * 128, w, c, h);
        if (__all(carry < -150.f)) break;
    }
    float* op = Oatt + (size_t)t * D + hd * 128 + 4 * h;
#pragma unroll
    for (int db = 0; db < 4; ++db)
#pragma unroll
        for (int q = 0; q < 4; ++q) *(f32x4*)(op + 32 * db + 8 * q) = (f32x4){o[db][4 * q], o[db][4 * q + 1], o[db][4 * q + 2], o[db][4 * q + 3]};
}

template <class MaskF>
__device__ __forceinline__ void flash_tile(float& m, float& l, f32x16 (&o)[4], const bf16x8 (&qf)[8], const bf16* Krow, const bf16* Vtile, int c, int h, MaskF valid) {
    const f32x16 st = qk_tile(Krow, qf);
    float x[16]; float tm = -INFINITY;
#pragma unroll
    for (int r = 0; r < 16; ++r) { x[r] = valid(r) ? st[r] : -INFINITY; tm = fmaxf(tm, x[r]); }
    tm = fmaxf(tm, __shfl_xor(tm, 32));
    const float mn = fmaxf(m, tm), ms = mn == -INFINITY ? 0.f : mn;
    const float alpha = ex2(m - ms);
    float w[16]; float ps = 0.f;
#pragma unroll
    for (int r = 0; r < 16; ++r) { w[r] = ex2(x[r] - ms); ps += w[r]; }
    l = l * alpha + ps; m = mn;
#pragma unroll
    for (int db = 0; db < 4; ++db) o[db] = o[db] * alpha;
    pv_tile(o, Vtile, w, c, h);
}

constexpr int NSA_WLDS = 2 * 8 * 128 * 4 + 8 * 16;
__device__ __forceinline__ void nsa_item(const Ctx& C, int g, int qo, float* Oatt, LAS unsigned char* wl) {
    const int lane = C.lane, c = lane & 31, h = lane >> 5, qi = c >> 2, hh = c & 3, head = 4 * g + hh, t0 = 8 * qo, t = t0 + qi;
    LAS float* impA = (LAS float*)wl; LAS float* impB = impA + 8 * 128; LAS unsigned long long* selm = (LAS unsigned long long*)(wl + 2 * 8 * 128 * 4);
    const bf16* Qp = wsb(C, WS_BIG + BG_NQ) + ((size_t)head * T + t) * 128 + 8 * h;
    bf16x8 qf[8];
#pragma unroll
    for (int s = 0; s < 8; ++s) qf[s] = *(const bf16x8*)(Qp + 16 * s);
    const float* gp = wsf(C, WS_GATES) + (size_t)t * 24 + head * 3;
    const float g_c = gp[0], g_s = gp[1], g_w = gp[2];
    float* op = Oatt + (size_t)t * D + 1024 + head * 128 + 4 * h;
#pragma unroll
    for (int i = 0; i < 32; ++i) impA[i * 64 + lane] = 0.f;
    const int ncmp = (t0 + 7 >= 31) ? ((t0 + 7 - 31) >> 4) + 1 : 0, ntile = (ncmp + 31) >> 5;
    const int cmax = (t >= 31) ? ((t - 31) >> 4) : -1;
    const bf16* Kc = wsb(C, WS_KCMP) + (size_t)g * 512 * 128; const bf16* Vc = wsb(C, WS_VCMPT) + (size_t)g * 16 * 128 * 32;
    if (ntile > 0) {
        float m = -INFINITY, l = 0.f;
        for (int kt = 0; kt < ntile; ++kt) {
            const f32x16 st = qk_tile(Kc + (size_t)(32 * kt + c) * 128 + 8 * h, qf);
            float tm = -INFINITY; float x[16];
#pragma unroll
            for (int r = 0; r < 16; ++r) { x[r] = (32 * kt + crow(r, h) <= cmax) ? st[r] : -INFINITY; tm = fmaxf(tm, x[r]); }
            tm = fmaxf(tm, __shfl_xor(tm, 32));
            const float mn = fmaxf(m, tm), ms = mn == -INFINITY ? 0.f : mn; float ps = 0.f;
#pragma unroll
            for (int r = 0; r < 16; ++r) ps += ex2(x[r] - ms);
            l = l * ex2(m - ms) + ps; m = mn;
        }
        l += __shfl_xor(l, 32);
        const float ms = m == -INFINITY ? 0.f : m, inv = l > 0.f ? 1.f / l : 0.f;
        f32x16 o[4] = {};
        for (int kt = 0; kt < ntile; ++kt) {
            const f32x16 st = qk_tile(Kc + (size_t)(32 * kt + c) * 128 + 8 * h, qf);
            float w[16];
#pragma unroll
            for (int r = 0; r < 16; ++r) w[r] = (32 * kt + crow(r, h) <= cmax) ? ex2(st[r] - ms) * inv : 0.f;
#pragma unroll
            for (int q = 0; q < 4; ++q) { float a = (w[4 * q] + w[4 * q + 1]) + (w[4 * q + 2] + 0.5f * w[4 * q + 3]), b = 0.5f * w[4 * q + 3];
                a += __shfl_xor(a, 1); a += __shfl_xor(a, 2); b += __shfl_xor(b, 1); b += __shfl_xor(b, 2);
                const int n = 8 * kt + 2 * q + h;
                if (hh == 0) { impA[qi * 128 + n] = a; if (n + 1 < NSEL) impB[qi * 128 + n + 1] = b; } }
            pv_tile(o, Vc + (size_t)kt * 128 * 32, w, c, h);
        }
#pragma unroll
        for (int db = 0; db < 4; ++db)
#pragma unroll
            for (int q = 0; q < 4; ++q) *(f32x4*)(op + 32 * db + 8 * q) = (f32x4){o[db][4 * q], o[db][4 * q + 1], o[db][4 * q + 2], o[db][4 * q + 3]} * g_c;
    } else {
#pragma unroll
        for (int db = 0; db < 4; ++db)
#pragma unroll
            for (int q = 0; q < 4; ++q) *(f32x4*)(op + 32 * db + 8 * q) = (f32x4){0.f, 0.f, 0.f, 0.f};
    }
    const int nb = t0 >> 6;
    LDS_WAIT(); asm volatile("" ::: "memory");
    for (int q = 0; q < 8; ++q) {
        unsigned long long mlo = 0ull, mhi = 0ull;
        if (nb < 16) { mlo = (2ull << nb) - 1ull; }
        else {
            float v0 = impA[q * 128 + lane] + impB[q * 128 + lane], v1 = impA[q * 128 + 64 + lane] + impB[q * 128 + 64 + lane];
            const int i0 = lane, i1 = lane + 64;
            v0 = (i0 == 0 || i0 == nb) ? INFINITY : (i0 <= nb ? v0 : -INFINITY);
            v1 = (i1 == nb) ? INFINITY : (i1 <= nb ? v1 : -INFINITY);
            for (int rd = 0; rd < 16; ++rd) {
                const float mx = wave_max(fmaxf(v0, v1));
                const unsigned long long b0 = __ballot(v0 == mx), b1 = __ballot(v1 == mx);
                int sel;
                if (b0) { sel = __ffsll((long long)b0) - 1; mlo |= 1ull << sel; if (lane == sel) v0 = -INFINITY; }
                else { sel = __ffsll((long long)b1) - 1; mhi |= 1ull << sel; if (lane == sel) v1 = -INFINITY; }
            }
        }
        if (lane == 0) { selm[2 * q] = mlo; selm[2 * q + 1] = mhi; }
    }
    LDS_WAIT(); asm volatile("" ::: "memory");
    const unsigned long long own_lo = selm[2 * qi], own_hi = selm[2 * qi + 1];
    unsigned long long u_lo = 0ull, u_hi = 0ull;
#pragma unroll
    for (int q = 0; q < 8; ++q) { u_lo |= selm[2 * q]; u_hi |= selm[2 * q + 1]; }
    u_lo = ((unsigned long long)__builtin_amdgcn_readfirstlane((unsigned)(u_lo >> 32)) << 32) | (unsigned)__builtin_amdgcn_readfirstlane((unsigned)u_lo);
    u_hi = ((unsigned long long)__builtin_amdgcn_readfirstlane((unsigned)(u_hi >> 32)) << 32) | (unsigned)__builtin_amdgcn_readfirstlane((unsigned)u_hi);
    {
        const bf16* Ks = wsb(C, WS_BIG + BG_KSL) + (size_t)g * T * 128; const bf16* Vs = wsb(C, WS_BIG + BG_VSLT) + (size_t)g * T * 128;
        float m = -INFINITY, l = 0.f; f32x16 o[4] = {};
        for (int half = 0; half < 2; ++half) {
            unsigned long long u = half ? u_hi : u_lo; const unsigned long long own = half ? own_hi : own_lo;
            while (u) {
                const int bi = __ffsll((long long)u) - 1; u &= u - 1ull; const int n = 64 * half + bi;
                const bool sel = (own >> bi) & 1ull;
#pragma unroll 1
                for (int tt = 0; tt < 2; ++tt) { const int key0 = 64 * n + 32 * tt;
                    flash_tile(m, l, o, qf, Ks + (size_t)(key0 + c) * 128 + 8 * h, Vs + (size_t)key0 * 128, c, h, [&](int r) { return sel && (key0 + crow(r, h) <= t); }); }
            }
        }
        l += __shfl_xor(l, 32);
        const float sc = l > 0.f ? g_s / l : 0.f;
#pragma unroll
        for (int db = 0; db < 4; ++db)
#pragma unroll
            for (int q = 0; q < 4; ++q) { f32x4* p = (f32x4*)(op + 32 * db + 8 * q); *p = *p + (f32x4){o[db][4 * q], o[db][4 * q + 1], o[db][4 * q + 2], o[db][4 * q + 3]} * sc; }
    }
    {
        const bf16* Kw = wsb(C, WS_BIG + BG_KWN) + (size_t)g * T * 128; const bf16* Vw = wsb(C, WS_BIG + BG_VWNT) + (size_t)g * T * 128;
        float m = -INFINITY, l = 0.f; f32x16 o[4] = {};
        const int klo = (t0 - 511 > 0 ? t0 - 511 : 0) >> 5, khi = t0 >> 5;
        for (int kt = klo; kt <= khi; ++kt) { const int key0 = 32 * kt;
            flash_tile(m, l, o, qf, Kw + (size_t)(key0 + c) * 128 + 8 * h, Vw + (size_t)key0 * 128, c, h, [&](int r) { const int key = key0 + crow(r, h); return key <= t && key > t - 512; }); }
        l += __shfl_xor(l, 32);
        const float sc = l > 0.f ? g_w / l : 0.f;
#pragma unroll
        for (int db = 0; db < 4; ++db)
#pragma unroll
            for (int q = 0; q < 4; ++q) { f32x4* p = (f32x4*)(op + 32 * db + 8 * q); *p = *p + (f32x4){o[db][4 * q], o[db][4 * q + 1], o[db][4 * q + 2], o[db][4 * q + 3]} * sc; }
    }
}

constexpr int RING_BYTES = 131072, MISC_OFF = RING_BYTES + 320, LDS_BYTES = 147456;
constexpr int N_PHASES = 20;
#ifndef MK_ONE_LAUNCH
#define MK_ONE_LAUNCH 1
#endif

__global__ void __launch_bounds__(NTHREADS, 2) fwd_kernel(Args args) {
    extern __shared__ __attribute__((aligned(16))) unsigned char lds_raw[];
    Ctx C;
    C.in = args.in; C.out = args.out; C.ws = args.ws; C.lds = (LAS unsigned char*)lds_raw;
    C.tid = threadIdx.x; C.lane = C.tid & 63; C.wave = __builtin_amdgcn_readfirstlane(C.tid >> 6);
    C.G = gridDim.x; C.bid = blockIdx.x; C.gw = C.bid * NWAVES + C.wave; C.NGW = C.G * NWAVES;
    volatile LAS unsigned* MISC = (volatile LAS unsigned*)(C.lds + MISC_OFF);
    for (int u = C.tid; u < (LDS_BYTES - RING_BYTES) / 4; u += NTHREADS) ((LAS unsigned*)(C.lds + RING_BYTES))[u] = 0u;
    __syncthreads();
    unsigned* barw = (unsigned*)(C.ws + WS_CTL) + CW_BAR;
    XcdBarrier bar; bar.bar = barw; bar.x = 0; bar.st = nullptr;
    const int lo = args.ph_lo, hi = args.ph_hi;
    if (hi - lo > 1) bar = xcd_barrier_post(barw, MISC + 8);
#ifndef MK_MASK
#define MK_MASK 0xFFFFFu
#endif
#define IN(k) (((MK_MASK >> (k)) & 1u) && lo <= (k) && (k) < hi)
#define SEAM(k) do { if (IN(k) && IN((k) + 1)) xcd_barrier(bar); } while (0)
    LAS unsigned char* ring = C.lds;
    float* Yout = C.out;
    float* X = wsf(C, WS_X); bf16* XB = wsb(C, WS_XB); bf16* Hb = wsb(C, WS_BIG);

    if (IN(0)) { p0_prologue(C, args.invf); } SEAM(0);
    if (IN(1)) {
        { pg8::Gemm gm{XB, wsb(C, WS_WGU1), D, D, D}; pg8::StaticOrder S; S.init(T, NGU, C.G, C.bid); pg8::EpiSwiGLU E{Hb, FF};
          pg8::gemm_phase<pg8::EpiSwiGLU, pg8::StaticOrder, true, true>(ring, gm, S, E); }
        { pg8::Gemm gm{wsb(C, WS_MEMB), wsb(C, WS_WK), D, D, D}; pg8::ListOrder S; S.init(1, 1, 8, C.G, C.bid, C.G - 8, 0, 0); pg8::EpiBf16S E{wsb(C, WS_KMEM), D, 1.f, 0};
          pg8::gemm_phase<pg8::EpiBf16S, pg8::ListOrder, true, true>(ring, gm, S, E); }
        { pg8::Gemm gm{wsb(C, WS_WV), wsb(C, WS_MEMB), D, D, D}; pg8::ListOrder S; S.init(1, 8, 1, C.G, C.bid, C.G - 16, 0, 0); pg8::EpiBf16S E{wsb(C, WS_VT), MEMT, 1.f, 0};
          pg8::gemm_phase<pg8::EpiBf16S, pg8::ListOrder, true, true>(ring, gm, S, E); }
    } SEAM(1);
    if (IN(2)) { pg8::Gemm gm{Hb, wsb(C, WS_WD1), FF, FF, FF}; pg8::StaticOrder S; S.init(T, D, C.G, C.bid); pg8::EpiF32 E{Yout, D, C.in[0], ALPHA, 0.5f, 0};
        pg8::gemm_phase<pg8::EpiF32, pg8::StaticOrder, true, true>(ring, gm, S, E); } SEAM(2);
    if (IN(3)) { ln_rows(C, Yout, C.in[2], C.in[3], X, XB); } SEAM(3);
    if (IN(4)) { pg8::Gemm gm{XB, wsb(C, WS_WIN), D, D, D}; pg8::StaticOrder S; S.init(T, INP, C.G, C.bid);
        pg8::EpiWin E{wsb(C, WS_BIG + BG_SBQ), wsb(C, WS_BIG + BG_SBK), wsb(C, WS_BIG + BG_SBVT), wsb(C, WS_BIG + BG_NQ), wsb(C, WS_BIG + BG_CMPIN), wsb(C, WS_BIG + BG_KSL), wsb(C, WS_BIG + BG_VSLT),
                      wsb(C, WS_BIG + BG_KWN), wsb(C, WS_BIG + BG_VWNT), wsf(C, WS_GATES), wsf(C, WS_ROPE), T, QSCALE};
        pg8::gemm_phase<pg8::EpiWin, pg8::StaticOrder, true, true>(ring, gm, S, E); } SEAM(4);
    if (IN(5)) { pg8::Gemm gm{wsb(C, WS_BIG + BG_CMPIN), wsb(C, WS_W1T), 16 * 128, 4096, 512}; pg8::CmpOrder S{C.G, C.bid, (size_t)T * 128 * 2, (size_t)256 * 4096 * 2};
        pg8::EpiF32 E{wsf(C, WS_PC), 256, nullptr, 0.f, 1.f, (size_t)512 * 256};
        pg8::gemm_phase<pg8::EpiF32, pg8::CmpOrder, true, true>(ring, gm, S, E); } SEAM(5);
    if (IN(6)) { compress_l2(C); } SEAM(6);
    if (IN(7)) {
        if (C.G == 256) {
            { const int item = C.wave * 256 + C.bid; sb_item(C, item & 7, item >> 3, Yout); }
            { const int item = C.wave * 256 + C.bid; nsa_item(C, item & 1, item >> 1, Yout, C.lds + C.wave * 8448); }
        }
    } SEAM(7);
    if (IN(8)) { rms_rows(C, Yout, C.in[14], XB); } SEAM(8);
    if (IN(9)) { pg8::Gemm gm{XB, wsb(C, WS_WOUT), D, D, D}; pg8::StaticOrder S; S.init(T, D, C.G, C.bid); pg8::EpiF32 E{Yout, D, X, ALPHA, 1.f, 0};
        pg8::gemm_phase<pg8::EpiF32, pg8::StaticOrder, true, true>(ring, gm, S, E); } SEAM(9);
    if (IN(10)) { ln_rows(C, Yout, C.in[16], C.in[17], X, XB); } SEAM(10);
    if (IN(11)) { pg8::Gemm gm{XB, wsb(C, WS_WQ), D, D, D}; pg8::StaticOrder S; S.init(T, D, C.G, C.bid); pg8::EpiBf16S E{wsb(C, WS_BIG + BG_QC), D, MEMQSCALE, 0};
        pg8::gemm_phase<pg8::EpiBf16S, pg8::StaticOrder, true, true>(ring, gm, S, E); } SEAM(11);
    if (IN(12)) { pg8::Gemm gm{wsb(C, WS_BIG + BG_QC), wsb(C, WS_KMEM), D, D, MEMD}; pg8::ListOrder S; S.init(MEMH, T / 256, 1, C.G, C.bid, 0, (size_t)MEMD * 2, (size_t)MEMD * 2);
        pg8::EpiF32 E{wsf(C, WS_BIG + BG_S), MEMT, nullptr, 0.f, 1.f, (size_t)T * MEMT};
        pg8::gemm_phase<pg8::EpiF32, pg8::ListOrder, true, true>(ring, gm, S, E); } SEAM(12);
    if (IN(13)) { softmax_rows(C, wsf(C, WS_BIG + BG_S), wsb(C, WS_BIG + BG_P)); } SEAM(13);
    if (IN(14)) { pg8::Gemm gm{wsb(C, WS_BIG + BG_P), wsb(C, WS_VT), MEMT, MEMT, MEMT}; pg8::ListOrder S; S.init(MEMH, T / 256, 2, C.G, C.bid, 0, (size_t)T * MEMT * 2, (size_t)MEMD * MEMT * 2);
        pg8::EpiBf16S E{wsb(C, WS_BIG + BG_QC), D, 1.f, MEMD};
        pg8::gemm_phase<pg8::EpiBf16S, pg8::ListOrder, true, true>(ring, gm, S, E); } SEAM(14);
    if (IN(15)) { pg8::Gemm gm{wsb(C, WS_BIG + BG_QC), wsb(C, WS_WO), D, D, D}; pg8::StaticOrder S; S.init(T, D, C.G, C.bid); pg8::EpiF32 E{Yout, D, X, ALPHA, 1.f, 0};
        pg8::gemm_phase<pg8::EpiF32, pg8::StaticOrder, true, true>(ring, gm, S, E); } SEAM(15);
    if (IN(16)) { ln_rows(C, Yout, C.in[22], C.in[23], X, XB); } SEAM(16);
    if (IN(17)) { pg8::Gemm gm{XB, wsb(C, WS_WGU2), D, D, D}; pg8::StaticOrder S; S.init(T, NGU, C.G, C.bid); pg8::EpiSwiGLU E{Hb, FF};
        pg8::gemm_phase<pg8::EpiSwiGLU, pg8::StaticOrder, true, true>(ring, gm, S, E); } SEAM(17);
    if (IN(18)) { pg8::Gemm gm{Hb, wsb(C, WS_WD2), FF, FF, FF}; pg8::StaticOrder S; S.init(T, D, C.G, C.bid); pg8::EpiF32 E{Yout, D, X, ALPHA, 0.5f, 0};
        pg8::gemm_phase<pg8::EpiF32, pg8::StaticOrder, true, true>(ring, gm, S, E); } SEAM(18);
    if (IN(19)) { ln_rows(C, Yout, C.in[27], C.in[28], Yout, nullptr); }
#undef IN
#undef SEAM
}

extern "C" void kernel_launch(void* const* d_in, const int* in_sizes, int n_in, void* d_out, int out_size, void* d_ws, size_t ws_size, hipStream_t stream) {
    static int grid = 0;
    if (grid == 0) {
        if (n_in != 29 || in_sizes[0] != T * D || out_size != T * D || ws_size < WS_END) { fprintf(stderr, "kernel_launch: unexpected shapes (n_in %d, in0 %d, out %d, ws %zu < %zu); nothing launched\n", n_in, n_in > 0 ? in_sizes[0] : -1, out_size, ws_size, (size_t)WS_END); grid = -1; return; }
        int dev = 0, cus = 0, per_cu = 0;
        if (hipGetDevice(&dev) != hipSuccess || hipDeviceGetAttribute(&cus, hipDeviceAttributeMultiprocessorCount, dev) != hipSuccess) { grid = -1; return; }
        if (hipFuncSetAttribute((const void*)fwd_kernel, hipFuncAttributeMaxDynamicSharedMemorySize, LDS_BYTES) != hipSuccess) { fprintf(stderr, "kernel_launch: hipFuncSetAttribute failed\n"); grid = -1; return; }
        if (hipOccupancyMaxActiveBlocksPerMultiprocessor(&per_cu, (const void*)fwd_kernel, NTHREADS, LDS_BYTES) != hipSuccess || per_cu < 1) { fprintf(stderr, "kernel_launch: occupancy query says %d blocks per CU\n", per_cu); per_cu = 1; }
        (void)hipGetLastError();
        grid = cus;
        if (grid != 256) fprintf(stderr, "kernel_launch: %d CUs; the attention phase is laid out for 256\n", grid);
    }
    if (grid < 0) return;
    (void)hipMemsetAsync((char*)d_ws + WS_CTL, 0, CTL_ZERO_BYTES, stream);
    Args a{};
    for (int i = 0; i < 29; ++i) a.in[i] = (const float*)d_in[i];
    a.out = (float*)d_out; a.ws = (unsigned char*)d_ws;
    for (int i = 0; i < 64; ++i) a.invf[i] = std::pow(10000.0, -(double)i / 64.0);
#if MK_ONE_LAUNCH
    a.ph_lo = 0; a.ph_hi = N_PHASES;
    hipLaunchKernelGGL(fwd_kernel, dim3(grid), dim3(NTHREADS), LDS_BYTES, stream, a);
#else
    for (int p = 0; p < N_PHASES; ++p) { a.ph_lo = p; a.ph_hi = p + 1; hipLaunchKernelGGL(fwd_kernel, dim3(grid), dim3(NTHREADS), LDS_BYTES, stream, a); }
#endif
}
```

```cpp
#include <hip/hip_runtime.h>
#include <cstdio>
#include <cstdint>
#include <cmath>

namespace pg8 {
#define PG8_LAS __attribute__((address_space(3)))
typedef unsigned short bf16_t;
typedef short bf16x8 __attribute__((ext_vector_type(8)));
typedef float f32x4 __attribute__((ext_vector_type(4)));
typedef unsigned u32x4 __attribute__((ext_vector_type(4)));
typedef unsigned u32x2 __attribute__((ext_vector_type(2)));
constexpr int BM = 256, BK = 64, HALF = 128, HTB = HALF * BK * 2  , STAGE_BYTES = 8 * HTB, NXCD = 8, WGM = 8;

__host__ __device__ __forceinline__ int lds_byte(int r, int c) { const int st = (r >> 4) * 2 + (c >> 5), rr = r & 15, cc = c & 31, ob = rr * 64 + cc * 2; return st * 1024 + (ob ^ (((ob >> 9) & 1) << 5)); }
__host__ __device__ __forceinline__ void stage_rc(int b, int& R, int& C) { const int st = b / 1024, sb = b % 1024, swz = sb ^ (((sb >> 9) & 1) << 5); R = (st >> 1) * 16 + swz / 64; C = (st & 1) * 32 + (swz % 64) / 2; }
__host__ __device__ __forceinline__ int perm32(int rho) { const int n = rho >> 4, i = rho & 15; return 8 * (i >> 2) + 4 * n + (i & 3); }

struct Unit { int pm, pn, z; size_t offA, offB; };
struct Gemm { const bf16_t* A; const bf16_t* Bt; int lda, ldb, K; };

struct StaticOrder {
    int nM, nN, nwg, G, c;
    __host__ __device__ void init(int M, int N, int G_, int c_) { nM = M / BM; nN = N / BM; nwg = nM * nN; G = G_; c = c_; }
    __host__ __device__ bool next(int i, Unit& u) const {
        const long L = (long)i * G + c; if (L >= nwg) return false;
        int wgid = (int)L; { const int q = nwg / NXCD, r = nwg % NXCD, xcd = wgid % NXCD, off = wgid / NXCD; wgid = (xcd < r ? xcd * (q + 1) : r * (q + 1) + (xcd - r) * q) + off; }
        const int nig = WGM * nN, gid = wgid / nig, fm = gid * WGM, gsz = (nM - fm) < WGM ? (nM - fm) : WGM;
        u.pm = fm + ((wgid % nig) % gsz); u.pn = (wgid % nig) / gsz; u.z = 0; u.offA = 0; u.offB = 0; return true;
    }
    __device__ __forceinline__ void a_ready(const Unit&) const {}
    __device__ __forceinline__ void done(const Unit&) const {}
};
struct ListOrder {
    int nM, nN, nwg, G, c; size_t zA, zB;
    __host__ __device__ void init(int nZ, int nM_, int nN_, int G_, int c_, int c0, size_t zA_, size_t zB_) { nM = nM_; nN = nN_; nwg = nZ * nM_ * nN_; G = G_; c = (c_ - c0 + G_) % G_; zA = zA_; zB = zB_; }
    __host__ __device__ bool next(int i, Unit& u) const {
        const long L = (long)i * G + c; if (L >= nwg) return false;
        const int l = (int)L; u.pn = l % nN; u.pm = (l / nN) % nM; u.z = l / (nN * nM); u.offA = (size_t)u.z * zA; u.offB = (size_t)u.z * zB; return true;
    }
    __device__ __forceinline__ void a_ready(const Unit&) const {}
    __device__ __forceinline__ void done(const Unit&) const {}
};

typedef float f32x2_t __attribute__((ext_vector_type(2))); typedef __bf16 bf16x2_t __attribute__((ext_vector_type(2)));
struct CmpOrder {
    int G, c; size_t grpA, kvB;
    __host__ __device__ bool next(int i, Unit& u) const {
        const long L = (long)i * G + c; if (L >= 64) return false;
        const int l = (int)L, kc = l & 7, pm = (l >> 3) & 1, g = (l >> 4) & 1, kv = l >> 5;
        u.pm = pm; u.pn = 0; u.z = (kc * 2 + kv) * 2 + g; u.offA = (size_t)(kv * 2 + g) * grpA + (size_t)kc * 1024; u.offB = (size_t)kv * kvB + (size_t)kc * 1024; return true;
    }
    __device__ __forceinline__ void a_ready(const Unit&) const {}
    __device__ __forceinline__ void done(const Unit&) const {}
};
__device__ __forceinline__ unsigned cvt_pk_bf16(float lo, float hi) { f32x2_t v = {lo, hi}; bf16x2_t b = __builtin_convertvector(v, bf16x2_t); return __builtin_bit_cast(unsigned, b); }
__device__ __forceinline__ u32x2 pack4(f32x4 v) { u32x2 w; w.x = cvt_pk_bf16(v[0], v[1]); w.y = cvt_pk_bf16(v[2], v[3]); return w; }

struct EpiSwiGLU {
    static constexpr bool PERM = false, AFTER_DRAIN = false;
    bf16_t* H; int ldh;
    __device__ __forceinline__ void operator()(const f32x4 (&acc)[2][2][4][2], const Unit& u, int wr, int wc, int fr, int fq) const {
        const int row0 = u.pm * BM + wr * 64 + fr, col0 = u.pn * HALF + wc * 32 + 4 * fq;
#pragma unroll
        for (int ai = 0; ai < 2; ++ai)
#pragma unroll
            for (int m = 0; m < 4; ++m) { bf16_t* rowp = H + (size_t)(row0 + ai * HALF + m * 16) * ldh + col0;
#pragma unroll
                for (int n = 0; n < 2; ++n) { const f32x4 g = acc[ai][0][m][n], up = acc[ai][1][m][n]; f32x4 h;
#pragma unroll
                    for (int j = 0; j < 4; ++j) { const float e = __builtin_amdgcn_exp2f(-1.4426950408889634f * g[j]); h[j] = g[j] * __builtin_amdgcn_rcpf(1.0f + e) * up[j]; }
                    *(u32x2*)(rowp + 16 * n) = pack4(h); } }
    }
};
struct EpiF32 {
    static constexpr bool PERM = false, AFTER_DRAIN = false;
    float* O; int ldc; const float* R; float alpha, beta; size_t zO;
    __device__ __forceinline__ void operator()(const f32x4 (&acc)[2][2][4][2], const Unit& u, int wr, int wc, int fr, int fq) const {
        const int row0 = u.pm * BM + wr * 64 + fr, col0 = u.pn * BM + wc * 32 + 4 * fq;
        float* base = O + (size_t)u.z * zO;
#pragma unroll
        for (int ai = 0; ai < 2; ++ai)
#pragma unroll
            for (int m = 0; m < 4; ++m) { const size_t off = (size_t)(row0 + ai * HALF + m * 16) * ldc + col0;
#pragma unroll
                for (int bj = 0; bj < 2; ++bj)
#pragma unroll
                    for (int n = 0; n < 2; ++n) { f32x4 v = acc[ai][bj][m][n] * beta; if (R) { const f32x4 r = *(const f32x4*)(R + off + bj * HALF + n * 16); v = v + r * alpha; }
                        *(f32x4*)(base + off + bj * HALF + n * 16) = v; } }
    }
};
struct EpiBf16S {
    static constexpr bool PERM = false, AFTER_DRAIN = false;
    bf16_t* O; int ldc; float scale; int zcol;
    __device__ __forceinline__ void operator()(const f32x4 (&acc)[2][2][4][2], const Unit& u, int wr, int wc, int fr, int fq) const {
        const int row0 = u.pm * BM + wr * 64 + fr, col0 = u.z * zcol + u.pn * BM + wc * 32 + 4 * fq;
#pragma unroll
        for (int ai = 0; ai < 2; ++ai)
#pragma unroll
            for (int m = 0; m < 4; ++m) { bf16_t* rowp = O + (size_t)(row0 + ai * HALF + m * 16) * ldc + col0;
#pragma unroll
                for (int bj = 0; bj < 2; ++bj)
#pragma unroll
                    for (int n = 0; n < 2; ++n) *(u32x2*)(rowp + bj * HALF + n * 16) = pack4(acc[ai][bj][m][n] * scale); }
    }
};
struct EpiWin {
    static constexpr bool PERM = false, AFTER_DRAIN = false;
    bf16_t *SBQ, *SBK, *SBVT, *NQ, *CMPIN, *KSL, *VSLT, *KWN, *VWNT; float* GATES; const float* ROPE; int T; float qscale;
    __device__ __forceinline__ void st_plain(bf16_t* dst, int head0, const f32x4 (&acc)[2][2][4][2], const Unit& u, int wr, int wc, int fr, int fq, float sc) const {
        const int row0 = u.pm * BM + wr * 64 + fr, c0 = wc * 32 + 4 * fq;
#pragma unroll
        for (int bj = 0; bj < 2; ++bj)
#pragma unroll
            for (int ai = 0; ai < 2; ++ai)
#pragma unroll
                for (int m = 0; m < 4; ++m) { bf16_t* rowp = dst + ((size_t)(head0 + bj) * T + row0 + ai * HALF + m * 16) * 128 + c0;
#pragma unroll
                    for (int n = 0; n < 2; ++n) *(u32x2*)(rowp + 16 * n) = pack4(acc[ai][bj][m][n] * sc); }
    }
    __device__ __forceinline__ void st_rope(bf16_t* dst, int head0, const f32x4 (&acc)[2][2][4][2], const Unit& u, int wr, int wc, int fr, int fq, float sc) const {
        const int row0 = u.pm * BM + wr * 64 + fr, i0 = wc * 16 + 4 * fq;
#pragma unroll
        for (int ai = 0; ai < 2; ++ai)
#pragma unroll
            for (int m = 0; m < 4; ++m) { const int tok = row0 + ai * HALF + m * 16;
                const f32x4 cs0 = *(const f32x4*)(ROPE + ((size_t)tok * 64 + i0) * 2), cs1 = *(const f32x4*)(ROPE + ((size_t)tok * 64 + i0) * 2 + 4);
                const f32x4 co = {cs0[0], cs0[2], cs1[0], cs1[2]}, si = {cs0[1], cs0[3], cs1[1], cs1[3]};
#pragma unroll
                for (int bj = 0; bj < 2; ++bj) { const f32x4 lo = acc[ai][bj][m][0], hi = acc[ai][bj][m][1];
                    const f32x4 olo = (lo * co - hi * si) * sc, ohi = (lo * si + hi * co) * sc;
                    bf16_t* rowp = dst + ((size_t)(head0 + bj) * T + tok) * 128 + i0;
                    *(u32x2*)(rowp) = pack4(olo); *(u32x2*)(rowp + 64) = pack4(ohi); } }
    }
    __device__ __forceinline__ void st_vt(bf16_t* dst, int head0, const f32x4 (&acc)[2][2][4][2], const Unit& u, int wr, int wc, int fr, int fq) const {
        const int row0 = u.pm * BM + wr * 64 + fr, c0 = wc * 32 + 4 * fq;
#pragma unroll
        for (int bj = 0; bj < 2; ++bj)
#pragma unroll
            for (int ai = 0; ai < 2; ++ai)
#pragma unroll
                for (int m = 0; m < 4; ++m) { const int tok = row0 + ai * HALF + m * 16; bf16_t* tb = dst + ((size_t)(head0 + bj) * T + (tok & ~31)) * 128 + (tok & 31);
#pragma unroll
                    for (int n = 0; n < 2; ++n) { const u32x2 w = pack4(acc[ai][bj][m][n]); const int d = c0 + 16 * n;
                        tb[(d + 0) * 32] = (bf16_t)(w.x & 0xffffu); tb[(d + 1) * 32] = (bf16_t)(w.x >> 16); tb[(d + 2) * 32] = (bf16_t)(w.y & 0xffffu); tb[(d + 3) * 32] = (bf16_t)(w.y >> 16); } }
    }
    __device__ __forceinline__ void operator()(const f32x4 (&acc)[2][2][4][2], const Unit& u, int wr, int wc, int fr, int fq) const {
        const int pn = u.pn;
        if (pn < 4) st_plain(SBQ, 2 * pn, acc, u, wr, wc, fr, fq, qscale);
        else if (pn < 8) st_plain(SBK, 2 * (pn - 4), acc, u, wr, wc, fr, fq, 1.f);
        else if (pn < 12) st_vt(SBVT, 2 * (pn - 8), acc, u, wr, wc, fr, fq);
        else if (pn < 16) st_rope(NQ, 2 * (pn - 12), acc, u, wr, wc, fr, fq, qscale);
        else if (pn == 16) st_rope(CMPIN, 0, acc, u, wr, wc, fr, fq, 1.f);
        else if (pn == 17) st_plain(CMPIN, 2, acc, u, wr, wc, fr, fq, 1.f);
        else if (pn == 18) st_rope(KSL, 0, acc, u, wr, wc, fr, fq, 1.f);
        else if (pn == 19) st_vt(VSLT, 0, acc, u, wr, wc, fr, fq);
        else if (pn == 20) st_rope(KWN, 0, acc, u, wr, wc, fr, fq, 1.f);
        else if (pn == 21) st_vt(VWNT, 0, acc, u, wr, wc, fr, fq);
        else {
            if (wc == 0) { const int row0 = u.pm * BM + wr * 64 + fr;
#pragma unroll
                for (int ai = 0; ai < 2; ++ai)
#pragma unroll
                    for (int m = 0; m < 4; ++m) { float* gp = GATES + (size_t)(row0 + ai * HALF + m * 16) * 24;
#pragma unroll
                        for (int n = 0; n < 2; ++n) { const int c = 16 * n + 4 * fq; if (c < 24) { const f32x4 v = acc[ai][0][m][n]; f32x4 s;
#pragma unroll
                                for (int j = 0; j < 4; ++j) s[j] = __builtin_amdgcn_rcpf(1.0f + __builtin_amdgcn_exp2f(-1.4426950408889634f * v[j]));
                                *(f32x4*)(gp + c) = s; } } } }
        }
    }
};

template <class Epi, class Sched, bool ALIGN_EPI = false, bool SP2 = false>
__device__ __forceinline__ void gemm_phase(PG8_LAS unsigned char* lds, const Gemm g, const Sched& S, const Epi& E) {
    const int tid = threadIdx.x, wid = __builtin_amdgcn_readfirstlane(tid >> 6), lane = tid & 63, wr = wid >> 2, wc = wid & 3, fr = lane & 15, fq = lane >> 4;
    const int K = g.K, nt = K / BK, lda = g.lda, ldb = g.ldb;
    unsigned voffA[2], voffB[2];
#pragma unroll
    for (int i = 0; i < 2; ++i) { int R, C; stage_rc(tid * 16 + i * 8192, R, C); const int Rb = Epi::PERM ? ((R & ~31) + perm32(R & 31)) : R;
        voffA[i] = (unsigned)(R * lda + C) * 2u; voffB[i] = (unsigned)(Rb * ldb + C) * 2u; }
    const size_t kstep = (size_t)(BK * 2);
    const size_t hstepA = (size_t)HALF * lda * 2, hstepB = (size_t)HALF * ldb * 2;
    const size_t tstepA = 2 * hstepA, tstepB = 2 * hstepB;
    const unsigned ldsw = (unsigned)wid * 1024u;
    const int aoff = lds_byte(wr * 64 + fr, fq * 8), boff = lds_byte(wc * 32 + fr, fq * 8);
#define PG8_SA(b, h) (((b) * 2 + (h)) * HTB)
#define PG8_SB(b, h) ((4 + (b) * 2 + (h)) * HTB)
#define PG8_STAGE(bufoff, gbase, voff) do { _Pragma("unroll") for (int _i = 0; _i < 2; ++_i) \
        __builtin_amdgcn_global_load_lds((const unsigned*)((const char*)(gbase) + (voff)[_i]), (PG8_LAS unsigned*)(lds + (bufoff) + ldsw + _i * 8192), 16, 0, 0); } while (0)
#define PG8_LDA(dst, b, h) do { _Pragma("unroll") for (int m = 0; m < 4; ++m) _Pragma("unroll") for (int k = 0; k < 2; ++k) dst[m][k] = *(const PG8_LAS bf16x8*)(lds + PG8_SA(b, h) + aoff + m * 2048 + k * 1024); } while (0)
#define PG8_LDB(dst, b, h) do { _Pragma("unroll") for (int n = 0; n < 2; ++n) _Pragma("unroll") for (int k = 0; k < 2; ++k) dst[n][k] = *(const PG8_LAS bf16x8*)(lds + PG8_SB(b, h) + boff + n * 2048 + k * 1024); } while (0)
#define PG8_MMA(ai, bj, At, Bt) do { __builtin_amdgcn_s_setprio(1); _Pragma("unroll") for (int m = 0; m < 4; ++m) _Pragma("unroll") for (int n = 0; n < 2; ++n) _Pragma("unroll") for (int k = 0; k < 2; ++k) \
        acc[ai][bj][m][n] = __builtin_amdgcn_mfma_f32_16x16x32_bf16(Bt[n][k], At[m][k], acc[ai][bj][m][n], 0, 0, 0); __builtin_amdgcn_s_setprio(0); } while (0)
#define PG8_WAIT_V(n) asm volatile("s_waitcnt vmcnt(" #n ")" ::: "memory")
#define PG8_WAIT_L(n) asm volatile("s_waitcnt lgkmcnt(" #n ")" ::: "memory")
#define PG8_BAR __builtin_amdgcn_s_barrier()
#define PG8_SCHED __builtin_amdgcn_sched_barrier(0)
    Unit cur, nxt; int ui = 0;
    if (!S.next(0, cur)) return;
    f32x4 acc[2][2][4][2];
#pragma unroll
    for (int a = 0; a < 2; ++a)
#pragma unroll
        for (int b = 0; b < 2; ++b)
#pragma unroll
            for (int m = 0; m < 4; ++m)
#pragma unroll
                for (int n = 0; n < 2; ++n) acc[a][b][m][n] = (f32x4){0.f, 0.f, 0.f, 0.f};
    bf16x8 At[4][2], B0[2][2], B1[2][2];
    const char* cA = (const char*)g.A + (size_t)cur.pm * tstepA + cur.offA; const char* cB = (const char*)g.Bt + (size_t)cur.pn * tstepB + cur.offB;
    S.a_ready(cur);
    if constexpr (SP2) {
        PG8_STAGE(PG8_SB(0, 0), cB, voffB); PG8_STAGE(PG8_SB(0, 1), cB + hstepB, voffB); PG8_STAGE(PG8_SA(0, 0), cA, voffA); PG8_STAGE(PG8_SA(0, 1), cA + hstepA, voffA);
        if (wr == 1) PG8_BAR;
        PG8_WAIT_V(2); PG8_BAR;
        PG8_STAGE(PG8_SB(1, 0), cB + kstep, voffB); PG8_STAGE(PG8_SA(1, 0), cA + kstep, voffA); PG8_STAGE(PG8_SB(1, 1), cB + hstepB + kstep, voffB);
        PG8_WAIT_V(6); PG8_BAR;
    } else {
        PG8_STAGE(PG8_SB(0, 0), cB, voffB); PG8_STAGE(PG8_SA(0, 0), cA, voffA); PG8_STAGE(PG8_SB(0, 1), cB + hstepB, voffB); PG8_STAGE(PG8_SA(0, 1), cA + hstepA, voffA);
        if (wr == 1) PG8_BAR;
        PG8_WAIT_V(4); PG8_BAR;
        PG8_STAGE(PG8_SB(1, 0), cB + kstep, voffB); PG8_STAGE(PG8_SA(1, 0), cA + kstep, voffA); PG8_STAGE(PG8_SB(1, 1), cB + hstepB + kstep, voffB);
        PG8_WAIT_V(6); PG8_BAR;
    }
    for (;;) {
        const bool has_next = S.next(ui + 1, nxt);
        const char* nA = has_next ? (const char*)g.A + (size_t)nxt.pm * tstepA + nxt.offA : cA; const char* nB = has_next ? (const char*)g.Bt + (size_t)nxt.pn * tstepB + nxt.offB : cB;
        for (int t = 0; t < nt; t += 2) {
            const bool last = (t == nt - 2);
            const char* a1 = cA + (size_t)(t + 1) * kstep;
            const char* a2 = last ? nA : cA + (size_t)(t + 2) * kstep; const char* b2 = last ? nB : cB + (size_t)(t + 2) * kstep;
            const char* a3 = a2 + kstep; const char* b3 = b2 + kstep;
            if (last && has_next) S.a_ready(nxt);
            if constexpr (SP2) {
            PG8_LDB(B0, 0, 0); PG8_LDB(B1, 0, 1); PG8_SCHED; PG8_LDA(At, 0, 0); PG8_STAGE(PG8_SA(1, 1), a1 + hstepA, voffA);
            PG8_WAIT_V(8); PG8_WAIT_L(0); PG8_BAR; PG8_MMA(0, 0, At, B0); PG8_MMA(0, 1, At, B1); PG8_BAR; PG8_SCHED;
            PG8_LDA(At, 0, 1); PG8_STAGE(PG8_SB(0, 0), b2, voffB); PG8_STAGE(PG8_SB(0, 1), b2 + hstepB, voffB); PG8_STAGE(PG8_SA(0, 0), a2, voffA);
            PG8_WAIT_V(8); PG8_WAIT_L(0); PG8_BAR; PG8_MMA(1, 0, At, B0); PG8_MMA(1, 1, At, B1); PG8_BAR; PG8_SCHED;
            PG8_LDB(B0, 1, 0); PG8_LDB(B1, 1, 1); PG8_SCHED; PG8_LDA(At, 1, 0); PG8_STAGE(PG8_SA(0, 1), a2 + hstepA, voffA);
            PG8_WAIT_V(8); PG8_WAIT_L(0); PG8_BAR; PG8_MMA(0, 0, At, B0); PG8_MMA(0, 1, At, B1); PG8_BAR; PG8_SCHED;
            PG8_LDA(At, 1, 1); PG8_STAGE(PG8_SB(1, 0), b3, voffB); PG8_STAGE(PG8_SB(1, 1), b3 + hstepB, voffB); PG8_STAGE(PG8_SA(1, 0), a3, voffA);
            PG8_WAIT_V(8); PG8_WAIT_L(0); PG8_BAR; PG8_MMA(1, 0, At, B0); PG8_MMA(1, 1, At, B1); PG8_BAR; PG8_SCHED;
            } else {
            PG8_LDB(B0, 0, 0); PG8_SCHED; PG8_LDA(At, 0, 0); PG8_STAGE(PG8_SA(1, 1), a1 + hstepA, voffA);
            PG8_WAIT_L(8); PG8_BAR; PG8_WAIT_L(0); PG8_MMA(0, 0, At, B0); PG8_BAR; PG8_SCHED;
            PG8_LDB(B1, 0, 1); PG8_STAGE(PG8_SB(0, 0), b2, voffB);
            PG8_BAR; PG8_WAIT_L(0); PG8_MMA(0, 1, At, B1); PG8_BAR;
            PG8_LDA(At, 0, 1); PG8_STAGE(PG8_SA(0, 0), a2, voffA);
            PG8_BAR; PG8_WAIT_L(0); PG8_MMA(1, 0, At, B0); PG8_BAR; PG8_SCHED;
            PG8_STAGE(PG8_SB(0, 1), b2 + hstepB, voffB);
            PG8_WAIT_V(6); PG8_BAR; PG8_MMA(1, 1, At, B1); PG8_BAR;
            PG8_LDB(B0, 1, 0); PG8_SCHED; PG8_LDA(At, 1, 0); PG8_STAGE(PG8_SA(0, 1), a2 + hstepA, voffA);
            PG8_WAIT_L(8); PG8_BAR; PG8_WAIT_L(0); PG8_MMA(0, 0, At, B0); PG8_BAR; PG8_SCHED;
            PG8_LDB(B1, 1, 1); PG8_STAGE(PG8_SB(1, 0), b3, voffB);
            PG8_BAR; PG8_WAIT_L(0); PG8_MMA(0, 1, At, B1); PG8_BAR;
            PG8_LDA(At, 1, 1); PG8_STAGE(PG8_SA(1, 0), a3, voffA);
            PG8_BAR; PG8_WAIT_L(0); PG8_MMA(1, 0, At, B0); PG8_BAR; PG8_SCHED;
            PG8_STAGE(PG8_SB(1, 1), b3 + hstepB, voffB);
            PG8_WAIT_V(6); PG8_BAR; PG8_MMA(1, 1, At, B1); PG8_BAR;
            }
        }
        if constexpr (ALIGN_EPI) { if (wr == 0) PG8_BAR; }
        if constexpr (!Epi::AFTER_DRAIN) { E(acc, cur, wr, wc, fr, fq); S.done(cur); }
        if (!has_next) break;
#pragma unroll
        for (int a = 0; a < 2; ++a)
#pragma unroll
            for (int b = 0; b < 2; ++b)
#pragma unroll
                for (int m = 0; m < 4; ++m)
#pragma unroll
                    for (int n = 0; n < 2; ++n) acc[a][b][m][n] = (f32x4){0.f, 0.f, 0.f, 0.f};
        cur = nxt; cA = nA; cB = nB; ++ui;
        if constexpr (ALIGN_EPI) { if (wr == 1) PG8_BAR; }
    }
    PG8_WAIT_V(0);
    if constexpr (!ALIGN_EPI) { if (wr == 0) PG8_BAR; }
    PG8_BAR;
    if constexpr (Epi::AFTER_DRAIN) { E.fused(acc, cur, wr, wc, fr, fq, lds, wid, lane); S.done(cur); }
#undef PG8_SA
#undef PG8_SB
#undef PG8_STAGE
#undef PG8_LDA
#undef PG8_LDB
#undef PG8_MMA
#undef PG8_WAIT_V
#undef PG8_WAIT_L
#undef PG8_BAR
#undef PG8_SCHED
}
}

constexpr int T = 8192, D = 2048, FF = 5504, NGU = 2 * FF, HD = 128, NSEL = 128, NCMP = 511;
constexpr int IN_COLS = 5656, INP = 5888;
constexpr int MEMT = 256, MEMH = 4, MEMD = 512;
constexpr float LN_EPS = 1e-5f, RMS_EPS = 1e-6f;
constexpr float ALPHA = 1.189207115002721f;
constexpr float LOG2E = 1.4426950408889634f;
constexpr float QSCALE = 0.08838834764831845f * LOG2E;
constexpr float MEMQSCALE = 0.04419417382415922f;
constexpr int NWAVES = 8, NTHREADS = 512;

constexpr size_t MiB = 1u << 20;
constexpr size_t WS_CTL = 0, CTL_ZERO_BYTES = 1 * MiB;
constexpr size_t CTL_BIAS1 = 512 * 1024;
constexpr size_t WS_ROPE = 1 * MiB;
constexpr size_t WS_GATES = 5 * MiB;
constexpr size_t WS_KCMP = 6 * MiB;
constexpr size_t WS_VCMPT = 6 * MiB + 256 * 1024;
constexpr size_t WS_W2T = 6 * MiB + 512 * 1024;
constexpr size_t WS_MEMB = 7 * MiB, WS_KMEM = 8 * MiB, WS_VT = 9 * MiB;
constexpr size_t WS_W1T = 10 * MiB;
constexpr size_t WS_PC = 14 * MiB;
constexpr size_t WS_WGU1 = 30 * MiB, WS_WD1 = 73 * MiB, WS_WGU2 = 95 * MiB, WS_WD2 = 138 * MiB, WS_WIN = 160 * MiB, WS_WOUT = 183 * MiB;
constexpr size_t WS_WQ = 191 * MiB, WS_WK = 199 * MiB, WS_WV = 207 * MiB, WS_WO = 215 * MiB;
constexpr size_t WS_X = 224 * MiB;
constexpr size_t WS_XB = 288 * MiB;
constexpr size_t WS_BIG = 320 * MiB, WS_END = 416 * MiB;
constexpr size_t BG_SBQ = 0, BG_SBK = 16 * MiB, BG_SBVT = 32 * MiB, BG_NQ = 48 * MiB, BG_CMPIN = 64 * MiB, BG_KSL = 72 * MiB, BG_VSLT = 76 * MiB, BG_KWN = 80 * MiB, BG_VWNT = 84 * MiB;
constexpr size_t BG_QC = 0, BG_S = 32 * MiB, BG_P = 64 * MiB;
static_assert((size_t)NGU * D * 2 <= WS_WD1 - WS_WGU1 && (size_t)D * FF * 2 <= WS_WGU2 - WS_WD1 && (size_t)INP * D * 2 <= WS_WOUT - WS_WIN && (size_t)T * FF * 2 <= WS_END - WS_BIG, "ws map");
constexpr int CW_TMO = 0, CW_BAR = 4096;

#define GAS __attribute__((address_space(1)))
#define LAS __attribute__((address_space(3)))
typedef unsigned short bf16;
typedef unsigned v4u __attribute__((ext_vector_type(4)));
typedef unsigned v2u __attribute__((ext_vector_type(2)));
typedef float f32x4 __attribute__((ext_vector_type(4)));
typedef float f32x16 __attribute__((ext_vector_type(16)));
typedef short bf16x8 __attribute__((ext_vector_type(8)));
typedef short s16x4 __attribute__((ext_vector_type(4)));
#define LDS_WAIT() asm volatile("s_waitcnt lgkmcnt(0)" ::: "memory")
using pg8::cvt_pk_bf16;
__device__ __forceinline__ int crow(int r, int h) { return (r & 3) + 8 * (r >> 2) + 4 * h; }
__device__ __forceinline__ float ex2(float x) { return __builtin_amdgcn_exp2f(x); }
__device__ __forceinline__ float lg2(float x) { return __builtin_amdgcn_logf(x); }

#define XB_TMO      128
#define XB_XCNT(j)  (256  + 64 * (j))
#define XB_XSUB(j)  (1280 + 64 * (j))
#define XB_XGEN(j)  (2304 + 64 * (j))
#define XB_TOP      3328
#define XB_TOPGEN   3392
#define XCD_BAR_WORDS 3456
#define XB_SPIN_CAP (1u << 20)
__device__ __forceinline__ unsigned xb_ld(unsigned* p)              { return __hip_atomic_load(p, __ATOMIC_RELAXED, __HIP_MEMORY_SCOPE_AGENT); }
__device__ __forceinline__ unsigned xb_add(unsigned* p, unsigned v) { return __hip_atomic_fetch_add(p, v, __ATOMIC_RELAXED, __HIP_MEMORY_SCOPE_AGENT); }
__device__ __forceinline__ unsigned xb_xcc_id() { return (unsigned)__builtin_amdgcn_s_getreg((3 << 11) | 20) & 0xFu; }
#define XB_SPIN(cond, bar) do { unsigned _sp = 0; while (cond) { __builtin_amdgcn_s_sleep(1); \
    if ((++_sp & 255u) == 0u) { if (xb_ld(&(bar)[XB_TMO])) break; if (_sp > XB_SPIN_CAP) { atomicAdd(&(bar)[XB_TMO], 1u); break; } } } } while (0)
struct XcdBarrier { unsigned* bar; unsigned x; volatile LAS unsigned* st; };
__device__ __forceinline__ XcdBarrier xcd_barrier_post(unsigned* bar, volatile LAS unsigned* st) {
    XcdBarrier b; b.bar = bar; b.x = xb_xcc_id(); b.st = st;
    if (threadIdx.x == 0) (void)xb_add(&bar[XB_XCNT(b.x)], 1u);
    return b;
}
__device__ __forceinline__ void xcd_barrier_complete(unsigned* bar, unsigned x, unsigned& nloc, unsigned& nx) {
    const unsigned G = gridDim.x * gridDim.y * gridDim.z;
    unsigned sum, cnt, mine, sp = 0u;
    for (;;) {
        sum = 0u; cnt = 0u; mine = 0u;
#pragma unroll
        for (unsigned j = 0; j < 16; ++j) { const unsigned c = xb_ld(&bar[XB_XCNT(j)]); sum += c; cnt += (c > 0u) ? 1u : 0u; mine = (j == x) ? c : mine; }
        if (sum == G) break;
        __builtin_amdgcn_s_sleep(1);
        if ((++sp & 255u) == 0u) { if (xb_ld(&bar[XB_TMO])) break; if (sp > XB_SPIN_CAP) { atomicAdd(&bar[XB_TMO], 1u); break; } }
    }
    nloc = mine > 0u ? mine : 1u; nx = cnt > 0u ? cnt : 1u;
}
__device__ __forceinline__ void xcd_barrier(const XcdBarrier& b) {
    asm volatile("s_waitcnt vmcnt(0)" ::: "memory");
    __syncthreads();
    if (threadIdx.x == 0) {
        unsigned* bar = b.bar;
        __builtin_amdgcn_s_waitcnt(0);
        unsigned nloc = b.st[0], nx = b.st[1];
        if (nloc == 0u) { xcd_barrier_complete(bar, b.x, nloc, nx); b.st[0] = nloc; b.st[1] = nx; }
        const unsigned old = xb_add(&bar[XB_XSUB(b.x)], 1u);
        const unsigned gen = old / nloc;
        if (old + 1u == (gen + 1u) * nloc) {
            __builtin_amdgcn_fence(__ATOMIC_RELEASE, "agent");
            asm volatile("s_waitcnt vmcnt(0)" ::: "memory");
            const unsigned og = xb_add(&bar[XB_TOP], 1u);
            const unsigned tg = og / nx;
            if (og + 1u == (tg + 1u) * nx) xb_add(&bar[XB_TOPGEN], 1u);
            else XB_SPIN(xb_ld(&bar[XB_TOPGEN]) == tg, bar);
            __builtin_amdgcn_fence(__ATOMIC_ACQUIRE, "agent");
            xb_add(&bar[XB_XGEN(b.x)], 1u);
            asm volatile("s_waitcnt vmcnt(0)" ::: "memory");
        } else {
            XB_SPIN(xb_ld(&bar[XB_XGEN(b.x)]) == gen, bar);
            __builtin_amdgcn_fence(__ATOMIC_ACQUIRE, "agent");
            asm volatile("s_waitcnt vmcnt(0)" ::: "memory");
        }
    }
    __syncthreads();
}

struct Args { const float* in[29]; float* out; unsigned char* ws; double invf[64]; int ph_lo, ph_hi, li, pad; };
struct Ctx {
    const float* const* in; float* out; unsigned char* ws; LAS unsigned char* lds;
    int tid, lane, wave, G, bid, gw, NGW;
};
__device__ __forceinline__ bf16* wsb(const Ctx& C, size_t off) { return (bf16*)(C.ws + off); }
__device__ __forceinline__ float* wsf(const Ctx& C, size_t off) { return (float*)(C.ws + off); }

__device__ __forceinline__ float wave_sum(float v) {
#pragma unroll
    for (int o = 1; o < 64; o <<= 1) v += __shfl_xor(v, o);
    return v;
}
__device__ __forceinline__ float wave_max(float v) {
#pragma unroll
    for (int o = 1; o < 64; o <<= 1) v = fmaxf(v, __shfl_xor(v, o));
    return v;
}

__device__ __forceinline__ void conv_item(const float* __restrict__ src, int ldsrc, int col4, int k0, bf16* dst, int ldd, int drow0, int lane) {
    const int ng = lane & 7, kg = lane >> 3;
    f32x4 v[8];
    if (col4 >= 0) {
#pragma unroll
        for (int i = 0; i < 8; ++i) v[i] = __builtin_nontemporal_load((const f32x4*)(src + (size_t)(k0 + 8 * kg + i) * ldsrc + col4)); }
    else {
#pragma unroll
        for (int i = 0; i < 8; ++i) v[i] = (f32x4){0.f, 0.f, 0.f, 0.f}; }
    bf16* dp = dst + (size_t)(drow0 + 4 * ng) * ldd + k0 + 8 * kg;
#pragma unroll
    for (int j = 0; j < 4; ++j) { v4u o; o.x = cvt_pk_bf16(v[0][j], v[1][j]); o.y = cvt_pk_bf16(v[2][j], v[3][j]); o.z = cvt_pk_bf16(v[4][j], v[5][j]); o.w = cvt_pk_bf16(v[6][j], v[7][j]);
        *(v4u*)(dp + (size_t)j * ldd) = o; }
}
__device__ __forceinline__ int win_srccol(int p) {
    if (p >= IN_COLS) return -1;
    const bool rope = (p >= 3072 && p < 4352) || (p >= 4608 && p < 4864) || (p >= 5120 && p < 5376);
    if (!rope) return p;
    const int hb = p & ~127, pp = p & 127, wc = pp >> 5, n = (pp >> 4) & 1, r = pp & 15;
    return hb + 64 * n + 16 * wc + r;
}
__device__ __forceinline__ int job_items(int job) { return (job == 0 || job == 2) ? 11008 : ((job == 1 || job == 3) ? 5504 : (job == 4 ? 5888 : (job <= 9 ? 2048 : (job <= 11 ? 512 : 16)))); }
__device__ __forceinline__ void conv_job(const Ctx& C, int job, int r) {
    const int lane = C.lane, ng4 = 4 * (lane & 7);
    if (job == 0 || job == 2) { const int f = job == 2; const int ndb = NGU / 32, db = r % ndb, kb = r / ndb, p0 = db * 32, tile = p0 >> 8, rr = p0 & 255;
        const float* src = C.in[rr < 128 ? (f ? 24 : 4) : (f ? 25 : 5)];
        conv_item(src, FF, tile * 128 + (rr & 127) + ng4, kb * 64, wsb(C, f ? WS_WGU2 : WS_WGU1), D, p0, lane); }
    else if (job == 1 || job == 3) { const int f = job == 3; const int db = r % 64, kb = r / 64;
        conv_item(C.in[f ? 26 : 6], D, db * 32 + ng4, kb * 64, wsb(C, f ? WS_WD2 : WS_WD1), FF, db * 32, lane); }
    else if (job == 4) { const int ndb = INP / 32, db = r % ndb, kb = r / ndb;
        conv_item(C.in[7], IN_COLS, win_srccol(db * 32 + ng4), kb * 64, wsb(C, WS_WIN), D, db * 32, lane); }
    else if (job <= 9) { const int w = job - 5, db = r % 64, kb = r / 64;
        const float* src = C.in[w == 0 ? 15 : 17 + w];
        const size_t dst = w == 0 ? WS_WOUT : (w == 1 ? WS_WQ : (w == 2 ? WS_WK : (w == 3 ? WS_WV : WS_WO)));
        conv_item(src, D, db * 32 + ng4, kb * 64, wsb(C, dst), D, db * 32, lane); }
    else if (job <= 11) { const int kv = job - 10, db = r % 8, kb = r / 8;
        conv_item(C.in[kv ? 12 : 9], 256, db * 32 + ng4, kb * 64, wsb(C, WS_W1T) + (size_t)kv * 256 * 4096, 4096, db * 32, lane); }
    else { const int kv = job - 12, db = r % 4, kb = r / 4;
        conv_item(C.in[kv ? 13 : 10], 128, db * 32 + ng4, kb * 64, wsb(C, WS_W2T) + (size_t)kv * 128 * 256, 256, db * 32, lane); }
}
template <unsigned MASK> __device__ __forceinline__ void conv_static(const Ctx& C, int w, int nw) {
    int base = 0;
#pragma unroll 1
    for (int job = 0; job < 14; ++job) { if (!((MASK >> job) & 1u)) continue; const int n = job_items(job);
        int first = (w - base % nw + nw) % nw;
#pragma unroll 1
        for (int r = first; r < n; r += nw) conv_job(C, job, r);
        base += n; }
}
template <unsigned MASK> __device__ __forceinline__ void conv_dynamic(const Ctx& C, unsigned* ctr) {
    int total = 0;
#pragma unroll
    for (int job = 0; job < 14; ++job) if ((MASK >> job) & 1u) total += job_items(job);
    for (;;) {
        unsigned idx = 0; if (C.lane == 0) idx = __hip_atomic_fetch_add(ctr, 1u, __ATOMIC_RELAXED, __HIP_MEMORY_SCOPE_AGENT);
        int r = __builtin_amdgcn_readfirstlane((int)idx); if (r >= total) break;
        int job = 0;
#pragma unroll 1
        for (; job < 14; ++job) { if (!((MASK >> job) & 1u)) continue; const int n = job_items(job); if (r < n) break; r -= n; }
        conv_job(C, job, r);
    }
}
constexpr unsigned JOBS_P0 = (1u << 0) | (1u << 7) | (1u << 8);
constexpr unsigned JOBS_P1 = (1u << 1) | (1u << 4) | (1u << 10) | (1u << 11) | (1u << 12) | (1u << 13);
constexpr unsigned JOBS_P7 = (1u << 2) | (1u << 3) | (1u << 5) | (1u << 6) | (1u << 9);
constexpr int CW_CONVCTR = 64;

__device__ __forceinline__ void sincos_d(double r, float& c, float& s) {
    const double x = 0.25 * r, x2 = x * x;
    double sn = x * (1.0 + x2 * (-1.0 / 6 + x2 * (1.0 / 120 + x2 * (-1.0 / 5040 + x2 * (1.0 / 362880 + x2 * (-1.0 / 39916800 + x2 * (1.0 / 6227020800.0)))))));
    double cs = 1.0 + x2 * (-0.5 + x2 * (1.0 / 24 + x2 * (-1.0 / 720 + x2 * (1.0 / 40320 + x2 * (-1.0 / 3628800 + x2 * (1.0 / 479001600.0))))));
    double s2 = 2.0 * sn * cs, c2 = 1.0 - 2.0 * sn * sn;
    double s4 = 2.0 * s2 * c2, c4 = 1.0 - 2.0 * s2 * s2;
    c = (float)c4; s = (float)s4;
}
__device__ __forceinline__ void p0_prologue(const Ctx& C, const double* invf, bool first) {
    const int lane = C.lane;
    conv_static<JOBS_P0>(C, C.gw, C.NGW);
    { const int gt = C.gw * 64 + lane, NT = C.NGW * 64;
      const float* x = C.in[0]; bf16* xb = wsb(C, WS_XB);
      for (int i = gt; i < T * D / 8; i += NT) { const f32x4 a = *(const f32x4*)(x + (size_t)i * 8), b = *(const f32x4*)(x + (size_t)i * 8 + 4);
          v4u o; o.x = cvt_pk_bf16(a[0], a[1]); o.y = cvt_pk_bf16(a[2], a[3]); o.z = cvt_pk_bf16(b[0], b[1]); o.w = cvt_pk_bf16(b[2], b[3]); *(v4u*)(xb + (size_t)i * 8) = o; }
      const float* mem = C.in[1]; bf16* mb = wsb(C, WS_MEMB);
      for (int i = gt; i < MEMT * D / 8; i += NT) { const f32x4 a = *(const f32x4*)(mem + (size_t)i * 8), b = *(const f32x4*)(mem + (size_t)i * 8 + 4);
          v4u o; o.x = cvt_pk_bf16(a[0], a[1]); o.y = cvt_pk_bf16(a[2], a[3]); o.z = cvt_pk_bf16(b[0], b[1]); o.w = cvt_pk_bf16(b[2], b[3]); *(v4u*)(mb + (size_t)i * 8) = o; }
      float* rope = wsf(C, WS_ROPE);
      for (int i = gt; i < T * 64; i += NT) { const int pos = i >> 6, fi = i & 63; const double ang = (double)pos * invf[fi];
          const double n = rint(ang * 0.15915494309189535); const double rr = fma(-n, 6.283185307179586, ang) - n * 2.4492935982947064e-16;
          float c, s; sincos_d(rr, c, s); rope[2 * (size_t)i] = c; rope[2 * (size_t)i + 1] = s; }
    }
    if (first) for (int task = C.gw; task < 2 * 4 * 32; task += C.NGW) { const int kv = task >> 7, nch = (task >> 5) & 3, kch = task & 31, n = nch * 64 + lane;
        const float* pos = C.in[kv ? 11 : 8]; const float* w1 = C.in[kv ? 12 : 9]; float acc = 0.f;
#pragma unroll 8
        for (int k = kch * 128; k < kch * 128 + 128; ++k) acc += pos[k] * w1[(size_t)k * 256 + n];
        atomicAdd((float*)(C.ws + CTL_BIAS1) + kv * 256 + n, acc); }
}

__device__ __forceinline__ void ln_rows(const Ctx& C, const float* Y, const float* g, const float* b, float* X, bf16* Xb) {
    for (int row = C.gw; row < T; row += C.NGW) {
        const f32x4* yr = (const f32x4*)(Y + (size_t)row * D) + C.lane;
        f32x4 v[8]; float s = 0.f;
#pragma unroll
        for (int j = 0; j < 8; ++j) { v[j] = yr[64 * j]; s += (v[j][0] + v[j][1]) + (v[j][2] + v[j][3]); }
        const float mean = wave_sum(s) * (1.f / D); float s2 = 0.f;
#pragma unroll
        for (int j = 0; j < 8; ++j) { v[j] = v[j] - mean; s2 += (v[j][0] * v[j][0] + v[j][1] * v[j][1]) + (v[j][2] * v[j][2] + v[j][3] * v[j][3]); }
        const float rstd = 1.f / sqrtf(wave_sum(s2) * (1.f / D) + LN_EPS);
#pragma unroll
        for (int j = 0; j < 8; ++j) { const f32x4 gg = *((const f32x4*)g + C.lane + 64 * j), bb = *((const f32x4*)b + C.lane + 64 * j);
            const f32x4 o = v[j] * rstd * gg + bb;
            *((f32x4*)(X + (size_t)row * D) + C.lane + 64 * j) = o;
            if (Xb) *((v2u*)(Xb + (size_t)row * D) + C.lane + 64 * j) = pg8::pack4(o); }
    }
}
__device__ __forceinline__ void rms_rows(const Ctx& C, const float* O, const float* g, bf16* Yb) {
    const int half = C.lane >> 5, l5 = C.lane & 31;
    for (int row = C.gw; row < T; row += C.NGW) {
        const f32x4* orow = (const f32x4*)(O + (size_t)row * D + half * 1024) + l5;
        f32x4 v[8]; float s2 = 0.f;
#pragma unroll
        for (int j = 0; j < 8; ++j) { v[j] = orow[32 * j]; s2 += (v[j][0] * v[j][0] + v[j][1] * v[j][1]) + (v[j][2] * v[j][2] + v[j][3] * v[j][3]); }
#pragma unroll
        for (int o = 1; o < 32; o <<= 1) s2 += __shfl_xor(s2, o);
        const float rstd = 1.f / sqrtf(s2 * (1.f / 1024.f) + RMS_EPS);
#pragma unroll
        for (int j = 0; j < 8; ++j) { const f32x4 gg = *((const f32x4*)(g + half * 1024) + l5 + 32 * j);
            *((v2u*)(Yb + (size_t)row * D + half * 1024) + l5 + 32 * j) = pg8::pack4(v[j] * rstd * gg); }
    }
}
__device__ __forceinline__ void softmax_rows(const Ctx& C, const float* S, bf16* P) {
    for (int row = C.gw; row < MEMH * T; row += C.NGW) {
        const f32x4 v = *((const f32x4*)(S + (size_t)row * MEMT) + C.lane);
        const float m = wave_max(fmaxf(fmaxf(v[0], v[1]), fmaxf(v[2], v[3])));
        f32x4 e; float s = 0.f;
#pragma unroll
        for (int j = 0; j < 4; ++j) { e[j] = ex2((v[j] - m) * LOG2E); s += e[j]; }
        const float inv = 1.f / wave_sum(s);
        *((v2u*)(P + (size_t)row * MEMT) + C.lane) = pg8::pack4(e * inv);
    }
}

__device__ __forceinline__ float gelu_tanh(float x) {
    const float u = 0.7978845608028654f * (x + 0.044715f * x * x * x);
    const float th = 1.f - 2.f * __builtin_amdgcn_rcpf(1.f + ex2(2.f * LOG2E * u));
    return 0.5f * x * (1.f + th);
}
__device__ __forceinline__ void compress_l2(const Ctx& C) {
    const int lane = C.lane, r32 = lane & 31, h = lane >> 5;
    const float* PC = wsf(C, WS_PC); const float* bias1 = (const float*)(C.ws + CTL_BIAS1);
    for (int task = C.gw; task < 2 * 2 * 16 * 4; task += C.NGW) {
        const int nt = task & 3, rt = (task >> 2) & 15, g = (task >> 6) & 1, kv = task >> 7;
        const bf16* w2 = wsb(C, WS_W2T) + (size_t)kv * 128 * 256 + (size_t)(nt * 32 + r32) * 256 + 8 * h;
        f32x16 acc = {};
#pragma unroll 2
        for (int s = 0; s < 16; ++s) {
            const int k0 = 16 * s + 8 * h; f32x4 a0 = *(const f32x4*)(bias1 + kv * 256 + k0), a1 = *(const f32x4*)(bias1 + kv * 256 + k0 + 4);
#pragma unroll
            for (int kc = 0; kc < 8; ++kc) { const float* p = PC + ((((size_t)kc * 2 + kv) * 2 + g) * 512 + rt * 32 + r32) * 256 + k0;
                a0 = a0 + *(const f32x4*)p; a1 = a1 + *(const f32x4*)(p + 4); }
            v4u aw; aw.x = cvt_pk_bf16(gelu_tanh(a0[0]), gelu_tanh(a0[1])); aw.y = cvt_pk_bf16(gelu_tanh(a0[2]), gelu_tanh(a0[3]));
            aw.z = cvt_pk_bf16(gelu_tanh(a1[0]), gelu_tanh(a1[1])); aw.w = cvt_pk_bf16(gelu_tanh(a1[2]), gelu_tanh(a1[3]));
            const bf16x8 bw = *(const bf16x8*)(w2 + 16 * s);
            acc = __builtin_amdgcn_mfma_f32_32x32x16_bf16(__builtin_bit_cast(bf16x8, aw), bw, acc, 0, 0, 0);
        }
        if (kv == 0) { bf16* o = wsb(C, WS_KCMP) + (size_t)g * 512 * 128;
#pragma unroll
            for (int r = 0; r < 16; ++r) { const int row = rt * 32 + crow(r, h); o[(size_t)row * 128 + nt * 32 + r32] = row < NCMP ? (bf16)(cvt_pk_bf16(acc[r], 0.f) & 0xffffu) : (bf16)0; } }
        else { bf16* o = wsb(C, WS_VCMPT) + ((size_t)g * 16 + rt) * 128 * 32 + (size_t)(nt * 32 + r32) * 32;
#pragma unroll
            for (int gq = 0; gq < 4; ++gq) { const int rl = 8 * gq + 4 * h; f32x4 v = {acc[4 * gq], acc[4 * gq + 1], acc[4 * gq + 2], acc[4 * gq + 3]};
#pragma unroll
                for (int i = 0; i < 4; ++i) if (rt * 32 + rl + i >= NCMP) v[i] = 0.f;
                *(v2u*)(o + rl) = pg8::pack4(v); } }
    }
}

__device__ __forceinline__ f32x16 qk_tile(const bf16* Krow  , const bf16x8 (&qf)[8]) {
    f32x16 st = {};
#pragma unroll
    for (int s = 0; s < 8; ++s) st = __builtin_amdgcn_mfma_f32_32x32x16_bf16(*(const bf16x8*)(Krow + 16 * s), qf[s], st, 0, 0, 0);
    return st;
}
__device__ __forceinline__ void pv_tile(f32x16 (&o)[4], const bf16* Vtile  , const float (&w)[16], int r32, int h) {
    v4u p0, p1;
    p0.x = cvt_pk_bf16(w[0], w[1]); p0.y = cvt_pk_bf16(w[2], w[3]); p0.z = cvt_pk_bf16(w[4], w[5]); p0.w = cvt_pk_bf16(w[6], w[7]);
    p1.x = cvt_pk_bf16(w[8], w[9]); p1.y = cvt_pk_bf16(w[10], w[11]); p1.z = cvt_pk_bf16(w[12], w[13]); p1.w = cvt_pk_bf16(w[14], w[15]);
    const bf16x8 b0 = __builtin_bit_cast(bf16x8, p0), b1 = __builtin_bit_cast(bf16x8, p1);
#pragma unroll
    for (int db = 0; db < 4; ++db) { const bf16* vr = Vtile + (size_t)(32 * db + r32) * 32 + 4 * h;
        const v2u a0 = *(const v2u*)(vr), a1 = *(const v2u*)(vr + 8), a2 = *(const v2u*)(vr + 16), a3 = *(const v2u*)(vr + 24);
        const v4u f0 = {a0.x, a0.y, a1.x, a1.y}, f1 = {a2.x, a2.y, a3.x, a3.y};
        o[db] = __builtin_amdgcn_mfma_f32_32x32x16_bf16(__builtin_bit_cast(bf16x8, f0), b0, o[db], 0, 0, 0);
        o[db] = __builtin_amdgcn_mfma_f32_32x32x16_bf16(__builtin_bit_cast(bf16x8, f1), b1, o[db], 0, 0, 0); }
}

__device__ __forceinline__ void sb_item(const Ctx& C, int hd, int qt, float* Oatt) {
    const int lane = C.lane, c = lane & 31, h = lane >> 5, t = 32 * qt + c;
    const bf16* Qp = wsb(C, WS_BIG + BG_SBQ) + ((size_t)hd * T + t) * 128 + 8 * h;
    bf16x8 qf[8];
#pragma unroll
    for (int s = 0; s < 8; ++s) qf[s] = *(const bf16x8*)(Qp + 16 * s);
    const bf16* Kh = wsb(C, WS_BIG + BG_SBK) + (size_t)hd * T * 128; const bf16* Vh = wsb(C, WS_BIG + BG_SBVT) + (size_t)hd * T * 128;
    f32x16 o[4] = {}; float carry = 0.f;
    for (int kt = qt; kt >= 0; --kt) {
        const f32x16 st = qk_tile(Kh + (size_t)(32 * kt + c) * 128 + 8 * h, qf);
        float l1m[16], lb[16], w[16];
#pragma unroll
        for (int r = 0; r < 16; ++r) { const int key = 32 * kt + crow(r, h); const float z = st[r];
            const float sp = fmaxf(z, 0.f) + lg2(1.f + ex2(-fabsf(z)));
            const bool valid = key < t; l1m[r] = valid ? -sp : 0.f; lb[r] = z - sp; }
        float G[4], PG[4], TT[4];
#pragma unroll
        for (int q = 0; q < 4; ++q) { G[q] = (l1m[4 * q] + l1m[4 * q + 1]) + (l1m[4 * q + 2] + l1m[4 * q + 3]); PG[q] = __shfl_xor(G[q], 32); TT[q] = G[q] + PG[q]; }
        const float SS[4] = {TT[3] + TT[2] + TT[1], TT[3] + TT[2], TT[3], 0.f};
#pragma unroll
        for (int q = 0; q < 4; ++q) { const float before = carry + SS[q] + (h == 0 ? PG[q] : 0.f);
            const float l3 = before, l2 = l3 + l1m[4 * q + 3], l1 = l2 + l1m[4 * q + 2], l0 = l1 + l1m[4 * q + 1];
            const float ls[4] = {l0, l1, l2, l3};
#pragma unroll
            for (int i = 0; i < 4; ++i) { const int r = 4 * q + i; const int key = 32 * kt + crow(r, h); w[r] = key < t ? ex2(lb[r] + ls[i]) : 0.f; } }
        carry += (TT[0] + TT[1]) + (TT[2] + TT[3]);
        pv_tile(o, Vh + (size_t)kt * 32 * 128, w, c, h);
        if (__all(carry < -150.f)) break;
    }
    float* op = Oatt + (size_t)t * D + hd * 128 + 4 * h;
#pragma unroll
    for (int db = 0; db < 4; ++db)
#pragma unroll
        for (int q = 0; q < 4; ++q) *(f32x4*)(op + 32 * db + 8 * q) = (f32x4){o[db][4 * q], o[db][4 * q + 1], o[db][4 * q + 2], o[db][4 * q + 3]};
}

template <class MaskF>
__device__ __forceinline__ void flash_tile(float& m, float& l, f32x16 (&o)[4], const bf16x8 (&qf)[8], const bf16* Krow, const bf16* Vtile, int c, int h, MaskF valid) {
    const f32x16 st = qk_tile(Krow, qf);
    float x[16]; float tm = -INFINITY;
#pragma unroll
    for (int r = 0; r < 16; ++r) { x[r] = valid(r) ? st[r] : -INFINITY; tm = fmaxf(tm, x[r]); }
    tm = fmaxf(tm, __shfl_xor(tm, 32));
    const float mn = fmaxf(m, tm), ms = mn == -INFINITY ? 0.f : mn;
    const float alpha = ex2(m - ms);
    float w[16]; float ps = 0.f;
#pragma unroll
    for (int r = 0; r < 16; ++r) { w[r] = ex2(x[r] - ms); ps += w[r]; }
    l = l * alpha + ps; m = mn;
#pragma unroll
    for (int db = 0; db < 4; ++db) o[db] = o[db] * alpha;
    pv_tile(o, Vtile, w, c, h);
}

constexpr int NSA_WLDS = 2 * 8 * 128 * 4 + 8 * 16;
__device__ __forceinline__ void nsa_item(const Ctx& C, int g, int qo, float* Oatt, LAS unsigned char* wl) {
    const int lane = C.lane, c = lane & 31, h = lane >> 5, qi = c >> 2, hh = c & 3, head = 4 * g + hh, t0 = 8 * qo, t = t0 + qi;
    LAS float* impA = (LAS float*)wl; LAS float* impB = impA + 8 * 128; LAS unsigned long long* selm = (LAS unsigned long long*)(wl + 2 * 8 * 128 * 4);
    const bf16* Qp = wsb(C, WS_BIG + BG_NQ) + ((size_t)head * T + t) * 128 + 8 * h;
    bf16x8 qf[8];
#pragma unroll
    for (int s = 0; s < 8; ++s) qf[s] = *(const bf16x8*)(Qp + 16 * s);
    const float* gp = wsf(C, WS_GATES) + (size_t)t * 24 + head * 3;
    const float g_c = gp[0], g_s = gp[1], g_w = gp[2];
    float* op = Oatt + (size_t)t * D + 1024 + head * 128 + 4 * h;
#pragma unroll
    for (int i = 0; i < 32; ++i) impA[i * 64 + lane] = 0.f;
    const int ncmp = (t0 + 7 >= 31) ? ((t0 + 7 - 31) >> 4) + 1 : 0, ntile = (ncmp + 31) >> 5;
    const int cmax = (t >= 31) ? ((t - 31) >> 4) : -1;
    const bf16* Kc = wsb(C, WS_KCMP) + (size_t)g * 512 * 128; const bf16* Vc = wsb(C, WS_VCMPT) + (size_t)g * 16 * 128 * 32;
    if (ntile > 0) {
        float m = -INFINITY, l = 0.f;
        for (int kt = 0; kt < ntile; ++kt) {
            const f32x16 st = qk_tile(Kc + (size_t)(32 * kt + c) * 128 + 8 * h, qf);
            float tm = -INFINITY; float x[16];
#pragma unroll
            for (int r = 0; r < 16; ++r) { x[r] = (32 * kt + crow(r, h) <= cmax) ? st[r] : -INFINITY; tm = fmaxf(tm, x[r]); }
            tm = fmaxf(tm, __shfl_xor(tm, 32));
            const float mn = fmaxf(m, tm), ms = mn == -INFINITY ? 0.f : mn; float ps = 0.f;
#pragma unroll
            for (int r = 0; r < 16; ++r) ps += ex2(x[r] - ms);
            l = l * ex2(m - ms) + ps; m = mn;
        }
        l += __shfl_xor(l, 32);
        const float ms = m == -INFINITY ? 0.f : m, inv = l > 0.f ? 1.f / l : 0.f;
        f32x16 o[4] = {};
        for (int kt = 0; kt < ntile; ++kt) {
            const f32x16 st = qk_tile(Kc + (size_t)(32 * kt + c) * 128 + 8 * h, qf);
            float w[16];
#pragma unroll
            for (int r = 0; r < 16; ++r) w[r] = (32 * kt + crow(r, h) <= cmax) ? ex2(st[r] - ms) * inv : 0.f;
#pragma unroll
            for (int q = 0; q < 4; ++q) { float a = (w[4 * q] + w[4 * q + 1]) + (w[4 * q + 2] + 0.5f * w[4 * q + 3]), b = 0.5f * w[4 * q + 3];
                a += __shfl_xor(a, 1); a += __shfl_xor(a, 2); b += __shfl_xor(b, 1); b += __shfl_xor(b, 2);
                const int n = 8 * kt + 2 * q + h;
                if (hh == 0) { impA[qi * 128 + n] = a; if (n + 1 < NSEL) impB[qi * 128 + n + 1] = b; } }
            pv_tile(o, Vc + (size_t)kt * 128 * 32, w, c, h);
        }
#pragma unroll
        for (int db = 0; db < 4; ++db)
#pragma unroll
            for (int q = 0; q < 4; ++q) *(f32x4*)(op + 32 * db + 8 * q) = (f32x4){o[db][4 * q], o[db][4 * q + 1], o[db][4 * q + 2], o[db][4 * q + 3]} * g_c;
    } else {
#pragma unroll
        for (int db = 0; db < 4; ++db)
#pragma unroll
            for (int q = 0; q < 4; ++q) *(f32x4*)(op + 32 * db + 8 * q) = (f32x4){0.f, 0.f, 0.f, 0.f};
    }
    const int nb = t0 >> 6;
    LDS_WAIT(); asm volatile("" ::: "memory");
    for (int q = 0; q < 8; ++q) {
        unsigned long long mlo = 0ull, mhi = 0ull;
        if (nb < 16) { mlo = (2ull << nb) - 1ull; }
        else {
            float v0 = impA[q * 128 + lane] + impB[q * 128 + lane], v1 = impA[q * 128 + 64 + lane] + impB[q * 128 + 64 + lane];
            const int i0 = lane, i1 = lane + 64;
            v0 = (i0 == 0 || i0 == nb) ? INFINITY : (i0 <= nb ? v0 : -INFINITY);
            v1 = (i1 == nb) ? INFINITY : (i1 <= nb ? v1 : -INFINITY);
            for (int rd = 0; rd < 16; ++rd) {
                const float mx = wave_max(fmaxf(v0, v1));
                const unsigned long long b0 = __ballot(v0 == mx), b1 = __ballot(v1 == mx);
                int sel;
                if (b0) { sel = __ffsll((long long)b0) - 1; mlo |= 1ull << sel; if (lane == sel) v0 = -INFINITY; }
                else { sel = __ffsll((long long)b1) - 1; mhi |= 1ull << sel; if (lane == sel) v1 = -INFINITY; }
            }
        }
        if (lane == 0) { selm[2 * q] = mlo; selm[2 * q + 1] = mhi; }
    }
    LDS_WAIT(); asm volatile("" ::: "memory");
    const unsigned long long own_lo = selm[2 * qi], own_hi = selm[2 * qi + 1];
    unsigned long long u_lo = 0ull, u_hi = 0ull;
#pragma unroll
    for (int q = 0; q < 8; ++q) { u_lo |= selm[2 * q]; u_hi |= selm[2 * q + 1]; }
    u_lo = ((unsigned long long)__builtin_amdgcn_readfirstlane((unsigned)(u_lo >> 32)) << 32) | (unsigned)__builtin_amdgcn_readfirstlane((unsigned)u_lo);
    u_hi = ((unsigned long long)__builtin_amdgcn_readfirstlane((unsigned)(u_hi >> 32)) << 32) | (unsigned)__builtin_amdgcn_readfirstlane((unsigned)u_hi);
    {
        const bf16* Ks = wsb(C, WS_BIG + BG_KSL) + (size_t)g * T * 128; const bf16* Vs = wsb(C, WS_BIG + BG_VSLT) + (size_t)g * T * 128;
        float m = -INFINITY, l = 0.f; f32x16 o[4] = {};
        for (int half = 0; half < 2; ++half) {
            unsigned long long u = half ? u_hi : u_lo; const unsigned long long own = half ? own_hi : own_lo;
            while (u) {
                const int bi = __ffsll((long long)u) - 1; u &= u - 1ull; const int n = 64 * half + bi;
                const bool sel = (own >> bi) & 1ull;
#pragma unroll 1
                for (int tt = 0; tt < 2; ++tt) { const int key0 = 64 * n + 32 * tt;
                    flash_tile(m, l, o, qf, Ks + (size_t)(key0 + c) * 128 + 8 * h, Vs + (size_t)key0 * 128, c, h, [&](int r) { return sel && (key0 + crow(r, h) <= t); }); }
            }
        }
        l += __shfl_xor(l, 32);
        const float sc = l > 0.f ? g_s / l : 0.f;
#pragma unroll
        for (int db = 0; db < 4; ++db)
#pragma unroll
            for (int q = 0; q < 4; ++q) { f32x4* p = (f32x4*)(op + 32 * db + 8 * q); *p = *p + (f32x4){o[db][4 * q], o[db][4 * q + 1], o[db][4 * q + 2], o[db][4 * q + 3]} * sc; }
    }
    {
        const bf16* Kw = wsb(C, WS_BIG + BG_KWN) + (size_t)g * T * 128; const bf16* Vw = wsb(C, WS_BIG + BG_VWNT) + (size_t)g * T * 128;
        float m = -INFINITY, l = 0.f; f32x16 o[4] = {};
        const int klo = (t0 - 511 > 0 ? t0 - 511 : 0) >> 5, khi = t0 >> 5;
        for (int kt = klo; kt <= khi; ++kt) { const int key0 = 32 * kt;
            flash_tile(m, l, o, qf, Kw + (size_t)(key0 + c) * 128 + 8 * h, Vw + (size_t)key0 * 128, c, h, [&](int r) { const int key = key0 + crow(r, h); return key <= t && key > t - 512; }); }
        l += __shfl_xor(l, 32);
        const float sc = l > 0.f ? g_w / l : 0.f;
#pragma unroll
        for (int db = 0; db < 4; ++db)
#pragma unroll
            for (int q = 0; q < 4; ++q) { f32x4* p = (f32x4*)(op + 32 * db + 8 * q); *p = *p + (f32x4){o[db][4 * q], o[db][4 * q + 1], o[db][4 * q + 2], o[db][4 * q + 3]} * sc; }
    }
}

constexpr int RING_BYTES = 131072, MISC_OFF = RING_BYTES + 320, LDS_BYTES = 147456;
constexpr int N_PHASES = 20;
#ifndef MK_ONE_LAUNCH
#define MK_ONE_LAUNCH 1
#endif

__global__ void __launch_bounds__(NTHREADS, 2) fwd_kernel(Args args) {
    extern __shared__ __attribute__((aligned(16))) unsigned char lds_raw[];
    Ctx C;
    C.in = args.in; C.out = args.out; C.ws = args.ws; C.lds = (LAS unsigned char*)lds_raw;
    C.tid = threadIdx.x; C.lane = C.tid & 63; C.wave = __builtin_amdgcn_readfirstlane(C.tid >> 6);
    C.G = gridDim.x; C.bid = blockIdx.x; C.gw = C.bid * NWAVES + C.wave; C.NGW = C.G * NWAVES;
    volatile LAS unsigned* MISC = (volatile LAS unsigned*)(C.lds + MISC_OFF);
    for (int u = C.tid; u < (LDS_BYTES - RING_BYTES) / 4; u += NTHREADS) ((LAS unsigned*)(C.lds + RING_BYTES))[u] = 0u;
    __syncthreads();
    unsigned* barw = (unsigned*)(C.ws + WS_CTL) + CW_BAR + args.li * XCD_BAR_WORDS;
    XcdBarrier bar; bar.bar = barw; bar.x = 0; bar.st = nullptr;
    const int lo = args.ph_lo, hi = args.ph_hi;
    if (hi - lo > 1) bar = xcd_barrier_post(barw, MISC + 8);
#ifndef MK_MASK
#define MK_MASK 0xFFFFFu
#endif
#define IN(k) (((MK_MASK >> (k)) & 1u) && lo <= (k) && (k) < hi)
#define SEAM(k) do { if (IN(k) && IN((k) + 1)) xcd_barrier(bar); } while (0)
    LAS unsigned char* ring = C.lds;
    float* Yout = C.out;
    float* X = wsf(C, WS_X); bf16* XB = wsb(C, WS_XB); bf16* Hb = wsb(C, WS_BIG);

    if (IN(0)) { p0_prologue(C, args.invf, args.li == 0); } SEAM(0);
    if (IN(1)) {
        { pg8::Gemm gm{XB, wsb(C, WS_WGU1), D, D, D}; pg8::StaticOrder S; S.init(T, NGU, C.G, C.bid); pg8::EpiSwiGLU E{Hb, FF};
          pg8::gemm_phase<pg8::EpiSwiGLU, pg8::StaticOrder, true, true>(ring, gm, S, E); }
        { pg8::Gemm gm{wsb(C, WS_MEMB), wsb(C, WS_WK), D, D, D}; pg8::ListOrder S; S.init(1, 1, 8, C.G, C.bid, 96, 0, 0); pg8::EpiBf16S E{wsb(C, WS_KMEM), D, 1.f, 0};
          pg8::gemm_phase<pg8::EpiBf16S, pg8::ListOrder, true, true>(ring, gm, S, E); }
        { pg8::Gemm gm{wsb(C, WS_WV), wsb(C, WS_MEMB), D, D, D}; pg8::ListOrder S; S.init(1, 8, 1, C.G, C.bid, 104, 0, 0); pg8::EpiBf16S E{wsb(C, WS_VT), MEMT, 1.f, 0};
          pg8::gemm_phase<pg8::EpiBf16S, pg8::ListOrder, true, true>(ring, gm, S, E); }
        if (C.G == 256 && C.bid >= 112) conv_static<JOBS_P1>(C, (C.bid - 112) * NWAVES + C.wave, 144 * NWAVES);
        else if (C.G != 256) conv_static<JOBS_P1>(C, C.gw, C.NGW);
    } SEAM(1);
    if (IN(2)) { pg8::Gemm gm{Hb, wsb(C, WS_WD1), FF, FF, FF}; pg8::StaticOrder S; S.init(T, D, C.G, C.bid); pg8::EpiF32 E{Yout, D, C.in[0], ALPHA, 0.5f, 0};
        pg8::gemm_phase<pg8::EpiF32, pg8::StaticOrder, true, true>(ring, gm, S, E); } SEAM(2);
    if (IN(3)) { ln_rows(C, Yout, C.in[2], C.in[3], X, XB); } SEAM(3);
    if (IN(4)) { pg8::Gemm gm{XB, wsb(C, WS_WIN), D, D, D}; pg8::StaticOrder S; S.init(T, INP, C.G, C.bid);
        pg8::EpiWin E{wsb(C, WS_BIG + BG_SBQ), wsb(C, WS_BIG + BG_SBK), wsb(C, WS_BIG + BG_SBVT), wsb(C, WS_BIG + BG_NQ), wsb(C, WS_BIG + BG_CMPIN), wsb(C, WS_BIG + BG_KSL), wsb(C, WS_BIG + BG_VSLT),
                      wsb(C, WS_BIG + BG_KWN), wsb(C, WS_BIG + BG_VWNT), wsf(C, WS_GATES), wsf(C, WS_ROPE), T, QSCALE};
        pg8::gemm_phase<pg8::EpiWin, pg8::StaticOrder, true, true>(ring, gm, S, E); } SEAM(4);
    if (IN(5)) { pg8::Gemm gm{wsb(C, WS_BIG + BG_CMPIN), wsb(C, WS_W1T), 16 * 128, 4096, 512}; pg8::CmpOrder S{C.G, C.bid, (size_t)T * 128 * 2, (size_t)256 * 4096 * 2};
        pg8::EpiF32 E{wsf(C, WS_PC), 256, nullptr, 0.f, 1.f, (size_t)512 * 256};
        pg8::gemm_phase<pg8::EpiF32, pg8::CmpOrder, true, true>(ring, gm, S, E); } SEAM(5);
    if (IN(6)) { compress_l2(C); } SEAM(6);
    if (IN(7)) {
        if (C.G == 256) {
            { const int item = C.wave * 256 + C.bid; sb_item(C, item & 7, item >> 3, Yout); }
            { const int item = C.wave * 256 + C.bid; nsa_item(C, item & 1, item >> 1, Yout, C.lds + C.wave * 8448); }
        }
        conv_dynamic<JOBS_P7>(C, (unsigned*)(C.ws + WS_CTL) + CW_CONVCTR + 64 * args.li);
    } SEAM(7);
    if (IN(8)) { rms_rows(C, Yout, C.in[14], XB); } SEAM(8);
    if (IN(9)) { pg8::Gemm gm{XB, wsb(C, WS_WOUT), D, D, D}; pg8::StaticOrder S; S.init(T, D, C.G, C.bid); pg8::EpiF32 E{Yout, D, X, ALPHA, 1.f, 0};
        pg8::gemm_phase<pg8::EpiF32, pg8::StaticOrder, true, true>(ring, gm, S, E); } SEAM(9);
    if (IN(10)) { ln_rows(C, Yout, C.in[16], C.in[17], X, XB); } SEAM(10);
    if (IN(11)) { pg8::Gemm gm{XB, wsb(C, WS_WQ), D, D, D}; pg8::StaticOrder S; S.init(T, D, C.G, C.bid); pg8::EpiBf16S E{wsb(C, WS_BIG + BG_QC), D, MEMQSCALE, 0};
        pg8::gemm_phase<pg8::EpiBf16S, pg8::StaticOrder, true, true>(ring, gm, S, E); } SEAM(11);
    if (IN(12)) { pg8::Gemm gm{wsb(C, WS_BIG + BG_QC), wsb(C, WS_KMEM), D, D, MEMD}; pg8::ListOrder S; S.init(MEMH, T / 256, 1, C.G, C.bid, 0, (size_t)MEMD * 2, (size_t)MEMD * 2);
        pg8::EpiF32 E{wsf(C, WS_BIG + BG_S), MEMT, nullptr, 0.f, 1.f, (size_t)T * MEMT};
        pg8::gemm_phase<pg8::EpiF32, pg8::ListOrder, true, true>(ring, gm, S, E); } SEAM(12);
    if (IN(13)) { softmax_rows(C, wsf(C, WS_BIG + BG_S), wsb(C, WS_BIG + BG_P)); } SEAM(13);
    if (IN(14)) { pg8::Gemm gm{wsb(C, WS_BIG + BG_P), wsb(C, WS_VT), MEMT, MEMT, MEMT}; pg8::ListOrder S; S.init(MEMH, T / 256, 2, C.G, C.bid, 0, (size_t)T * MEMT * 2, (size_t)MEMD * MEMT * 2);
        pg8::EpiBf16S E{wsb(C, WS_BIG + BG_QC), D, 1.f, MEMD};
        pg8::gemm_phase<pg8::EpiBf16S, pg8::ListOrder, true, true>(ring, gm, S, E); } SEAM(14);
    if (IN(15)) { pg8::Gemm gm{wsb(C, WS_BIG + BG_QC), wsb(C, WS_WO), D, D, D}; pg8::StaticOrder S; S.init(T, D, C.G, C.bid); pg8::EpiF32 E{Yout, D, X, ALPHA, 1.f, 0};
        pg8::gemm_phase<pg8::EpiF32, pg8::StaticOrder, true, true>(ring, gm, S, E); } SEAM(15);
    if (IN(16)) { ln_rows(C, Yout, C.in[22], C.in[23], X, XB); } SEAM(16);
    if (IN(17)) { pg8::Gemm gm{XB, wsb(C, WS_WGU2), D, D, D}; pg8::StaticOrder S; S.init(T, NGU, C.G, C.bid); pg8::EpiSwiGLU E{Hb, FF};
        pg8::gemm_phase<pg8::EpiSwiGLU, pg8::StaticOrder, true, true>(ring, gm, S, E); } SEAM(17);
    if (IN(18)) { pg8::Gemm gm{Hb, wsb(C, WS_WD2), FF, FF, FF}; pg8::StaticOrder S; S.init(T, D, C.G, C.bid); pg8::EpiF32 E{Yout, D, X, ALPHA, 0.5f, 0};
        pg8::gemm_phase<pg8::EpiF32, pg8::StaticOrder, true, true>(ring, gm, S, E); } SEAM(18);
    if (IN(19)) { ln_rows(C, Yout, C.in[27], C.in[28], Yout, nullptr); }
#undef IN
#undef SEAM
}

extern "C" void kernel_launch(void* const* d_in, const int* in_sizes, int n_in, void* d_out, int out_size, void* d_ws, size_t ws_size, hipStream_t stream) {
    static int grid = 0;
    if (grid == 0) {
        if (n_in != 29 || in_sizes[0] != T * D || out_size != T * D || ws_size < WS_END) { fprintf(stderr, "kernel_launch: unexpected shapes (n_in %d, in0 %d, out %d, ws %zu < %zu); nothing launched\n", n_in, n_in > 0 ? in_sizes[0] : -1, out_size, ws_size, (size_t)WS_END); grid = -1; return; }
        int dev = 0, cus = 0, per_cu = 0;
        if (hipGetDevice(&dev) != hipSuccess || hipDeviceGetAttribute(&cus, hipDeviceAttributeMultiprocessorCount, dev) != hipSuccess) { grid = -1; return; }
        if (hipFuncSetAttribute((const void*)fwd_kernel, hipFuncAttributeMaxDynamicSharedMemorySize, LDS_BYTES) != hipSuccess) { fprintf(stderr, "kernel_launch: hipFuncSetAttribute failed\n"); grid = -1; return; }
        if (hipOccupancyMaxActiveBlocksPerMultiprocessor(&per_cu, (const void*)fwd_kernel, NTHREADS, LDS_BYTES) != hipSuccess || per_cu < 1) { fprintf(stderr, "kernel_launch: occupancy query says %d blocks per CU\n", per_cu); per_cu = 1; }
        (void)hipGetLastError();
        grid = cus;
        if (grid != 256) fprintf(stderr, "kernel_launch: %d CUs; the attention phase is laid out for 256\n", grid);
    }
    if (grid < 0) return;
    (void)hipMemsetAsync((char*)d_ws + WS_CTL, 0, CTL_ZERO_BYTES, stream);
    Args a{};
    for (int i = 0; i < 29; ++i) a.in[i] = (const float*)d_in[i];
    a.out = (float*)d_out; a.ws = (unsigned char*)d_ws;
    for (int i = 0; i < 64; ++i) a.invf[i] = std::pow(10000.0, -(double)i / 64.0);
#if defined(MK_PROBE_PHASE)
    a.ph_lo = 0; a.ph_hi = MK_PROBE_PHASE + 1; a.li = 0; hipLaunchKernelGGL(fwd_kernel, dim3(grid), dim3(NTHREADS), LDS_BYTES, stream, a);
    a.ph_lo = MK_PROBE_PHASE; a.ph_hi = MK_PROBE_PHASE + 1; a.li = 1; hipLaunchKernelGGL(fwd_kernel, dim3(grid), dim3(NTHREADS), LDS_BYTES, stream, a);
    a.ph_lo = MK_PROBE_PHASE + 1; a.ph_hi = N_PHASES; a.li = 2; hipLaunchKernelGGL(fwd_kernel, dim3(grid), dim3(NTHREADS), LDS_BYTES, stream, a);
#elif MK_ONE_LAUNCH
    a.ph_lo = 0; a.ph_hi = N_PHASES; a.li = 0;
    hipLaunchKernelGGL(fwd_kernel, dim3(grid), dim3(NTHREADS), LDS_BYTES, stream, a);
#else
    for (int p = 0; p < N_PHASES; ++p) { a.ph_lo = p; a.ph_hi = p + 1; a.li = 0; hipLaunchKernelGGL(fwd_kernel, dim3(grid), dim3(NTHREADS), LDS_BYTES, stream, a); }
#endif
}
```

```cpp
#include <hip/hip_runtime.h>
#include <cstdio>
#include <cstdint>
#include <cmath>

namespace pg8 {
#define PG8_LAS __attribute__((address_space(3)))
typedef unsigned short bf16_t;
typedef short bf16x8 __attribute__((ext_vector_type(8)));
typedef float f32x4 __attribute__((ext_vector_type(4)));
typedef unsigned u32x4 __attribute__((ext_vector_type(4)));
typedef unsigned u32x2 __attribute__((ext_vector_type(2)));
constexpr int BM = 256, BK = 64, HALF = 128, HTB = HALF * BK * 2  , STAGE_BYTES = 8 * HTB, NXCD = 8, WGM = 8;

__host__ __device__ __forceinline__ int lds_byte(int r, int c) { const int st = (r >> 4) * 2 + (c >> 5), rr = r & 15, cc = c & 31, ob = rr * 64 + cc * 2; return st * 1024 + (ob ^ (((ob >> 9) & 1) << 5)); }
__host__ __device__ __forceinline__ void stage_rc(int b, int& R, int& C) { const int st = b / 1024, sb = b % 1024, swz = sb ^ (((sb >> 9) & 1) << 5); R = (st >> 1) * 16 + swz / 64; C = (st & 1) * 32 + (swz % 64) / 2; }
__host__ __device__ __forceinline__ int perm32(int rho) { const int n = rho >> 4, i = rho & 15; return 8 * (i >> 2) + 4 * n + (i & 3); }

struct Unit { int pm, pn, z; size_t offA, offB; };
struct Gemm { const bf16_t* A; const bf16_t* Bt; int lda, ldb, K; };

struct StaticOrder {
    int nM, nN, nwg, G, c;
    __host__ __device__ void init(int M, int N, int G_, int c_) { nM = M / BM; nN = N / BM; nwg = nM * nN; G = G_; c = c_; }
    __host__ __device__ bool next(int i, Unit& u) const {
        const long L = (long)i * G + c; if (L >= nwg) return false;
        int wgid = (int)L; { const int q = nwg / NXCD, r = nwg % NXCD, xcd = wgid % NXCD, off = wgid / NXCD; wgid = (xcd < r ? xcd * (q + 1) : r * (q + 1) + (xcd - r) * q) + off; }
        const int nig = WGM * nN, gid = wgid / nig, fm = gid * WGM, gsz = (nM - fm) < WGM ? (nM - fm) : WGM;
        u.pm = fm + ((wgid % nig) % gsz); u.pn = (wgid % nig) / gsz; u.z = 0; u.offA = 0; u.offB = 0; return true;
    }
    __device__ __forceinline__ void a_ready(const Unit&) const {}
    __device__ __forceinline__ void done(const Unit&) const {}
};
struct ListOrder {
    int nM, nN, nwg, G, c; size_t zA, zB;
    __host__ __device__ void init(int nZ, int nM_, int nN_, int G_, int c_, int c0, size_t zA_, size_t zB_) { nM = nM_; nN = nN_; nwg = nZ * nM_ * nN_; G = G_; c = (c_ - c0 + G_) % G_; zA = zA_; zB = zB_; }
    __host__ __device__ bool next(int i, Unit& u) const {
        const long L = (long)i * G + c; if (L >= nwg) return false;
        const int l = (int)L; u.pn = l % nN; u.pm = (l / nN) % nM; u.z = l / (nN * nM); u.offA = (size_t)u.z * zA; u.offB = (size_t)u.z * zB; return true;
    }
    __device__ __forceinline__ void a_ready(const Unit&) const {}
    __device__ __forceinline__ void done(const Unit&) const {}
};

typedef float f32x2_t __attribute__((ext_vector_type(2))); typedef __bf16 bf16x2_t __attribute__((ext_vector_type(2)));
struct CmpOrder {
    int G, c; size_t grpA, kvB;
    __host__ __device__ bool next(int i, Unit& u) const {
        const long L = (long)i * G + c; if (L >= 64) return false;
        const int l = (int)L, kc = l & 7, pm = (l >> 3) & 1, g = (l >> 4) & 1, kv = l >> 5;
        u.pm = pm; u.pn = 0; u.z = (kc * 2 + kv) * 2 + g; u.offA = (size_t)(kv * 2 + g) * grpA + (size_t)kc * 1024; u.offB = (size_t)kv * kvB + (size_t)kc * 1024; return true;
    }
    __device__ __forceinline__ void a_ready(const Unit&) const {}
    __device__ __forceinline__ void done(const Unit&) const {}
};
__device__ __forceinline__ unsigned cvt_pk_bf16(float lo, float hi) { f32x2_t v = {lo, hi}; bf16x2_t b = __builtin_convertvector(v, bf16x2_t); return __builtin_bit_cast(unsigned, b); }
__device__ __forceinline__ u32x2 pack4(f32x4 v) { u32x2 w; w.x = cvt_pk_bf16(v[0], v[1]); w.y = cvt_pk_bf16(v[2], v[3]); return w; }

struct EpiSwiGLU {
    static constexpr bool PERM = false, AFTER_DRAIN = false;
    bf16_t* H; int ldh;
    __device__ __forceinline__ void operator()(const f32x4 (&acc)[2][2][4][2], const Unit& u, int wr, int wc, int fr, int fq) const {
        const int row0 = u.pm * BM + wr * 64 + fr, col0 = u.pn * HALF + wc * 32 + 4 * fq;
#pragma unroll
        for (int ai = 0; ai < 2; ++ai)
#pragma unroll
            for (int m = 0; m < 4; ++m) { bf16_t* rowp = H + (size_t)(row0 + ai * HALF + m * 16) * ldh + col0;
#pragma unroll
                for (int n = 0; n < 2; ++n) { const f32x4 g = acc[ai][0][m][n], up = acc[ai][1][m][n]; f32x4 h;
#pragma unroll
                    for (int j = 0; j < 4; ++j) { const float e = __builtin_amdgcn_exp2f(-1.4426950408889634f * g[j]); h[j] = g[j] * __builtin_amdgcn_rcpf(1.0f + e) * up[j]; }
                    *(u32x2*)(rowp + 16 * n) = pack4(h); } }
    }
};
struct EpiF32 {
    static constexpr bool PERM = false, AFTER_DRAIN = false;
    float* O; int ldc; const float* R; float alpha, beta; size_t zO;
    __device__ __forceinline__ void operator()(const f32x4 (&acc)[2][2][4][2], const Unit& u, int wr, int wc, int fr, int fq) const {
        const int row0 = u.pm * BM + wr * 64 + fr, col0 = u.pn * BM + wc * 32 + 4 * fq;
        float* base = O + (size_t)u.z * zO;
#pragma unroll
        for (int ai = 0; ai < 2; ++ai)
#pragma unroll
            for (int m = 0; m < 4; ++m) { const size_t off = (size_t)(row0 + ai * HALF + m * 16) * ldc + col0;
#pragma unroll
                for (int bj = 0; bj < 2; ++bj)
#pragma unroll
                    for (int n = 0; n < 2; ++n) { f32x4 v = acc[ai][bj][m][n] * beta; if (R) { const f32x4 r = *(const f32x4*)(R + off + bj * HALF + n * 16); v = v + r * alpha; }
                        *(f32x4*)(base + off + bj * HALF + n * 16) = v; } }
    }
};
struct EpiBf16S {
    static constexpr bool PERM = false, AFTER_DRAIN = false;
    bf16_t* O; int ldc; float scale; int zcol;
    __device__ __forceinline__ void operator()(const f32x4 (&acc)[2][2][4][2], const Unit& u, int wr, int wc, int fr, int fq) const {
        const int row0 = u.pm * BM + wr * 64 + fr, col0 = u.z * zcol + u.pn * BM + wc * 32 + 4 * fq;
#pragma unroll
        for (int ai = 0; ai < 2; ++ai)
#pragma unroll
            for (int m = 0; m < 4; ++m) { bf16_t* rowp = O + (size_t)(row0 + ai * HALF + m * 16) * ldc + col0;
#pragma unroll
                for (int bj = 0; bj < 2; ++bj)
#pragma unroll
                    for (int n = 0; n < 2; ++n) *(u32x2*)(rowp + bj * HALF + n * 16) = pack4(acc[ai][bj][m][n] * scale); }
    }
};
struct EpiWin {
    static constexpr bool PERM = false, AFTER_DRAIN = false;
    bf16_t *SBQ, *SBK, *SBVT, *NQ, *CMPIN, *KSL, *VSLT, *KWN, *VWNT; float* GATES; const float* ROPE; int T; float qscale;
    template <bool SWZ> __device__ __forceinline__ void st_plain(bf16_t* dst, int head0, const f32x4 (&acc)[2][2][4][2], const Unit& u, int wr, int wc, int fr, int fq, float sc) const {
        const int row0 = u.pm * BM + wr * 64 + fr, c0 = wc * 32 + 4 * fq;
#pragma unroll
        for (int bj = 0; bj < 2; ++bj)
#pragma unroll
            for (int ai = 0; ai < 2; ++ai)
#pragma unroll
                for (int m = 0; m < 4; ++m) { const int tok = row0 + ai * HALF + m * 16; bf16_t* rowp = dst + ((size_t)(head0 + bj) * T + tok) * 128;
#pragma unroll
                    for (int n = 0; n < 2; ++n) { const int c = c0 + 16 * n; const int off = SWZ ? ((((c >> 3) ^ (tok & 15)) << 3) + (c & 7)) : c;
                        *(u32x2*)(rowp + off) = pack4(acc[ai][bj][m][n] * sc); } }
    }
    template <bool SWZ> __device__ __forceinline__ void st_rope(bf16_t* dst, int head0, const f32x4 (&acc)[2][2][4][2], const Unit& u, int wr, int wc, int fr, int fq, float sc) const {
        const int row0 = u.pm * BM + wr * 64 + fr, i0 = wc * 16 + 4 * fq;
#pragma unroll
        for (int ai = 0; ai < 2; ++ai)
#pragma unroll
            for (int m = 0; m < 4; ++m) { const int tok = row0 + ai * HALF + m * 16;
                const f32x4 cs0 = *(const f32x4*)(ROPE + ((size_t)tok * 64 + i0) * 2), cs1 = *(const f32x4*)(ROPE + ((size_t)tok * 64 + i0) * 2 + 4);
                const f32x4 co = {cs0[0], cs0[2], cs1[0], cs1[2]}, si = {cs0[1], cs0[3], cs1[1], cs1[3]};
                const int olo_off = SWZ ? ((((i0 >> 3) ^ (tok & 15)) << 3) + (i0 & 7)) : i0, ohi_off = SWZ ? (((((i0 >> 3) + 8) ^ (tok & 15)) << 3) + (i0 & 7)) : i0 + 64;
#pragma unroll
                for (int bj = 0; bj < 2; ++bj) { const f32x4 lo = acc[ai][bj][m][0], hi = acc[ai][bj][m][1];
                    const f32x4 olo = (lo * co - hi * si) * sc, ohi = (lo * si + hi * co) * sc;
                    bf16_t* rowp = dst + ((size_t)(head0 + bj) * T + tok) * 128;
                    *(u32x2*)(rowp + olo_off) = pack4(olo); *(u32x2*)(rowp + ohi_off) = pack4(ohi); } }
    }
    __device__ __forceinline__ void st_vt(bf16_t* dst, int head0, const f32x4 (&acc)[2][2][4][2], const Unit& u, int wr, int wc, int fr, int fq) const {
        const int row0 = u.pm * BM + wr * 64 + fr, c0 = wc * 32 + 4 * fq;
#pragma unroll
        for (int bj = 0; bj < 2; ++bj)
#pragma unroll
            for (int ai = 0; ai < 2; ++ai)
#pragma unroll
                for (int m = 0; m < 4; ++m) { const int tok = row0 + ai * HALF + m * 16, kk = tok & 31; bf16_t* tb = dst + ((size_t)(head0 + bj) * T + (tok & ~31)) * 128 + (kk & 3);
#pragma unroll
                    for (int n = 0; n < 2; ++n) { const u32x2 w = pack4(acc[ai][bj][m][n]); const int d = c0 + 16 * n;
                        bf16_t* p = tb + d * 32 + (((kk >> 2) ^ ((d >> 2) & 7)) << 2);
                        p[0] = (bf16_t)(w.x & 0xffffu); p[32] = (bf16_t)(w.x >> 16); p[64] = (bf16_t)(w.y & 0xffffu); p[96] = (bf16_t)(w.y >> 16); } }
    }
    __device__ __forceinline__ void operator()(const f32x4 (&acc)[2][2][4][2], const Unit& u, int wr, int wc, int fr, int fq) const {
        asm volatile("" : "+v"(fr), "+v"(fq));
        const int pn = u.pn;
        if (pn < 4) st_plain<false>(SBQ, 2 * pn, acc, u, wr, wc, fr, fq, qscale);
        else if (pn < 8) st_plain<true>(SBK, 2 * (pn - 4), acc, u, wr, wc, fr, fq, 1.f);
        else if (pn < 12) st_vt(SBVT, 2 * (pn - 8), acc, u, wr, wc, fr, fq);
        else if (pn < 16) st_rope<false>(NQ, 2 * (pn - 12), acc, u, wr, wc, fr, fq, qscale);
        else if (pn == 16) st_rope<false>(CMPIN, 0, acc, u, wr, wc, fr, fq, 1.f);
        else if (pn == 17) st_plain<false>(CMPIN, 2, acc, u, wr, wc, fr, fq, 1.f);
        else if (pn == 18) st_rope<true>(KSL, 0, acc, u, wr, wc, fr, fq, 1.f);
        else if (pn == 19) st_vt(VSLT, 0, acc, u, wr, wc, fr, fq);
        else if (pn == 20) st_rope<true>(KWN, 0, acc, u, wr, wc, fr, fq, 1.f);
        else if (pn == 21) st_vt(VWNT, 0, acc, u, wr, wc, fr, fq);
        else {
            if (wc == 0) { const int row0 = u.pm * BM + wr * 64 + fr;
#pragma unroll
                for (int ai = 0; ai < 2; ++ai)
#pragma unroll
                    for (int m = 0; m < 4; ++m) { float* gp = GATES + (size_t)(row0 + ai * HALF + m * 16) * 24;
#pragma unroll
                        for (int n = 0; n < 2; ++n) { const int c = 16 * n + 4 * fq; if (c < 24) { const f32x4 v = acc[ai][0][m][n]; f32x4 s;
#pragma unroll
                                for (int j = 0; j < 4; ++j) s[j] = __builtin_amdgcn_rcpf(1.0f + __builtin_amdgcn_exp2f(-1.4426950408889634f * v[j]));
                                *(f32x4*)(gp + c) = s; } } } }
        }
    }
};

template <class Epi, class Sched, bool ALIGN_EPI = false, bool SP2 = false>
__device__ __forceinline__ void gemm_phase(PG8_LAS unsigned char* lds, const Gemm g, const Sched& S, const Epi& E) {
    const int tid = threadIdx.x, wid = __builtin_amdgcn_readfirstlane(tid >> 6), lane = tid & 63, wr = wid >> 2, wc = wid & 3, fr = lane & 15, fq = lane >> 4;
    const int K = g.K, nt = K / BK, lda = g.lda, ldb = g.ldb;
    unsigned voffA[2], voffB[2];
#pragma unroll
    for (int i = 0; i < 2; ++i) { int R, C; stage_rc(tid * 16 + i * 8192, R, C); const int Rb = Epi::PERM ? ((R & ~31) + perm32(R & 31)) : R;
        voffA[i] = (unsigned)(R * lda + C) * 2u; voffB[i] = (unsigned)(Rb * ldb + C) * 2u; }
    const size_t kstep = (size_t)(BK * 2);
    const size_t hstepA = (size_t)HALF * lda * 2, hstepB = (size_t)HALF * ldb * 2;
    const size_t tstepA = 2 * hstepA, tstepB = 2 * hstepB;
    const unsigned ldsw = (unsigned)wid * 1024u;
    const int aoff = lds_byte(wr * 64 + fr, fq * 8), boff = lds_byte(wc * 32 + fr, fq * 8);
#define PG8_SA(b, h) (((b) * 2 + (h)) * HTB)
#define PG8_SB(b, h) ((4 + (b) * 2 + (h)) * HTB)
#define PG8_STAGE(bufoff, gbase, voff) do { _Pragma("unroll") for (int _i = 0; _i < 2; ++_i) \
        __builtin_amdgcn_global_load_lds((const unsigned*)((const char*)(gbase) + (voff)[_i]), (PG8_LAS unsigned*)(lds + (bufoff) + ldsw + _i * 8192), 16, 0, 0); } while (0)
#define PG8_LDA(dst, b, h) do { _Pragma("unroll") for (int m = 0; m < 4; ++m) _Pragma("unroll") for (int k = 0; k < 2; ++k) dst[m][k] = *(const PG8_LAS bf16x8*)(lds + PG8_SA(b, h) + aoff + m * 2048 + k * 1024); } while (0)
#define PG8_LDB(dst, b, h) do { _Pragma("unroll") for (int n = 0; n < 2; ++n) _Pragma("unroll") for (int k = 0; k < 2; ++k) dst[n][k] = *(const PG8_LAS bf16x8*)(lds + PG8_SB(b, h) + boff + n * 2048 + k * 1024); } while (0)
#define PG8_MMA(ai, bj, At, Bt) do { __builtin_amdgcn_s_setprio(1); _Pragma("unroll") for (int m = 0; m < 4; ++m) _Pragma("unroll") for (int n = 0; n < 2; ++n) _Pragma("unroll") for (int k = 0; k < 2; ++k) \
        acc[ai][bj][m][n] = __builtin_amdgcn_mfma_f32_16x16x32_bf16(Bt[n][k], At[m][k], acc[ai][bj][m][n], 0, 0, 0); __builtin_amdgcn_s_setprio(0); } while (0)
#define PG8_WAIT_V(n) asm volatile("s_waitcnt vmcnt(" #n ")" ::: "memory")
#define PG8_WAIT_L(n) asm volatile("s_waitcnt lgkmcnt(" #n ")" ::: "memory")
#define PG8_BAR __builtin_amdgcn_s_barrier()
#define PG8_SCHED __builtin_amdgcn_sched_barrier(0)
    Unit cur, nxt; int ui = 0;
    if (!S.next(0, cur)) return;
    f32x4 acc[2][2][4][2];
#pragma unroll
    for (int a = 0; a < 2; ++a)
#pragma unroll
        for (int b = 0; b < 2; ++b)
#pragma unroll
            for (int m = 0; m < 4; ++m)
#pragma unroll
                for (int n = 0; n < 2; ++n) acc[a][b][m][n] = (f32x4){0.f, 0.f, 0.f, 0.f};
    bf16x8 At[4][2], B0[2][2], B1[2][2];
    const char* cA = (const char*)g.A + (size_t)cur.pm * tstepA + cur.offA; const char* cB = (const char*)g.Bt + (size_t)cur.pn * tstepB + cur.offB;
    S.a_ready(cur);
    if constexpr (SP2) {
        PG8_STAGE(PG8_SB(0, 0), cB, voffB); PG8_STAGE(PG8_SB(0, 1), cB + hstepB, voffB); PG8_STAGE(PG8_SA(0, 0), cA, voffA); PG8_STAGE(PG8_SA(0, 1), cA + hstepA, voffA);
        if (wr == 1) PG8_BAR;
        PG8_WAIT_V(2); PG8_BAR;
        PG8_STAGE(PG8_SB(1, 0), cB + kstep, voffB); PG8_STAGE(PG8_SA(1, 0), cA + kstep, voffA); PG8_STAGE(PG8_SB(1, 1), cB + hstepB + kstep, voffB);
        PG8_WAIT_V(6); PG8_BAR;
    } else {
        PG8_STAGE(PG8_SB(0, 0), cB, voffB); PG8_STAGE(PG8_SA(0, 0), cA, voffA); PG8_STAGE(PG8_SB(0, 1), cB + hstepB, voffB); PG8_STAGE(PG8_SA(0, 1), cA + hstepA, voffA);
        if (wr == 1) PG8_BAR;
        PG8_WAIT_V(4); PG8_BAR;
        PG8_STAGE(PG8_SB(1, 0), cB + kstep, voffB); PG8_STAGE(PG8_SA(1, 0), cA + kstep, voffA); PG8_STAGE(PG8_SB(1, 1), cB + hstepB + kstep, voffB);
        PG8_WAIT_V(6); PG8_BAR;
    }
    for (;;) {
        const bool has_next = S.next(ui + 1, nxt);
        const char* nA = has_next ? (const char*)g.A + (size_t)nxt.pm * tstepA + nxt.offA : cA; const char* nB = has_next ? (const char*)g.Bt + (size_t)nxt.pn * tstepB + nxt.offB : cB;
        for (int t = 0; t < nt; t += 2) {
            const bool last = (t == nt - 2);
            const char* a1 = cA + (size_t)(t + 1) * kstep;
            const char* a2 = last ? nA : cA + (size_t)(t + 2) * kstep; const char* b2 = last ? nB : cB + (size_t)(t + 2) * kstep;
            const char* a3 = a2 + kstep; const char* b3 = b2 + kstep;
            if (last && has_next) S.a_ready(nxt);
            if constexpr (SP2) {
            PG8_LDB(B0, 0, 0); PG8_LDB(B1, 0, 1); PG8_SCHED; PG8_LDA(At, 0, 0); PG8_STAGE(PG8_SA(1, 1), a1 + hstepA, voffA);
            PG8_WAIT_V(8); PG8_WAIT_L(0); PG8_BAR; PG8_MMA(0, 0, At, B0); PG8_MMA(0, 1, At, B1); PG8_BAR; PG8_SCHED;
            PG8_LDA(At, 0, 1); PG8_STAGE(PG8_SB(0, 0), b2, voffB); PG8_STAGE(PG8_SB(0, 1), b2 + hstepB, voffB); PG8_STAGE(PG8_SA(0, 0), a2, voffA);
            PG8_WAIT_V(8); PG8_WAIT_L(0); PG8_BAR; PG8_MMA(1, 0, At, B0); PG8_MMA(1, 1, At, B1); PG8_BAR; PG8_SCHED;
            PG8_LDB(B0, 1, 0); PG8_LDB(B1, 1, 1); PG8_SCHED; PG8_LDA(At, 1, 0); PG8_STAGE(PG8_SA(0, 1), a2 + hstepA, voffA);
            PG8_WAIT_V(8); PG8_WAIT_L(0); PG8_BAR; PG8_MMA(0, 0, At, B0); PG8_MMA(0, 1, At, B1); PG8_BAR; PG8_SCHED;
            PG8_LDA(At, 1, 1); PG8_STAGE(PG8_SB(1, 0), b3, voffB); PG8_STAGE(PG8_SB(1, 1), b3 + hstepB, voffB); PG8_STAGE(PG8_SA(1, 0), a3, voffA);
            PG8_WAIT_V(8); PG8_WAIT_L(0); PG8_BAR; PG8_MMA(1, 0, At, B0); PG8_MMA(1, 1, At, B1); PG8_BAR; PG8_SCHED;
            } else {
            PG8_LDB(B0, 0, 0); PG8_SCHED; PG8_LDA(At, 0, 0); PG8_STAGE(PG8_SA(1, 1), a1 + hstepA, voffA);
            PG8_WAIT_L(8); PG8_BAR; PG8_WAIT_L(0); PG8_MMA(0, 0, At, B0); PG8_BAR; PG8_SCHED;
            PG8_LDB(B1, 0, 1); PG8_STAGE(PG8_SB(0, 0), b2, voffB);
            PG8_BAR; PG8_WAIT_L(0); PG8_MMA(0, 1, At, B1); PG8_BAR;
            PG8_LDA(At, 0, 1); PG8_STAGE(PG8_SA(0, 0), a2, voffA);
            PG8_BAR; PG8_WAIT_L(0); PG8_MMA(1, 0, At, B0); PG8_BAR; PG8_SCHED;
            PG8_STAGE(PG8_SB(0, 1), b2 + hstepB, voffB);
            PG8_WAIT_V(6); PG8_BAR; PG8_MMA(1, 1, At, B1); PG8_BAR;
            PG8_LDB(B0, 1, 0); PG8_SCHED; PG8_LDA(At, 1, 0); PG8_STAGE(PG8_SA(0, 1), a2 + hstepA, voffA);
            PG8_WAIT_L(8); PG8_BAR; PG8_WAIT_L(0); PG8_MMA(0, 0, At, B0); PG8_BAR; PG8_SCHED;
            PG8_LDB(B1, 1, 1); PG8_STAGE(PG8_SB(1, 0), b3, voffB);
            PG8_BAR; PG8_WAIT_L(0); PG8_MMA(0, 1, At, B1); PG8_BAR;
            PG8_LDA(At, 1, 1); PG8_STAGE(PG8_SA(1, 0), a3, voffA);
            PG8_BAR; PG8_WAIT_L(0); PG8_MMA(1, 0, At, B0); PG8_BAR; PG8_SCHED;
            PG8_STAGE(PG8_SB(1, 1), b3 + hstepB, voffB);
            PG8_WAIT_V(6); PG8_BAR; PG8_MMA(1, 1, At, B1); PG8_BAR;
            }
        }
        if constexpr (ALIGN_EPI) { if (wr == 0) PG8_BAR; }
        if constexpr (!Epi::AFTER_DRAIN) { E(acc, cur, wr, wc, fr, fq); S.done(cur); }
        if (!has_next) break;
#pragma unroll
        for (int a = 0; a < 2; ++a)
#pragma unroll
            for (int b = 0; b < 2; ++b)
#pragma unroll
                for (int m = 0; m < 4; ++m)
#pragma unroll
                    for (int n = 0; n < 2; ++n) acc[a][b][m][n] = (f32x4){0.f, 0.f, 0.f, 0.f};
        cur = nxt; cA = nA; cB = nB; ++ui;
        if constexpr (ALIGN_EPI) { if (wr == 1) PG8_BAR; }
    }
    PG8_WAIT_V(0);
    if constexpr (!ALIGN_EPI) { if (wr == 0) PG8_BAR; }
    PG8_BAR;
    if constexpr (Epi::AFTER_DRAIN) { E.fused(acc, cur, wr, wc, fr, fq, lds, wid, lane); S.done(cur); }
#undef PG8_SA
#undef PG8_SB
#undef PG8_STAGE
#undef PG8_LDA
#undef PG8_LDB
#undef PG8_MMA
#undef PG8_WAIT_V
#undef PG8_WAIT_L
#undef PG8_BAR
#undef PG8_SCHED
}
}

constexpr int T = 8192, D = 2048, FF = 5504, NGU = 2 * FF, HD = 128, NSEL = 128, NCMP = 511;
constexpr int IN_COLS = 5656, INP = 5888;
constexpr int MEMT = 256, MEMH = 4, MEMD = 512;
constexpr float LN_EPS = 1e-5f, RMS_EPS = 1e-6f;
constexpr float ALPHA = 1.189207115002721f;
constexpr float LOG2E = 1.4426950408889634f;
constexpr float QSCALE = 0.08838834764831845f * LOG2E;
constexpr float MEMQSCALE = 0.04419417382415922f;
constexpr int NWAVES = 8, NTHREADS = 512;

constexpr size_t MiB = 1u << 20;
constexpr size_t WS_CTL = 0, CTL_ZERO_BYTES = 1 * MiB;
constexpr size_t CTL_BIAS1 = 512 * 1024;
constexpr size_t WS_ROPE = 1 * MiB;
constexpr size_t WS_GATES = 5 * MiB;
constexpr size_t WS_KCMP = 6 * MiB;
constexpr size_t WS_VCMPT = 6 * MiB + 256 * 1024;
constexpr size_t WS_W2T = 6 * MiB + 512 * 1024;
constexpr size_t WS_MEMB = 7 * MiB, WS_KMEM = 8 * MiB, WS_VT = 9 * MiB;
constexpr size_t WS_W1T = 10 * MiB;
constexpr size_t WS_PC = 14 * MiB;
constexpr size_t WS_WGU1 = 30 * MiB, WS_WD1 = 73 * MiB, WS_WGU2 = 95 * MiB, WS_WD2 = 138 * MiB, WS_WIN = 160 * MiB, WS_WOUT = 183 * MiB;
constexpr size_t WS_WQ = 191 * MiB, WS_WK = 199 * MiB, WS_WV = 207 * MiB, WS_WO = 215 * MiB;
constexpr size_t WS_X = 224 * MiB;
constexpr size_t WS_XB = 288 * MiB;
constexpr size_t WS_BIG = 320 * MiB, WS_END = 416 * MiB;
constexpr size_t BG_SBQ = 0, BG_SBK = 16 * MiB, BG_SBVT = 32 * MiB, BG_NQ = 48 * MiB, BG_CMPIN = 64 * MiB, BG_KSL = 72 * MiB, BG_VSLT = 76 * MiB, BG_KWN = 80 * MiB, BG_VWNT = 84 * MiB;
constexpr size_t BG_QC = 0, BG_S = 32 * MiB, BG_P = 64 * MiB;
static_assert((size_t)NGU * D * 2 <= WS_WD1 - WS_WGU1 && (size_t)D * FF * 2 <= WS_WGU2 - WS_WD1 && (size_t)INP * D * 2 <= WS_WOUT - WS_WIN && (size_t)T * FF * 2 <= WS_END - WS_BIG, "ws map");
constexpr int CW_TMO = 0, CW_BAR = 4096;

#define GAS __attribute__((address_space(1)))
#define LAS __attribute__((address_space(3)))
typedef unsigned short bf16;
typedef unsigned v4u __attribute__((ext_vector_type(4)));
typedef unsigned v2u __attribute__((ext_vector_type(2)));
typedef float f32x4 __attribute__((ext_vector_type(4)));
typedef float f32x16 __attribute__((ext_vector_type(16)));
typedef short bf16x8 __attribute__((ext_vector_type(8)));
typedef short s16x4 __attribute__((ext_vector_type(4)));
#define LDS_WAIT() asm volatile("s_waitcnt lgkmcnt(0)" ::: "memory")
using pg8::cvt_pk_bf16;
__device__ __forceinline__ int crow(int r, int h) { return (r & 3) + 8 * (r >> 2) + 4 * h; }
__device__ __forceinline__ float ex2(float x) { return __builtin_amdgcn_exp2f(x); }
__device__ __forceinline__ float lg2(float x) { return __builtin_amdgcn_logf(x); }

#define XB_TMO      128
#define XB_XCNT(j)  (256  + 64 * (j))
#define XB_XSUB(j)  (1280 + 64 * (j))
#define XB_XGEN(j)  (2304 + 64 * (j))
#define XB_TOP      3328
#define XB_TOPGEN   3392
#define XCD_BAR_WORDS 3456
#define XB_SPIN_CAP (1u << 20)
__device__ __forceinline__ unsigned xb_ld(unsigned* p)              { return __hip_atomic_load(p, __ATOMIC_RELAXED, __HIP_MEMORY_SCOPE_AGENT); }
__device__ __forceinline__ unsigned xb_add(unsigned* p, unsigned v) { return __hip_atomic_fetch_add(p, v, __ATOMIC_RELAXED, __HIP_MEMORY_SCOPE_AGENT); }
__device__ __forceinline__ unsigned xb_xcc_id() { return (unsigned)__builtin_amdgcn_s_getreg((3 << 11) | 20) & 0xFu; }
#define XB_SPIN(cond, bar) do { unsigned _sp = 0; while (cond) { __builtin_amdgcn_s_sleep(1); \
    if ((++_sp & 255u) == 0u) { if (xb_ld(&(bar)[XB_TMO])) break; if (_sp > XB_SPIN_CAP) { atomicAdd(&(bar)[XB_TMO], 1u); break; } } } } while (0)
struct XcdBarrier { unsigned* bar; unsigned x; volatile LAS unsigned* st; };
__device__ __forceinline__ XcdBarrier xcd_barrier_post(unsigned* bar, volatile LAS unsigned* st) {
    XcdBarrier b; b.bar = bar; b.x = xb_xcc_id(); b.st = st;
    if (threadIdx.x == 0) (void)xb_add(&bar[XB_XCNT(b.x)], 1u);
    return b;
}
__device__ __forceinline__ void xcd_barrier_complete(unsigned* bar, unsigned x, unsigned& nloc, unsigned& nx) {
    const unsigned G = gridDim.x * gridDim.y * gridDim.z;
    unsigned sum, cnt, mine, sp = 0u;
    for (;;) {
        sum = 0u; cnt = 0u; mine = 0u;
#pragma unroll
        for (unsigned j = 0; j < 16; ++j) { const unsigned c = xb_ld(&bar[XB_XCNT(j)]); sum += c; cnt += (c > 0u) ? 1u : 0u; mine = (j == x) ? c : mine; }
        if (sum == G) break;
        __builtin_amdgcn_s_sleep(1);
        if ((++sp & 255u) == 0u) { if (xb_ld(&bar[XB_TMO])) break; if (sp > XB_SPIN_CAP) { atomicAdd(&bar[XB_TMO], 1u); break; } }
    }
    nloc = mine > 0u ? mine : 1u; nx = cnt > 0u ? cnt : 1u;
}
__device__ __forceinline__ void xcd_barrier(const XcdBarrier& b) {
    asm volatile("s_waitcnt vmcnt(0)" ::: "memory");
    __syncthreads();
    if (threadIdx.x == 0) {
        unsigned* bar = b.bar;
        __builtin_amdgcn_s_waitcnt(0);
        unsigned nloc = b.st[0], nx = b.st[1];
        if (nloc == 0u) { xcd_barrier_complete(bar, b.x, nloc, nx); b.st[0] = nloc; b.st[1] = nx; }
        const unsigned old = xb_add(&bar[XB_XSUB(b.x)], 1u);
        const unsigned gen = old / nloc;
        if (old + 1u == (gen + 1u) * nloc) {
            __builtin_amdgcn_fence(__ATOMIC_RELEASE, "agent");
            asm volatile("s_waitcnt vmcnt(0)" ::: "memory");
            const unsigned og = xb_add(&bar[XB_TOP], 1u);
            const unsigned tg = og / nx;
            if (og + 1u == (tg + 1u) * nx) xb_add(&bar[XB_TOPGEN], 1u);
            else XB_SPIN(xb_ld(&bar[XB_TOPGEN]) == tg, bar);
            __builtin_amdgcn_fence(__ATOMIC_ACQUIRE, "agent");
            xb_add(&bar[XB_XGEN(b.x)], 1u);
            asm volatile("s_waitcnt vmcnt(0)" ::: "memory");
        } else {
            XB_SPIN(xb_ld(&bar[XB_XGEN(b.x)]) == gen, bar);
            __builtin_amdgcn_fence(__ATOMIC_ACQUIRE, "agent");
            asm volatile("s_waitcnt vmcnt(0)" ::: "memory");
        }
    }
    __syncthreads();
}

struct Args { const float* in[29]; float* out; unsigned char* ws; double invf[64]; int ph_lo, ph_hi, li, pad; };
struct Ctx {
    const float* const* in; float* out; unsigned char* ws; LAS unsigned char* lds;
    int tid, lane, wave, G, bid, gw, NGW;
};
__device__ __forceinline__ bf16* wsb(const Ctx& C, size_t off) { return (bf16*)(C.ws + off); }
__device__ __forceinline__ float* wsf(const Ctx& C, size_t off) { return (float*)(C.ws + off); }

__device__ __forceinline__ float wave_sum(float v) {
#pragma unroll
    for (int o = 1; o < 64; o <<= 1) v += __shfl_xor(v, o);
    return v;
}
__device__ __forceinline__ float wave_max(float v) {
#pragma unroll
    for (int o = 1; o < 64; o <<= 1) v = fmaxf(v, __shfl_xor(v, o));
    return v;
}

__device__ __forceinline__ void conv_item(const float* __restrict__ src, int ldsrc, int col4, int k0, bf16* dst, int ldd, int drow0, int lane) {
    const int ng = lane & 7, kg = lane >> 3;
    f32x4 v[8];
    if (col4 >= 0) {
#pragma unroll
        for (int i = 0; i < 8; ++i) v[i] = __builtin_nontemporal_load((const f32x4*)(src + (size_t)(k0 + 8 * kg + i) * ldsrc + col4)); }
    else {
#pragma unroll
        for (int i = 0; i < 8; ++i) v[i] = (f32x4){0.f, 0.f, 0.f, 0.f}; }
    bf16* dp = dst + (size_t)(drow0 + 4 * ng) * ldd + k0 + 8 * kg;
#pragma unroll
    for (int j = 0; j < 4; ++j) { v4u o; o.x = cvt_pk_bf16(v[0][j], v[1][j]); o.y = cvt_pk_bf16(v[2][j], v[3][j]); o.z = cvt_pk_bf16(v[4][j], v[5][j]); o.w = cvt_pk_bf16(v[6][j], v[7][j]);
        *(v4u*)(dp + (size_t)j * ldd) = o; }
}
__device__ __forceinline__ int win_srccol(int p) {
    if (p >= IN_COLS) return -1;
    const bool rope = (p >= 3072 && p < 4352) || (p >= 4608 && p < 4864) || (p >= 5120 && p < 5376);
    if (!rope) return p;
    const int hb = p & ~127, pp = p & 127, wc = pp >> 5, n = (pp >> 4) & 1, r = pp & 15;
    return hb + 64 * n + 16 * wc + r;
}
__device__ __forceinline__ int job_items(int job) { return (job == 0 || job == 2) ? 11008 : ((job == 1 || job == 3) ? 5504 : (job == 4 ? 5888 : (job <= 9 ? 2048 : (job <= 11 ? 512 : 16)))); }
__device__ __forceinline__ void conv_job(const Ctx& C, int job, int r) {
    const int lane = C.lane, ng4 = 4 * (lane & 7);
    if (job == 0 || job == 2) { const int f = job == 2; const int ndb = NGU / 32, db = r % ndb, kb = r / ndb, p0 = db * 32, tile = p0 >> 8, rr = p0 & 255;
        const float* src = C.in[rr < 128 ? (f ? 24 : 4) : (f ? 25 : 5)];
        conv_item(src, FF, tile * 128 + (rr & 127) + ng4, kb * 64, wsb(C, f ? WS_WGU2 : WS_WGU1), D, p0, lane); }
    else if (job == 1 || job == 3) { const int f = job == 3; const int db = r % 64, kb = r / 64;
        conv_item(C.in[f ? 26 : 6], D, db * 32 + ng4, kb * 64, wsb(C, f ? WS_WD2 : WS_WD1), FF, db * 32, lane); }
    else if (job == 4) { const int ndb = INP / 32, db = r % ndb, kb = r / ndb;
        conv_item(C.in[7], IN_COLS, win_srccol(db * 32 + ng4), kb * 64, wsb(C, WS_WIN), D, db * 32, lane); }
    else if (job <= 9) { const int w = job - 5, db = r % 64, kb = r / 64;
        const float* src = C.in[w == 0 ? 15 : 17 + w];
        const size_t dst = w == 0 ? WS_WOUT : (w == 1 ? WS_WQ : (w == 2 ? WS_WK : (w == 3 ? WS_WV : WS_WO)));
        conv_item(src, D, db * 32 + ng4, kb * 64, wsb(C, dst), D, db * 32, lane); }
    else if (job <= 11) { const int kv = job - 10, db = r % 8, kb = r / 8;
        conv_item(C.in[kv ? 12 : 9], 256, db * 32 + ng4, kb * 64, wsb(C, WS_W1T) + (size_t)kv * 256 * 4096, 4096, db * 32, lane); }
    else { const int kv = job - 12, db = r % 4, kb = r / 4;
        conv_item(C.in[kv ? 13 : 10], 128, db * 32 + ng4, kb * 64, wsb(C, WS_W2T) + (size_t)kv * 128 * 256, 256, db * 32, lane); }
}
template <unsigned MASK> __device__ __forceinline__ void conv_static(const Ctx& C, int w, int nw) {
    int base = 0;
#pragma unroll 1
    for (int job = 0; job < 14; ++job) { if (!((MASK >> job) & 1u)) continue; const int n = job_items(job);
        int first = (w - base % nw + nw) % nw;
#pragma unroll 1
        for (int r = first; r < n; r += nw) conv_job(C, job, r);
        base += n; }
}
template <unsigned MASK> __device__ __forceinline__ void conv_dynamic(const Ctx& C, unsigned* ctr) {
    int total = 0;
#pragma unroll
    for (int job = 0; job < 14; ++job) if ((MASK >> job) & 1u) total += job_items(job);
    for (;;) {
        unsigned idx = 0; if (C.lane == 0) idx = __hip_atomic_fetch_add(ctr, 1u, __ATOMIC_RELAXED, __HIP_MEMORY_SCOPE_AGENT);
        int r = __builtin_amdgcn_readfirstlane((int)idx); if (r >= total) break;
        int job = 0;
#pragma unroll 1
        for (; job < 14; ++job) { if (!((MASK >> job) & 1u)) continue; const int n = job_items(job); if (r < n) break; r -= n; }
        conv_job(C, job, r);
    }
}
constexpr unsigned JOBS_P0 = (1u << 0) | (1u << 7) | (1u << 8);
constexpr unsigned JOBS_P1 = (1u << 1) | (1u << 4) | (1u << 10) | (1u << 11) | (1u << 12) | (1u << 13);
constexpr unsigned JOBS_P7 = (1u << 2) | (1u << 3) | (1u << 5) | (1u << 6) | (1u << 9);
constexpr int CW_CONVCTR = 1024;

__device__ __forceinline__ void sincos_d(double r, float& c, float& s) {
    const double x = 0.25 * r, x2 = x * x;
    double sn = x * (1.0 + x2 * (-1.0 / 6 + x2 * (1.0 / 120 + x2 * (-1.0 / 5040 + x2 * (1.0 / 362880 + x2 * (-1.0 / 39916800 + x2 * (1.0 / 6227020800.0)))))));
    double cs = 1.0 + x2 * (-0.5 + x2 * (1.0 / 24 + x2 * (-1.0 / 720 + x2 * (1.0 / 40320 + x2 * (-1.0 / 3628800 + x2 * (1.0 / 479001600.0))))));
    double s2 = 2.0 * sn * cs, c2 = 1.0 - 2.0 * sn * sn;
    double s4 = 2.0 * s2 * c2, c4 = 1.0 - 2.0 * s2 * s2;
    c = (float)c4; s = (float)s4;
}
__device__ __forceinline__ void p0_prologue(const Ctx& C, const double* invf, bool first) {
    const int lane = C.lane;
    conv_static<JOBS_P0>(C, C.gw, C.NGW);
    { const int gt = C.gw * 64 + lane, NT = C.NGW * 64;
      const float* x = C.in[0]; bf16* xb = wsb(C, WS_XB);
      for (int i = gt; i < T * D / 8; i += NT) { const f32x4 a = *(const f32x4*)(x + (size_t)i * 8), b = *(const f32x4*)(x + (size_t)i * 8 + 4);
          v4u o; o.x = cvt_pk_bf16(a[0], a[1]); o.y = cvt_pk_bf16(a[2], a[3]); o.z = cvt_pk_bf16(b[0], b[1]); o.w = cvt_pk_bf16(b[2], b[3]); *(v4u*)(xb + (size_t)i * 8) = o; }
      const float* mem = C.in[1]; bf16* mb = wsb(C, WS_MEMB);
      for (int i = gt; i < MEMT * D / 8; i += NT) { const f32x4 a = *(const f32x4*)(mem + (size_t)i * 8), b = *(const f32x4*)(mem + (size_t)i * 8 + 4);
          v4u o; o.x = cvt_pk_bf16(a[0], a[1]); o.y = cvt_pk_bf16(a[2], a[3]); o.z = cvt_pk_bf16(b[0], b[1]); o.w = cvt_pk_bf16(b[2], b[3]); *(v4u*)(mb + (size_t)i * 8) = o; }
      float* rope = wsf(C, WS_ROPE);
      for (int i = gt; i < T * 64; i += NT) { const int pos = i >> 6, fi = i & 63; const double ang = (double)pos * invf[fi];
          const double n = rint(ang * 0.15915494309189535); const double rr = fma(-n, 6.283185307179586, ang) - n * 2.4492935982947064e-16;
          float c, s; sincos_d(rr, c, s); rope[2 * (size_t)i] = c; rope[2 * (size_t)i + 1] = s; }
    }
    if (first) for (int task = C.gw; task < 2 * 4 * 32; task += C.NGW) { const int kv = task >> 7, nch = (task >> 5) & 3, kch = task & 31, n = nch * 64 + lane;
        const float* pos = C.in[kv ? 11 : 8]; const float* w1 = C.in[kv ? 12 : 9]; float acc = 0.f;
#pragma unroll 8
        for (int k = kch * 128; k < kch * 128 + 128; ++k) acc += pos[k] * w1[(size_t)k * 256 + n];
        atomicAdd((float*)(C.ws + CTL_BIAS1) + kv * 256 + n, acc); }
}

__device__ __forceinline__ void ln_rows(const Ctx& C, const float* Y, const float* g, const float* b, float* X, bf16* Xb) {
    for (int row = C.gw; row < T; row += C.NGW) {
        const f32x4* yr = (const f32x4*)(Y + (size_t)row * D) + C.lane;
        f32x4 v[8]; float s = 0.f;
#pragma unroll
        for (int j = 0; j < 8; ++j) { v[j] = yr[64 * j]; s += (v[j][0] + v[j][1]) + (v[j][2] + v[j][3]); }
        const float mean = wave_sum(s) * (1.f / D); float s2 = 0.f;
#pragma unroll
        for (int j = 0; j < 8; ++j) { v[j] = v[j] - mean; s2 += (v[j][0] * v[j][0] + v[j][1] * v[j][1]) + (v[j][2] * v[j][2] + v[j][3] * v[j][3]); }
        const float rstd = 1.f / sqrtf(wave_sum(s2) * (1.f / D) + LN_EPS);
#pragma unroll
        for (int j = 0; j < 8; ++j) { const f32x4 gg = *((const f32x4*)g + C.lane + 64 * j), bb = *((const f32x4*)b + C.lane + 64 * j);
            const f32x4 o = v[j] * rstd * gg + bb;
            *((f32x4*)(X + (size_t)row * D) + C.lane + 64 * j) = o;
            if (Xb) *((v2u*)(Xb + (size_t)row * D) + C.lane + 64 * j) = pg8::pack4(o); }
    }
}
__device__ __forceinline__ void rms_rows(const Ctx& C, const float* O, const float* g, bf16* Yb) {
    const int half = C.lane >> 5, l5 = C.lane & 31;
    for (int row = C.gw; row < T; row += C.NGW) {
        const f32x4* orow = (const f32x4*)(O + (size_t)row * D + half * 1024) + l5;
        f32x4 v[8]; float s2 = 0.f;
#pragma unroll
        for (int j = 0; j < 8; ++j) { v[j] = orow[32 * j]; s2 += (v[j][0] * v[j][0] + v[j][1] * v[j][1]) + (v[j][2] * v[j][2] + v[j][3] * v[j][3]); }
#pragma unroll
        for (int o = 1; o < 32; o <<= 1) s2 += __shfl_xor(s2, o);
        const float rstd = 1.f / sqrtf(s2 * (1.f / 1024.f) + RMS_EPS);
#pragma unroll
        for (int j = 0; j < 8; ++j) { const f32x4 gg = *((const f32x4*)(g + half * 1024) + l5 + 32 * j);
            *((v2u*)(Yb + (size_t)row * D + half * 1024) + l5 + 32 * j) = pg8::pack4(v[j] * rstd * gg); }
    }
}
__device__ __forceinline__ void softmax_rows(const Ctx& C, const float* S, bf16* P) {
    for (int row = C.gw; row < MEMH * T; row += C.NGW) {
        const f32x4 v = *((const f32x4*)(S + (size_t)row * MEMT) + C.lane);
        const float m = wave_max(fmaxf(fmaxf(v[0], v[1]), fmaxf(v[2], v[3])));
        f32x4 e; float s = 0.f;
#pragma unroll
        for (int j = 0; j < 4; ++j) { e[j] = ex2((v[j] - m) * LOG2E); s += e[j]; }
        const float inv = 1.f / wave_sum(s);
        *((v2u*)(P + (size_t)row * MEMT) + C.lane) = pg8::pack4(e * inv);
    }
}

__device__ __forceinline__ float gelu_tanh(float x) {
    const float u = 0.7978845608028654f * (x + 0.044715f * x * x * x);
    const float th = 1.f - 2.f * __builtin_amdgcn_rcpf(1.f + ex2(2.f * LOG2E * u));
    return 0.5f * x * (1.f + th);
}
__device__ __forceinline__ void compress_l2(const Ctx& C) {
    const int lane = C.lane, r32 = lane & 31, h = lane >> 5;
    const float* PC = wsf(C, WS_PC); const float* bias1 = (const float*)(C.ws + CTL_BIAS1);
    for (int task = C.gw; task < 2 * 2 * 16 * 4; task += C.NGW) {
        const int nt = task & 3, rt = (task >> 2) & 15, g = (task >> 6) & 1, kv = task >> 7;
        const bf16* w2 = wsb(C, WS_W2T) + (size_t)kv * 128 * 256 + (size_t)(nt * 32 + r32) * 256 + 8 * h;
        f32x16 acc = {};
#pragma unroll 2
        for (int s = 0; s < 16; ++s) {
            const int k0 = 16 * s + 8 * h; f32x4 a0 = *(const f32x4*)(bias1 + kv * 256 + k0), a1 = *(const f32x4*)(bias1 + kv * 256 + k0 + 4);
#pragma unroll
            for (int kc = 0; kc < 8; ++kc) { const float* p = PC + ((((size_t)kc * 2 + kv) * 2 + g) * 512 + rt * 32 + r32) * 256 + k0;
                a0 = a0 + *(const f32x4*)p; a1 = a1 + *(const f32x4*)(p + 4); }
            v4u aw; aw.x = cvt_pk_bf16(gelu_tanh(a0[0]), gelu_tanh(a0[1])); aw.y = cvt_pk_bf16(gelu_tanh(a0[2]), gelu_tanh(a0[3]));
            aw.z = cvt_pk_bf16(gelu_tanh(a1[0]), gelu_tanh(a1[1])); aw.w = cvt_pk_bf16(gelu_tanh(a1[2]), gelu_tanh(a1[3]));
            const bf16x8 bw = *(const bf16x8*)(w2 + 16 * s);
            acc = __builtin_amdgcn_mfma_f32_32x32x16_bf16(__builtin_bit_cast(bf16x8, aw), bw, acc, 0, 0, 0);
        }
        if (kv == 0) { bf16* o = wsb(C, WS_KCMP) + (size_t)g * 512 * 128; const int d = nt * 32 + r32;
#pragma unroll
            for (int r = 0; r < 16; ++r) { const int row = rt * 32 + crow(r, h); o[(size_t)row * 128 + (((d >> 3) ^ (row & 15)) << 3) + (d & 7)] = row < NCMP ? (bf16)(cvt_pk_bf16(acc[r], 0.f) & 0xffffu) : (bf16)0; } }
        else { const int d = nt * 32 + r32; bf16* o = wsb(C, WS_VCMPT) + ((size_t)g * 16 + rt) * 128 * 32 + (size_t)d * 32;
#pragma unroll
            for (int gq = 0; gq < 4; ++gq) { const int rl = 8 * gq + 4 * h; f32x4 v = {acc[4 * gq], acc[4 * gq + 1], acc[4 * gq + 2], acc[4 * gq + 3]};
#pragma unroll
                for (int i = 0; i < 4; ++i) if (rt * 32 + rl + i >= NCMP) v[i] = 0.f;
                *(v2u*)(o + (((rl >> 2) ^ ((d >> 2) & 7)) << 2)) = pg8::pack4(v); } }
    }
}

__device__ __forceinline__ f32x16 qk_tile_g(const bf16* Ktile, const bf16x8 (&qf)[8], int r32, int h) {
    f32x16 st = {}; const bf16* kr = Ktile + (size_t)r32 * 128; const int sw = (r32 & 15) ^ h;
#pragma unroll
    for (int s = 0; s < 8; ++s) st = __builtin_amdgcn_mfma_f32_32x32x16_bf16(*(const bf16x8*)(kr + ((sw ^ (2 * s)) << 3)), qf[s], st, 0, 0, 0);
    return st;
}
__device__ __forceinline__ f32x16 qk_tile_l(const LAS unsigned char* kslot, const bf16x8 (&qf)[8], int r32, int h) {
    f32x16 st = {}; const LAS unsigned char* kr = kslot + r32 * 256; const int sw = ((r32 & 15) ^ h) << 4;
#pragma unroll
    for (int s = 0; s < 8; ++s) st = __builtin_amdgcn_mfma_f32_32x32x16_bf16(*(const LAS bf16x8*)(kr + (sw ^ (s << 5))), qf[s], st, 0, 0, 0);
    return st;
}
__device__ __forceinline__ void pack_w(const float (&w)[16], bf16x8& b0, bf16x8& b1) {
    v4u p0, p1;
    p0.x = cvt_pk_bf16(w[0], w[1]); p0.y = cvt_pk_bf16(w[2], w[3]); p0.z = cvt_pk_bf16(w[4], w[5]); p0.w = cvt_pk_bf16(w[6], w[7]);
    p1.x = cvt_pk_bf16(w[8], w[9]); p1.y = cvt_pk_bf16(w[10], w[11]); p1.z = cvt_pk_bf16(w[12], w[13]); p1.w = cvt_pk_bf16(w[14], w[15]);
    b0 = __builtin_bit_cast(bf16x8, p0); b1 = __builtin_bit_cast(bf16x8, p1);
}
__device__ __forceinline__ void pv_tile_g(f32x16 (&o)[4], const bf16* Vtile, const float (&w)[16], int r32, int h) {
    bf16x8 b0, b1; pack_w(w, b0, b1);
#pragma unroll
    for (int db = 0; db < 4; ++db) { const int d = 32 * db + r32; const bf16* vr = Vtile + (size_t)d * 32; const int sw = ((d >> 2) & 7) ^ h;
        const v2u a0 = *(const v2u*)(vr + (sw << 2)), a1 = *(const v2u*)(vr + ((sw ^ 2) << 2)), a2 = *(const v2u*)(vr + ((sw ^ 4) << 2)), a3 = *(const v2u*)(vr + ((sw ^ 6) << 2));
        const v4u f0 = {a0.x, a0.y, a1.x, a1.y}, f1 = {a2.x, a2.y, a3.x, a3.y};
        o[db] = __builtin_amdgcn_mfma_f32_32x32x16_bf16(__builtin_bit_cast(bf16x8, f0), b0, o[db], 0, 0, 0);
        o[db] = __builtin_amdgcn_mfma_f32_32x32x16_bf16(__builtin_bit_cast(bf16x8, f1), b1, o[db], 0, 0, 0); }
}
__device__ __forceinline__ void pv_tile_l(f32x16 (&o)[4], const LAS unsigned char* vslot, const float (&w)[16], int r32, int h) {
    bf16x8 b0, b1; pack_w(w, b0, b1);
#pragma unroll
    for (int db = 0; db < 4; ++db) { const int d = 32 * db + r32; const LAS unsigned char* vr = vslot + d * 64; const int sw = (((d >> 2) & 7) ^ h) << 3;
        const v2u a0 = *(const LAS v2u*)(vr + sw), a1 = *(const LAS v2u*)(vr + (sw ^ 16)), a2 = *(const LAS v2u*)(vr + (sw ^ 32)), a3 = *(const LAS v2u*)(vr + (sw ^ 48));
        const v4u f0 = {a0.x, a0.y, a1.x, a1.y}, f1 = {a2.x, a2.y, a3.x, a3.y};
        o[db] = __builtin_amdgcn_mfma_f32_32x32x16_bf16(__builtin_bit_cast(bf16x8, f0), b0, o[db], 0, 0, 0);
        o[db] = __builtin_amdgcn_mfma_f32_32x32x16_bf16(__builtin_bit_cast(bf16x8, f1), b1, o[db], 0, 0, 0); }
}

__device__ __forceinline__ void sb_item(const Ctx& C, int hd, int qt, float* Oatt) {
    const int lane = C.lane, c = lane & 31, h = lane >> 5, t = 32 * qt + c;
    const bf16* Qp = wsb(C, WS_BIG + BG_SBQ) + ((size_t)hd * T + t) * 128 + 8 * h;
    bf16x8 qf[8];
#pragma unroll
    for (int s = 0; s < 8; ++s) qf[s] = *(const bf16x8*)(Qp + 16 * s);
    const bf16* Kh = wsb(C, WS_BIG + BG_SBK) + (size_t)hd * T * 128; const bf16* Vh = wsb(C, WS_BIG + BG_SBVT) + (size_t)hd * T * 128;
    f32x16 o[4] = {}; float carry = 0.f;
    for (int kt = qt; kt >= 0; --kt) {
        const f32x16 st = qk_tile_g(Kh + (size_t)kt * 4096, qf, c, h);
        float l1m[16], lb[16], w[16];
#pragma unroll
        for (int r = 0; r < 16; ++r) { const int key = 32 * kt + crow(r, h); const float z = st[r];
            const float sp = fmaxf(z, 0.f) + lg2(1.f + ex2(-fabsf(z)));
            const bool valid = key < t; l1m[r] = valid ? -sp : 0.f; lb[r] = z - sp; }
        float G[4], PG[4], TT[4];
#pragma unroll
        for (int q = 0; q < 4; ++q) { G[q] = (l1m[4 * q] + l1m[4 * q + 1]) + (l1m[4 * q + 2] + l1m[4 * q + 3]); PG[q] = __shfl_xor(G[q], 32); TT[q] = G[q] + PG[q]; }
        const float SS[4] = {TT[3] + TT[2] + TT[1], TT[3] + TT[2], TT[3], 0.f};
#pragma unroll
        for (int q = 0; q < 4; ++q) { const float before = carry + SS[q] + (h == 0 ? PG[q] : 0.f);
            const float l3 = before, l2 = l3 + l1m[4 * q + 3], l1 = l2 + l1m[4 * q + 2], l0 = l1 + l1m[4 * q + 1];
            const float ls[4] = {l0, l1, l2, l3};
#pragma unroll
            for (int i = 0; i < 4; ++i) { const int r = 4 * q + i; const int key = 32 * kt + crow(r, h); w[r] = key < t ? ex2(lb[r] + ls[i]) : 0.f; } }
        carry += (TT[0] + TT[1]) + (TT[2] + TT[3]);
        pv_tile_g(o, Vh + (size_t)kt * 4096, w, c, h);
        if (__all(carry < -150.f)) break;
    }
    float* op = Oatt + (size_t)t * D + hd * 128 + 4 * h;
#pragma unroll
    for (int db = 0; db < 4; ++db)
#pragma unroll
        for (int q = 0; q < 4; ++q) *(f32x4*)(op + 32 * db + 8 * q) = (f32x4){o[db][4 * q], o[db][4 * q + 1], o[db][4 * q + 2], o[db][4 * q + 3]};
}

constexpr int AT_NS = 4, AT_SLOT = 16384, AT_RING = AT_NS * AT_SLOT;
__device__ __forceinline__ void glds16(const void* gsrc, unsigned lds_dst) { unsigned keep;
    asm volatile("s_mov_b32 %0, m0\n\ts_mov_b32 m0, %2\n\ts_nop 0\n\tglobal_load_lds_dwordx4 %1, off\n\ts_mov_b32 m0, %0" : "=&s"(keep) : "v"(gsrc), "s"(lds_dst) : "memory"); }
#define AT_WAITBAR(N) asm volatile("s_waitcnt vmcnt(" #N ") lgkmcnt(0)\n\ts_barrier" ::: "memory")
template <bool HASV, class Body>
__device__ __forceinline__ void stream_tiles(unsigned ring0, const bf16* Kt0, const bf16* Vt0, int ntiles, int wave, int lane, Body body) {
    const bf16* ksrc = Kt0 + wave * 512 + lane * 8; const bf16* vsrc = Vt0 + wave * 512 + lane * 8;
    const unsigned kdst = ring0 + wave * 1024, vdst = kdst + 8192;
    AT_WAITBAR(0);
#pragma unroll
    for (int j = 0; j < AT_NS - 1; ++j) if (j < ntiles) {
        glds16(ksrc + (size_t)j * 4096, (unsigned)__builtin_amdgcn_readfirstlane(kdst + j * AT_SLOT));
        if (HASV) glds16(vsrc + (size_t)j * 4096, (unsigned)__builtin_amdgcn_readfirstlane(vdst + j * AT_SLOT)); }
    for (int i = 0; i < ntiles; ++i) {
        const int rem = ntiles - 1 - i;
        if (rem >= 2) { if (HASV) AT_WAITBAR(4); else AT_WAITBAR(2); }
        else if (rem == 1) { if (HASV) AT_WAITBAR(2); else AT_WAITBAR(1); }
        else AT_WAITBAR(0);
        const int jn = i + AT_NS - 1;
        if (jn < ntiles) { const int sl = (jn & (AT_NS - 1)) * AT_SLOT;
            glds16(ksrc + (size_t)jn * 4096, (unsigned)__builtin_amdgcn_readfirstlane(kdst + sl));
            if (HASV) glds16(vsrc + (size_t)jn * 4096, (unsigned)__builtin_amdgcn_readfirstlane(vdst + sl)); }
        body(i, (i & (AT_NS - 1)) * AT_SLOT);
    }
}

template <class MaskF>
__device__ __forceinline__ void flash_tile_l(float& m, float& l, f32x16 (&o)[4], const bf16x8 (&qf)[8], const LAS unsigned char* slot, int c, int h, MaskF valid) {
    const f32x16 st = qk_tile_l(slot, qf, c, h);
    float x[16]; float tm = -INFINITY;
#pragma unroll
    for (int r = 0; r < 16; ++r) { x[r] = valid(r) ? st[r] : -INFINITY; tm = fmaxf(tm, x[r]); }
    tm = fmaxf(tm, __shfl_xor(tm, 32));
    const float mn = fmaxf(m, tm), ms = mn == -INFINITY ? 0.f : mn;
    const float alpha = ex2(m - ms);
    float w[16]; float ps = 0.f;
#pragma unroll
    for (int r = 0; r < 16; ++r) { w[r] = ex2(x[r] - ms); ps += w[r]; }
    l = l * alpha + ps; m = mn;
#pragma unroll
    for (int db = 0; db < 4; ++db) o[db] = o[db] * alpha;
    pv_tile_l(o, slot + 8192, w, c, h);
}

constexpr int NSA_WLDS = 8320;
static_assert(AT_RING + NWAVES * NSA_WLDS <= 147200, "attention LDS map (MISC words sit at 147200)");
__device__ __forceinline__ void nsa_unit(const Ctx& C, int g, int qt, float* Oatt) {
    const int lane = C.lane, wave = C.wave, c = lane & 31, h = lane >> 5, qi = c >> 2, hh = c & 3, head = 4 * g + hh, t0 = 64 * qt + 8 * wave, t = t0 + qi;
    const LAS unsigned char* ring = C.lds; const unsigned ring0 = (unsigned)(uintptr_t)C.lds;
    LAS unsigned char* wl = C.lds + AT_RING + wave * NSA_WLDS;
    LAS float* impA = (LAS float*)wl; LAS float* impB = impA + 8 * 128; LAS unsigned long long* selm = (LAS unsigned long long*)(wl + 2 * 8 * 128 * 4);
    const bf16* Qp = wsb(C, WS_BIG + BG_NQ) + ((size_t)head * T + t) * 128 + 8 * h;
    bf16x8 qf[8];
#pragma unroll
    for (int s = 0; s < 8; ++s) qf[s] = *(const bf16x8*)(Qp + 16 * s);
    const float* gp = wsf(C, WS_GATES) + (size_t)t * 24 + head * 3;
    const float g_c = gp[0], g_s = gp[1], g_w = gp[2];
    float* op = Oatt + (size_t)t * D + 1024 + head * 128 + 4 * h;
#pragma unroll
    for (int i = 0; i < 32; ++i) impA[i * 64 + lane] = 0.f;
    const int tq = 64 * qt + 63, ncmp = (tq >= 31) ? ((tq - 31) >> 4) + 1 : 0, ntile = (ncmp + 31) >> 5;
    const int cmax = (t >= 31) ? ((t - 31) >> 4) : -1;
    const int wcmax = (t0 + 7 >= 31) ? ((t0 + 7 - 31) >> 4) : -1;
    const bf16* Kc = wsb(C, WS_KCMP) + (size_t)g * 512 * 128; const bf16* Vc = wsb(C, WS_VCMPT) + (size_t)g * 16 * 128 * 32;
    if (ntile > 0) {
        float m = -INFINITY, l = 0.f;
        stream_tiles<false>(ring0, Kc, Vc, ntile, wave, lane, [&](int i, int so) {
            if (32 * i > wcmax) return;
            const f32x16 st = qk_tile_l(ring + so, qf, c, h);
            float tm = -INFINITY; float x[16];
#pragma unroll
            for (int r = 0; r < 16; ++r) { x[r] = (32 * i + crow(r, h) <= cmax) ? st[r] : -INFINITY; tm = fmaxf(tm, x[r]); }
            tm = fmaxf(tm, __shfl_xor(tm, 32));
            const float mn = fmaxf(m, tm), ms = mn == -INFINITY ? 0.f : mn; float ps = 0.f;
#pragma unroll
            for (int r = 0; r < 16; ++r) ps += ex2(x[r] - ms);
            l = l * ex2(m - ms) + ps; m = mn; });
        l += __shfl_xor(l, 32);
        const float ms = m == -INFINITY ? 0.f : m, inv = l > 0.f ? 1.f / l : 0.f;
        f32x16 o[4] = {};
        stream_tiles<true>(ring0, Kc, Vc, ntile, wave, lane, [&](int i, int so) {
            if (32 * i > wcmax) return;
            const f32x16 st = qk_tile_l(ring + so, qf, c, h);
            float w[16];
#pragma unroll
            for (int r = 0; r < 16; ++r) w[r] = (32 * i + crow(r, h) <= cmax) ? ex2(st[r] - ms) * inv : 0.f;
#pragma unroll
            for (int q = 0; q < 4; ++q) { float a = (w[4 * q] + w[4 * q + 1]) + (w[4 * q + 2] + 0.5f * w[4 * q + 3]), b = 0.5f * w[4 * q + 3];
                a += __shfl_xor(a, 1); a += __shfl_xor(a, 2); b += __shfl_xor(b, 1); b += __shfl_xor(b, 2);
                const int n = 8 * i + 2 * q + h;
                if (hh == 0) { impA[qi * 128 + n] = a; if (n + 1 < NSEL) impB[qi * 128 + n + 1] = b; } }
            pv_tile_l(o, ring + so + 8192, w, c, h); });
#pragma unroll
        for (int db = 0; db < 4; ++db)
#pragma unroll
            for (int q = 0; q < 4; ++q) *(f32x4*)(op + 32 * db + 8 * q) = (f32x4){o[db][4 * q], o[db][4 * q + 1], o[db][4 * q + 2], o[db][4 * q + 3]} * g_c;
    } else {
#pragma unroll
        for (int db = 0; db < 4; ++db)
#pragma unroll
            for (int q = 0; q < 4; ++q) *(f32x4*)(op + 32 * db + 8 * q) = (f32x4){0.f, 0.f, 0.f, 0.f};
    }
    const int nb = qt;
    LDS_WAIT(); asm volatile("" ::: "memory");
    for (int q = 0; q < 8; ++q) {
        unsigned long long mlo = 0ull, mhi = 0ull;
        if (nb < 16) { mlo = (2ull << nb) - 1ull; }
        else {
            float v0 = impA[q * 128 + lane] + impB[q * 128 + lane], v1 = impA[q * 128 + 64 + lane] + impB[q * 128 + 64 + lane];
            const int i0 = lane, i1 = lane + 64;
            v0 = (i0 == 0 || i0 == nb) ? INFINITY : (i0 <= nb ? v0 : -INFINITY);
            v1 = (i1 == nb) ? INFINITY : (i1 <= nb ? v1 : -INFINITY);
            for (int rd = 0; rd < 16; ++rd) {
                const float mx = wave_max(fmaxf(v0, v1));
                const unsigned long long b0 = __ballot(v0 == mx), b1 = __ballot(v1 == mx);
                int sel;
                if (b0) { sel = __ffsll((long long)b0) - 1; mlo |= 1ull << sel; if (lane == sel) v0 = -INFINITY; }
                else { sel = __ffsll((long long)b1) - 1; mhi |= 1ull << sel; if (lane == sel) v1 = -INFINITY; }
            }
        }
        if (lane == 0) { selm[2 * q] = mlo; selm[2 * q + 1] = mhi; }
    }
    LDS_WAIT(); asm volatile("" ::: "memory");
    const unsigned long long own_lo = selm[2 * qi], own_hi = selm[2 * qi + 1];
    unsigned long long u_lo = 0ull, u_hi = 0ull;
#pragma unroll
    for (int q = 0; q < 8; ++q) { u_lo |= selm[2 * q]; u_hi |= selm[2 * q + 1]; }
    u_lo = ((unsigned long long)__builtin_amdgcn_readfirstlane((unsigned)(u_lo >> 32)) << 32) | (unsigned)__builtin_amdgcn_readfirstlane((unsigned)u_lo);
    u_hi = ((unsigned long long)__builtin_amdgcn_readfirstlane((unsigned)(u_hi >> 32)) << 32) | (unsigned)__builtin_amdgcn_readfirstlane((unsigned)u_hi);
    {
        const bf16* Ks = wsb(C, WS_BIG + BG_KSL) + (size_t)g * T * 128; const bf16* Vs = wsb(C, WS_BIG + BG_VSLT) + (size_t)g * T * 128;
        float m = -INFINITY, l = 0.f; f32x16 o[4] = {};
        stream_tiles<true>(ring0, Ks, Vs, 2 * (nb + 1), wave, lane, [&](int i, int so) {
            const int n = i >> 1; const unsigned long long uu = n < 64 ? u_lo : u_hi, ow = n < 64 ? own_lo : own_hi;
            if (!((uu >> (n & 63)) & 1ull)) return;
            const bool sel = (ow >> (n & 63)) & 1ull; const int key0 = 32 * i;
            flash_tile_l(m, l, o, qf, ring + so, c, h, [&](int r) { return sel && (key0 + crow(r, h) <= t); }); });
        l += __shfl_xor(l, 32);
        const float sc = l > 0.f ? g_s / l : 0.f;
#pragma unroll
        for (int db = 0; db < 4; ++db)
#pragma unroll
            for (int q = 0; q < 4; ++q) { f32x4* p = (f32x4*)(op + 32 * db + 8 * q); *p = *p + (f32x4){o[db][4 * q], o[db][4 * q + 1], o[db][4 * q + 2], o[db][4 * q + 3]} * sc; }
    }
    {
        const bf16* Kw = wsb(C, WS_BIG + BG_KWN) + (size_t)g * T * 128; const bf16* Vw = wsb(C, WS_BIG + BG_VWNT) + (size_t)g * T * 128;
        float m = -INFINITY, l = 0.f; f32x16 o[4] = {};
        const int klo = (64 * qt - 511 > 0 ? 64 * qt - 511 : 0) >> 5, khi = (64 * qt + 63) >> 5;
        stream_tiles<true>(ring0, Kw + (size_t)klo * 4096, Vw + (size_t)klo * 4096, khi - klo + 1, wave, lane, [&](int i, int so) {
            const int key0 = 32 * (klo + i);
            if (key0 + 31 < t0 - 511 || key0 > t0 + 7) return;
            flash_tile_l(m, l, o, qf, ring + so, c, h, [&](int r) { const int key = key0 + crow(r, h); return key <= t && key > t - 512; }); });
        l += __shfl_xor(l, 32);
        const float sc = l > 0.f ? g_w / l : 0.f;
#pragma unroll
        for (int db = 0; db < 4; ++db)
#pragma unroll
            for (int q = 0; q < 4; ++q) { f32x4* p = (f32x4*)(op + 32 * db + 8 * q); *p = *p + (f32x4){o[db][4 * q], o[db][4 * q + 1], o[db][4 * q + 2], o[db][4 * q + 3]} * sc; }
    }
    AT_WAITBAR(0);
}
constexpr int CW_SBCTR = 2048;

constexpr int RING_BYTES = 131072, LDS_BYTES = 147456, MISC_OFF = LDS_BYTES - 256;
constexpr int N_PHASES = 20;
#ifndef MK_ONE_LAUNCH
#define MK_ONE_LAUNCH 1
#endif

__global__ void __launch_bounds__(NTHREADS, 2) fwd_kernel(Args args) {
    extern __shared__ __attribute__((aligned(16))) unsigned char lds_raw[];
    Ctx C;
    C.in = args.in; C.out = args.out; C.ws = args.ws; C.lds = (LAS unsigned char*)lds_raw;
    C.tid = threadIdx.x; C.lane = C.tid & 63; C.wave = __builtin_amdgcn_readfirstlane(C.tid >> 6);
    C.G = gridDim.x; C.bid = blockIdx.x; C.gw = C.bid * NWAVES + C.wave; C.NGW = C.G * NWAVES;
    volatile LAS unsigned* MISC = (volatile LAS unsigned*)(C.lds + MISC_OFF);
    for (int u = C.tid; u < (LDS_BYTES - RING_BYTES) / 4; u += NTHREADS) ((LAS unsigned*)(C.lds + RING_BYTES))[u] = 0u;
    __syncthreads();
    unsigned* barw = (unsigned*)(C.ws + WS_CTL) + CW_BAR + args.li * XCD_BAR_WORDS;
    XcdBarrier bar; bar.bar = barw; bar.x = 0; bar.st = nullptr;
    const int lo = args.ph_lo, hi = args.ph_hi;
    if (hi - lo > 1) bar = xcd_barrier_post(barw, MISC + 8);
#ifndef MK_MASK
#define MK_MASK 0xFFFFFu
#endif
#define IN(k) (((MK_MASK >> (k)) & 1u) && lo <= (k) && (k) < hi)
#define SEAM(k) do { if (IN(k) && IN((k) + 1)) xcd_barrier(bar); } while (0)
    LAS unsigned char* ring = C.lds;
    float* Yout = C.out;
    float* X = wsf(C, WS_X); bf16* XB = wsb(C, WS_XB); bf16* Hb = wsb(C, WS_BIG);

    if (IN(0)) { p0_prologue(C, args.invf, args.li == 0); } SEAM(0);
    if (IN(1)) {
        { pg8::Gemm gm{XB, wsb(C, WS_WGU1), D, D, D}; pg8::StaticOrder S; S.init(T, NGU, C.G, C.bid); pg8::EpiSwiGLU E{Hb, FF};
          pg8::gemm_phase<pg8::EpiSwiGLU, pg8::StaticOrder, true, true>(ring, gm, S, E); }
        { pg8::Gemm gm{wsb(C, WS_MEMB), wsb(C, WS_WK), D, D, D}; pg8::ListOrder S; S.init(1, 1, 8, C.G, C.bid, 96, 0, 0); pg8::EpiBf16S E{wsb(C, WS_KMEM), D, 1.f, 0};
          pg8::gemm_phase<pg8::EpiBf16S, pg8::ListOrder, true, true>(ring, gm, S, E); }
        { pg8::Gemm gm{wsb(C, WS_WV), wsb(C, WS_MEMB), D, D, D}; pg8::ListOrder S; S.init(1, 8, 1, C.G, C.bid, 104, 0, 0); pg8::EpiBf16S E{wsb(C, WS_VT), MEMT, 1.f, 0};
          pg8::gemm_phase<pg8::EpiBf16S, pg8::ListOrder, true, true>(ring, gm, S, E); }
        if (C.G == 256 && C.bid >= 112) conv_static<JOBS_P1>(C, (C.bid - 112) * NWAVES + C.wave, 144 * NWAVES);
        else if (C.G != 256) conv_static<JOBS_P1>(C, C.gw, C.NGW);
    } SEAM(1);
    if (IN(2)) { pg8::Gemm gm{Hb, wsb(C, WS_WD1), FF, FF, FF}; pg8::StaticOrder S; S.init(T, D, C.G, C.bid); pg8::EpiF32 E{Yout, D, C.in[0], ALPHA, 0.5f, 0};
        pg8::gemm_phase<pg8::EpiF32, pg8::StaticOrder, true, true>(ring, gm, S, E); } SEAM(2);
    if (IN(3)) { ln_rows(C, Yout, C.in[2], C.in[3], X, XB); } SEAM(3);
    if (IN(4)) { pg8::Gemm gm{XB, wsb(C, WS_WIN), D, D, D}; pg8::StaticOrder S; S.init(T, INP, C.G, C.bid);
        pg8::EpiWin E{wsb(C, WS_BIG + BG_SBQ), wsb(C, WS_BIG + BG_SBK), wsb(C, WS_BIG + BG_SBVT), wsb(C, WS_BIG + BG_NQ), wsb(C, WS_BIG + BG_CMPIN), wsb(C, WS_BIG + BG_KSL), wsb(C, WS_BIG + BG_VSLT),
                      wsb(C, WS_BIG + BG_KWN), wsb(C, WS_BIG + BG_VWNT), wsf(C, WS_GATES), wsf(C, WS_ROPE), T, QSCALE};
        pg8::gemm_phase<pg8::EpiWin, pg8::StaticOrder, true, true>(ring, gm, S, E); } SEAM(4);
    if (IN(5)) { pg8::Gemm gm{wsb(C, WS_BIG + BG_CMPIN), wsb(C, WS_W1T), 16 * 128, 4096, 512}; pg8::CmpOrder S{C.G, C.bid, (size_t)T * 128 * 2, (size_t)256 * 4096 * 2};
        pg8::EpiF32 E{wsf(C, WS_PC), 256, nullptr, 0.f, 1.f, (size_t)512 * 256};
        pg8::gemm_phase<pg8::EpiF32, pg8::CmpOrder, true, true>(ring, gm, S, E); } SEAM(5);
    if (IN(6)) { compress_l2(C); } SEAM(6);
    if (IN(7)) {
        if (C.G == 256) {
            nsa_unit(C, C.bid & 1, C.bid >> 1, Yout);
            unsigned* sbctr = (unsigned*)(C.ws + WS_CTL) + CW_SBCTR + 64 * args.li;
            for (;;) { unsigned idx = 0; if (C.lane == 0) idx = __hip_atomic_fetch_add(sbctr, 1u, __ATOMIC_RELAXED, __HIP_MEMORY_SCOPE_AGENT);
                const int item = __builtin_amdgcn_readfirstlane((int)idx); if (item >= 2048) break;
                sb_item(C, item & 7, item >> 3, Yout); }
        }
        conv_dynamic<JOBS_P7>(C, (unsigned*)(C.ws + WS_CTL) + CW_CONVCTR + 64 * args.li);
    } SEAM(7);
    if (IN(8)) { rms_rows(C, Yout, C.in[14], XB); } SEAM(8);
    if (IN(9)) { pg8::Gemm gm{XB, wsb(C, WS_WOUT), D, D, D}; pg8::StaticOrder S; S.init(T, D, C.G, C.bid); pg8::EpiF32 E{Yout, D, X, ALPHA, 1.f, 0};
        pg8::gemm_phase<pg8::EpiF32, pg8::StaticOrder, true, true>(ring, gm, S, E); } SEAM(9);
    if (IN(10)) { ln_rows(C, Yout, C.in[16], C.in[17], X, XB); } SEAM(10);
    if (IN(11)) { pg8::Gemm gm{XB, wsb(C, WS_WQ), D, D, D}; pg8::StaticOrder S; S.init(T, D, C.G, C.bid); pg8::EpiBf16S E{wsb(C, WS_BIG + BG_QC), D, MEMQSCALE, 0};
        pg8::gemm_phase<pg8::EpiBf16S, pg8::StaticOrder, true, true>(ring, gm, S, E); } SEAM(11);
    if (IN(12)) { pg8::Gemm gm{wsb(C, WS_BIG + BG_QC), wsb(C, WS_KMEM), D, D, MEMD}; pg8::ListOrder S; S.init(MEMH, T / 256, 1, C.G, C.bid, 0, (size_t)MEMD * 2, (size_t)MEMD * 2);
        pg8::EpiF32 E{wsf(C, WS_BIG + BG_S), MEMT, nullptr, 0.f, 1.f, (size_t)T * MEMT};
        pg8::gemm_phase<pg8::EpiF32, pg8::ListOrder, true, true>(ring, gm, S, E); } SEAM(12);
    if (IN(13)) { softmax_rows(C, wsf(C, WS_BIG + BG_S), wsb(C, WS_BIG + BG_P)); } SEAM(13);
    if (IN(14)) { pg8::Gemm gm{wsb(C, WS_BIG + BG_P), wsb(C, WS_VT), MEMT, MEMT, MEMT}; pg8::ListOrder S; S.init(MEMH, T / 256, 2, C.G, C.bid, 0, (size_t)T * MEMT * 2, (size_t)MEMD * MEMT * 2);
        pg8::EpiBf16S E{wsb(C, WS_BIG + BG_QC), D, 1.f, MEMD};
        pg8::gemm_phase<pg8::EpiBf16S, pg8::ListOrder, true, true>(ring, gm, S, E); } SEAM(14);
    if (IN(15)) { pg8::Gemm gm{wsb(C, WS_BIG + BG_QC), wsb(C, WS_WO), D, D, D}; pg8::StaticOrder S; S.init(T, D, C.G, C.bid); pg8::EpiF32 E{Yout, D, X, ALPHA, 1.f, 0};
        pg8::gemm_phase<pg8::EpiF32, pg8::StaticOrder, true, true>(ring, gm, S, E); } SEAM(15);
    if (IN(16)) { ln_rows(C, Yout, C.in[22], C.in[23], X, XB); } SEAM(16);
    if (IN(17)) { pg8::Gemm gm{XB, wsb(C, WS_WGU2), D, D, D}; pg8::StaticOrder S; S.init(T, NGU, C.G, C.bid); pg8::EpiSwiGLU E{Hb, FF};
        pg8::gemm_phase<pg8::EpiSwiGLU, pg8::StaticOrder, true, true>(ring, gm, S, E); } SEAM(17);
    if (IN(18)) { pg8::Gemm gm{Hb, wsb(C, WS_WD2), FF, FF, FF}; pg8::StaticOrder S; S.init(T, D, C.G, C.bid); pg8::EpiF32 E{Yout, D, X, ALPHA, 0.5f, 0};
        pg8::gemm_phase<pg8::EpiF32, pg8::StaticOrder, true, true>(ring, gm, S, E); } SEAM(18);
    if (IN(19)) { ln_rows(C, Yout, C.in[27], C.in[28], Yout, nullptr); }
#undef IN
#undef SEAM
}

extern "C" void kernel_launch(void* const* d_in, const int* in_sizes, int n_in, void* d_out, int out_size, void* d_ws, size_t ws_size, hipStream_t stream) {
    static int grid = 0;
    if (grid == 0) {
        if (n_in != 29 || in_sizes[0] != T * D || out_size != T * D || ws_size < WS_END) { fprintf(stderr, "kernel_launch: unexpected shapes (n_in %d, in0 %d, out %d, ws %zu < %zu); nothing launched\n", n_in, n_in > 0 ? in_sizes[0] : -1, out_size, ws_size, (size_t)WS_END); grid = -1; return; }
        int dev = 0, cus = 0, per_cu = 0;
        if (hipGetDevice(&dev) != hipSuccess || hipDeviceGetAttribute(&cus, hipDeviceAttributeMultiprocessorCount, dev) != hipSuccess) { grid = -1; return; }
        if (hipFuncSetAttribute((const void*)fwd_kernel, hipFuncAttributeMaxDynamicSharedMemorySize, LDS_BYTES) != hipSuccess) { fprintf(stderr, "kernel_launch: hipFuncSetAttribute failed\n"); grid = -1; return; }
        if (hipOccupancyMaxActiveBlocksPerMultiprocessor(&per_cu, (const void*)fwd_kernel, NTHREADS, LDS_BYTES) != hipSuccess || per_cu < 1) { fprintf(stderr, "kernel_launch: occupancy query says %d blocks per CU\n", per_cu); per_cu = 1; }
        (void)hipGetLastError();
        grid = cus;
        if (grid != 256) fprintf(stderr, "kernel_launch: %d CUs; the attention phase is laid out for 256\n", grid);
    }
    if (grid < 0) return;
    (void)hipMemsetAsync((char*)d_ws + WS_CTL, 0, CTL_ZERO_BYTES, stream);
    Args a{};
    for (int i = 0; i < 29; ++i) a.in[i] = (const float*)d_in[i];
    a.out = (float*)d_out; a.ws = (unsigned char*)d_ws;
    for (int i = 0; i < 64; ++i) a.invf[i] = std::pow(10000.0, -(double)i / 64.0);
#if defined(MK_PROBE_PHASE)
    a.ph_lo = 0; a.ph_hi = MK_PROBE_PHASE + 1; a.li = 0; hipLaunchKernelGGL(fwd_kernel, dim3(grid), dim3(NTHREADS), LDS_BYTES, stream, a);
    a.ph_lo = MK_PROBE_PHASE; a.ph_hi = MK_PROBE_PHASE + 1; a.li = 1; hipLaunchKernelGGL(fwd_kernel, dim3(grid), dim3(NTHREADS), LDS_BYTES, stream, a);
    a.ph_lo = MK_PROBE_PHASE + 1; a.ph_hi = N_PHASES; a.li = 2; hipLaunchKernelGGL(fwd_kernel, dim3(grid), dim3(NTHREADS), LDS_BYTES, stream, a);
#elif MK_ONE_LAUNCH
    a.ph_lo = 0; a.ph_hi = N_PHASES; a.li = 0;
    hipLaunchKernelGGL(fwd_kernel, dim3(grid), dim3(NTHREADS), LDS_BYTES, stream, a);
#else
    for (int p = 0; p < N_PHASES; ++p) { a.ph_lo = p; a.ph_hi = p + 1; a.li = 0; hipLaunchKernelGGL(fwd_kernel, dim3(grid), dim3(NTHREADS), LDS_BYTES, stream, a); }
#endif
}
```

```cpp
#define AT_SB 0
#include <hip/hip_runtime.h>
#include <cstdio>
#include <cstdint>
#include <cmath>

namespace pg8 {
#define PG8_LAS __attribute__((address_space(3)))
typedef unsigned short bf16_t;
typedef short bf16x8 __attribute__((ext_vector_type(8)));
typedef float f32x4 __attribute__((ext_vector_type(4)));
typedef unsigned u32x4 __attribute__((ext_vector_type(4)));
typedef unsigned u32x2 __attribute__((ext_vector_type(2)));
constexpr int BM = 256, BK = 64, HALF = 128, HTB = HALF * BK * 2  , STAGE_BYTES = 8 * HTB, NXCD = 8, WGM = 8;

__host__ __device__ __forceinline__ int lds_byte(int r, int c) { const int st = (r >> 4) * 2 + (c >> 5), rr = r & 15, cc = c & 31, ob = rr * 64 + cc * 2; return st * 1024 + (ob ^ (((ob >> 9) & 1) << 5)); }
__host__ __device__ __forceinline__ void stage_rc(int b, int& R, int& C) { const int st = b / 1024, sb = b % 1024, swz = sb ^ (((sb >> 9) & 1) << 5); R = (st >> 1) * 16 + swz / 64; C = (st & 1) * 32 + (swz % 64) / 2; }
__host__ __device__ __forceinline__ int perm32(int rho) { const int n = rho >> 4, i = rho & 15; return 8 * (i >> 2) + 4 * n + (i & 3); }

struct Unit { int pm, pn, z; size_t offA, offB; };
struct Gemm { const bf16_t* A; const bf16_t* Bt; int lda, ldb, K; };

struct StaticOrder {
    int nM, nN, nwg, G, c;
    __host__ __device__ void init(int M, int N, int G_, int c_) { nM = M / BM; nN = N / BM; nwg = nM * nN; G = G_; c = c_; }
    __host__ __device__ bool next(int i, Unit& u) const {
        const long L = (long)i * G + c; if (L >= nwg) return false;
        int wgid = (int)L; { const int q = nwg / NXCD, r = nwg % NXCD, xcd = wgid % NXCD, off = wgid / NXCD; wgid = (xcd < r ? xcd * (q + 1) : r * (q + 1) + (xcd - r) * q) + off; }
        const int nig = WGM * nN, gid = wgid / nig, fm = gid * WGM, gsz = (nM - fm) < WGM ? (nM - fm) : WGM;
        u.pm = fm + ((wgid % nig) % gsz); u.pn = (wgid % nig) / gsz; u.z = 0; u.offA = 0; u.offB = 0; return true;
    }
    __device__ __forceinline__ void a_ready(const Unit&) const {}
    __device__ __forceinline__ void done(const Unit&) const {}
};
struct ListOrder {
    int nM, nN, nwg, G, c; size_t zA, zB;
    __host__ __device__ void init(int nZ, int nM_, int nN_, int G_, int c_, int c0, size_t zA_, size_t zB_) { nM = nM_; nN = nN_; nwg = nZ * nM_ * nN_; G = G_; c = (c_ - c0 + G_) % G_; zA = zA_; zB = zB_; }
    __host__ __device__ bool next(int i, Unit& u) const {
        const long L = (long)i * G + c; if (L >= nwg) return false;
        const int l = (int)L; u.pn = l % nN; u.pm = (l / nN) % nM; u.z = l / (nN * nM); u.offA = (size_t)u.z * zA; u.offB = (size_t)u.z * zB; return true;
    }
    __device__ __forceinline__ void a_ready(const Unit&) const {}
    __device__ __forceinline__ void done(const Unit&) const {}
};

typedef float f32x2_t __attribute__((ext_vector_type(2))); typedef __bf16 bf16x2_t __attribute__((ext_vector_type(2)));
struct CmpOrder {
    int G, c; size_t grpA, kvB;
    __host__ __device__ bool next(int i, Unit& u) const {
        const long L = (long)i * G + c; if (L >= 64) return false;
        const int l = (int)L, kc = l & 7, pm = (l >> 3) & 1, g = (l >> 4) & 1, kv = l >> 5;
        u.pm = pm; u.pn = 0; u.z = (kc * 2 + kv) * 2 + g; u.offA = (size_t)(kv * 2 + g) * grpA + (size_t)kc * 1024; u.offB = (size_t)kv * kvB + (size_t)kc * 1024; return true;
    }
    __device__ __forceinline__ void a_ready(const Unit&) const {}
    __device__ __forceinline__ void done(const Unit&) const {}
};
__device__ __forceinline__ unsigned cvt_pk_bf16(float lo, float hi) { f32x2_t v = {lo, hi}; bf16x2_t b = __builtin_convertvector(v, bf16x2_t); return __builtin_bit_cast(unsigned, b); }
__device__ __forceinline__ u32x2 pack4(f32x4 v) { u32x2 w; w.x = cvt_pk_bf16(v[0], v[1]); w.y = cvt_pk_bf16(v[2], v[3]); return w; }

struct EpiSwiGLU {
    static constexpr bool PERM = false, AFTER_DRAIN = false;
    bf16_t* H; int ldh;
    __device__ __forceinline__ void operator()(const f32x4 (&acc)[2][2][4][2], const Unit& u, int wr, int wc, int fr, int fq) const {
        const int row0 = u.pm * BM + wr * 64 + fr, col0 = u.pn * HALF + wc * 32 + 4 * fq;
#pragma unroll
        for (int ai = 0; ai < 2; ++ai)
#pragma unroll
            for (int m = 0; m < 4; ++m) { bf16_t* rowp = H + (size_t)(row0 + ai * HALF + m * 16) * ldh + col0;
#pragma unroll
                for (int n = 0; n < 2; ++n) { const f32x4 g = acc[ai][0][m][n], up = acc[ai][1][m][n]; f32x4 h;
#pragma unroll
                    for (int j = 0; j < 4; ++j) { const float e = __builtin_amdgcn_exp2f(-1.4426950408889634f * g[j]); h[j] = g[j] * __builtin_amdgcn_rcpf(1.0f + e) * up[j]; }
                    *(u32x2*)(rowp + 16 * n) = pack4(h); } }
    }
};
struct EpiF32 {
    static constexpr bool PERM = false, AFTER_DRAIN = false;
    float* O; int ldc; const float* R; float alpha, beta; size_t zO;
    __device__ __forceinline__ void operator()(const f32x4 (&acc)[2][2][4][2], const Unit& u, int wr, int wc, int fr, int fq) const {
        const int row0 = u.pm * BM + wr * 64 + fr, col0 = u.pn * BM + wc * 32 + 4 * fq;
        float* base = O + (size_t)u.z * zO;
#pragma unroll
        for (int ai = 0; ai < 2; ++ai)
#pragma unroll
            for (int m = 0; m < 4; ++m) { const size_t off = (size_t)(row0 + ai * HALF + m * 16) * ldc + col0;
#pragma unroll
                for (int bj = 0; bj < 2; ++bj)
#pragma unroll
                    for (int n = 0; n < 2; ++n) { f32x4 v = acc[ai][bj][m][n] * beta; if (R) { const f32x4 r = *(const f32x4*)(R + off + bj * HALF + n * 16); v = v + r * alpha; }
                        *(f32x4*)(base + off + bj * HALF + n * 16) = v; } }
    }
};
struct EpiBf16S {
    static constexpr bool PERM = false, AFTER_DRAIN = false;
    bf16_t* O; int ldc; float scale; int zcol;
    __device__ __forceinline__ void operator()(const f32x4 (&acc)[2][2][4][2], const Unit& u, int wr, int wc, int fr, int fq) const {
        const int row0 = u.pm * BM + wr * 64 + fr, col0 = u.z * zcol + u.pn * BM + wc * 32 + 4 * fq;
#pragma unroll
        for (int ai = 0; ai < 2; ++ai)
#pragma unroll
            for (int m = 0; m < 4; ++m) { bf16_t* rowp = O + (size_t)(row0 + ai * HALF + m * 16) * ldc + col0;
#pragma unroll
                for (int bj = 0; bj < 2; ++bj)
#pragma unroll
                    for (int n = 0; n < 2; ++n) *(u32x2*)(rowp + bj * HALF + n * 16) = pack4(acc[ai][bj][m][n] * scale); }
    }
};
struct EpiWin {
    static constexpr bool PERM = false, AFTER_DRAIN = false;
    bf16_t *SBQ, *SBK, *SBVT, *NQ, *CMPIN, *KSL, *VSLT, *KWN, *VWNT; float* GATES; const float* ROPE; int T; float qscale;
    template <bool SWZ> __device__ __forceinline__ void st_plain(bf16_t* dst, int head0, const f32x4 (&acc)[2][2][4][2], const Unit& u, int wr, int wc, int fr, int fq, float sc) const {
        const int row0 = u.pm * BM + wr * 64 + fr, c0 = wc * 32 + 4 * fq;
#pragma unroll
        for (int bj = 0; bj < 2; ++bj)
#pragma unroll
            for (int ai = 0; ai < 2; ++ai)
#pragma unroll
                for (int m = 0; m < 4; ++m) { const int tok = row0 + ai * HALF + m * 16; bf16_t* rowp = dst + ((size_t)(head0 + bj) * T + tok) * 128;
#pragma unroll
                    for (int n = 0; n < 2; ++n) { const int c = c0 + 16 * n; const int off = SWZ ? ((((c >> 3) ^ (tok & 15)) << 3) + (c & 7)) : c;
                        *(u32x2*)(rowp + off) = pack4(acc[ai][bj][m][n] * sc); } }
    }
    template <bool SWZ> __device__ __forceinline__ void st_rope(bf16_t* dst, int head0, const f32x4 (&acc)[2][2][4][2], const Unit& u, int wr, int wc, int fr, int fq, float sc) const {
        const int row0 = u.pm * BM + wr * 64 + fr, i0 = wc * 16 + 4 * fq;
#pragma unroll
        for (int ai = 0; ai < 2; ++ai)
#pragma unroll
            for (int m = 0; m < 4; ++m) { const int tok = row0 + ai * HALF + m * 16;
                const f32x4 cs0 = *(const f32x4*)(ROPE + ((size_t)tok * 64 + i0) * 2), cs1 = *(const f32x4*)(ROPE + ((size_t)tok * 64 + i0) * 2 + 4);
                const f32x4 co = {cs0[0], cs0[2], cs1[0], cs1[2]}, si = {cs0[1], cs0[3], cs1[1], cs1[3]};
                const int olo_off = SWZ ? ((((i0 >> 3) ^ (tok & 15)) << 3) + (i0 & 7)) : i0, ohi_off = SWZ ? (((((i0 >> 3) + 8) ^ (tok & 15)) << 3) + (i0 & 7)) : i0 + 64;
#pragma unroll
                for (int bj = 0; bj < 2; ++bj) { const f32x4 lo = acc[ai][bj][m][0], hi = acc[ai][bj][m][1];
                    const f32x4 olo = (lo * co - hi * si) * sc, ohi = (lo * si + hi * co) * sc;
                    bf16_t* rowp = dst + ((size_t)(head0 + bj) * T + tok) * 128;
                    *(u32x2*)(rowp + olo_off) = pack4(olo); *(u32x2*)(rowp + ohi_off) = pack4(ohi); } }
    }
    __device__ __forceinline__ void st_vt(bf16_t* dst, int head0, const f32x4 (&acc)[2][2][4][2], const Unit& u, int wr, int wc, int fr, int fq) const {
        const int row0 = u.pm * BM + wr * 64 + fr, c0 = wc * 32 + 4 * fq;
#pragma unroll
        for (int bj = 0; bj < 2; ++bj)
#pragma unroll
            for (int ai = 0; ai < 2; ++ai)
#pragma unroll
                for (int m = 0; m < 4; ++m) { const int tok = row0 + ai * HALF + m * 16, kk = tok & 31, p16 = 2 * (kk >> 4) + ((kk >> 2) & 1), sub = ((kk >> 3) & 1) * 4 + (kk & 3);
                    bf16_t* tb = dst + ((size_t)(head0 + bj) * T + (tok & ~31)) * 128 + sub;
#pragma unroll
                    for (int n = 0; n < 2; ++n) { const u32x2 w = pack4(acc[ai][bj][m][n]); const int d = c0 + 16 * n;
                        bf16_t* p = tb + d * 32 + ((p16 ^ ((d >> 2) & 3)) << 3);
                        p[0] = (bf16_t)(w.x & 0xffffu); p[32] = (bf16_t)(w.x >> 16); p[64] = (bf16_t)(w.y & 0xffffu); p[96] = (bf16_t)(w.y >> 16); } }
    }
    __device__ __forceinline__ void operator()(const f32x4 (&acc)[2][2][4][2], const Unit& u, int wr, int wc, int fr, int fq) const {
        asm volatile("" : "+v"(fr), "+v"(fq));
        const int pn = u.pn;
        if (pn < 4) st_plain<false>(SBQ, 2 * pn, acc, u, wr, wc, fr, fq, qscale);
        else if (pn < 8) st_plain<true>(SBK, 2 * (pn - 4), acc, u, wr, wc, fr, fq, 1.f);
        else if (pn < 12) st_vt(SBVT, 2 * (pn - 8), acc, u, wr, wc, fr, fq);
        else if (pn < 16) st_rope<false>(NQ, 2 * (pn - 12), acc, u, wr, wc, fr, fq, qscale);
        else if (pn == 16) st_rope<false>(CMPIN, 0, acc, u, wr, wc, fr, fq, 1.f);
        else if (pn == 17) st_plain<false>(CMPIN, 2, acc, u, wr, wc, fr, fq, 1.f);
        else if (pn == 18) st_rope<true>(KSL, 0, acc, u, wr, wc, fr, fq, 1.f);
        else if (pn == 19) st_vt(VSLT, 0, acc, u, wr, wc, fr, fq);
        else if (pn == 20) st_rope<true>(KWN, 0, acc, u, wr, wc, fr, fq, 1.f);
        else if (pn == 21) st_vt(VWNT, 0, acc, u, wr, wc, fr, fq);
        else {
            if (wc == 0) { const int row0 = u.pm * BM + wr * 64 + fr;
#pragma unroll
                for (int ai = 0; ai < 2; ++ai)
#pragma unroll
                    for (int m = 0; m < 4; ++m) { float* gp = GATES + (size_t)(row0 + ai * HALF + m * 16) * 24;
#pragma unroll
                        for (int n = 0; n < 2; ++n) { const int c = 16 * n + 4 * fq; if (c < 24) { const f32x4 v = acc[ai][0][m][n]; f32x4 s;
#pragma unroll
                                for (int j = 0; j < 4; ++j) s[j] = __builtin_amdgcn_rcpf(1.0f + __builtin_amdgcn_exp2f(-1.4426950408889634f * v[j]));
                                *(f32x4*)(gp + c) = s; } } } }
        }
    }
};

template <class Epi, class Sched, bool ALIGN_EPI = false, bool SP2 = false>
__device__ __forceinline__ void gemm_phase(PG8_LAS unsigned char* lds, const Gemm g, const Sched& S, const Epi& E) {
    const int tid = threadIdx.x, wid = __builtin_amdgcn_readfirstlane(tid >> 6), lane = tid & 63, wr = wid >> 2, wc = wid & 3, fr = lane & 15, fq = lane >> 4;
    const int K = g.K, nt = K / BK, lda = g.lda, ldb = g.ldb;
    unsigned voffA[2], voffB[2];
#pragma unroll
    for (int i = 0; i < 2; ++i) { int R, C; stage_rc(tid * 16 + i * 8192, R, C); const int Rb = Epi::PERM ? ((R & ~31) + perm32(R & 31)) : R;
        voffA[i] = (unsigned)(R * lda + C) * 2u; voffB[i] = (unsigned)(Rb * ldb + C) * 2u; }
    const size_t kstep = (size_t)(BK * 2);
    const size_t hstepA = (size_t)HALF * lda * 2, hstepB = (size_t)HALF * ldb * 2;
    const size_t tstepA = 2 * hstepA, tstepB = 2 * hstepB;
    const unsigned ldsw = (unsigned)wid * 1024u;
    const int aoff = lds_byte(wr * 64 + fr, fq * 8), boff = lds_byte(wc * 32 + fr, fq * 8);
#define PG8_SA(b, h) (((b) * 2 + (h)) * HTB)
#define PG8_SB(b, h) ((4 + (b) * 2 + (h)) * HTB)
#define PG8_STAGE(bufoff, gbase, voff) do { _Pragma("unroll") for (int _i = 0; _i < 2; ++_i) \
        __builtin_amdgcn_global_load_lds((const unsigned*)((const char*)(gbase) + (voff)[_i]), (PG8_LAS unsigned*)(lds + (bufoff) + ldsw + _i * 8192), 16, 0, 0); } while (0)
#define PG8_LDA(dst, b, h) do { _Pragma("unroll") for (int m = 0; m < 4; ++m) _Pragma("unroll") for (int k = 0; k < 2; ++k) dst[m][k] = *(const PG8_LAS bf16x8*)(lds + PG8_SA(b, h) + aoff + m * 2048 + k * 1024); } while (0)
#define PG8_LDB(dst, b, h) do { _Pragma("unroll") for (int n = 0; n < 2; ++n) _Pragma("unroll") for (int k = 0; k < 2; ++k) dst[n][k] = *(const PG8_LAS bf16x8*)(lds + PG8_SB(b, h) + boff + n * 2048 + k * 1024); } while (0)
#define PG8_MMA(ai, bj, At, Bt) do { __builtin_amdgcn_s_setprio(1); _Pragma("unroll") for (int m = 0; m < 4; ++m) _Pragma("unroll") for (int n = 0; n < 2; ++n) _Pragma("unroll") for (int k = 0; k < 2; ++k) \
        acc[ai][bj][m][n] = __builtin_amdgcn_mfma_f32_16x16x32_bf16(Bt[n][k], At[m][k], acc[ai][bj][m][n], 0, 0, 0); __builtin_amdgcn_s_setprio(0); } while (0)
#define PG8_WAIT_V(n) asm volatile("s_waitcnt vmcnt(" #n ")" ::: "memory")
#define PG8_WAIT_L(n) asm volatile("s_waitcnt lgkmcnt(" #n ")" ::: "memory")
#define PG8_BAR __builtin_amdgcn_s_barrier()
#define PG8_SCHED __builtin_amdgcn_sched_barrier(0)
    Unit cur, nxt; int ui = 0;
    if (!S.next(0, cur)) return;
    f32x4 acc[2][2][4][2];
#pragma unroll
    for (int a = 0; a < 2; ++a)
#pragma unroll
        for (int b = 0; b < 2; ++b)
#pragma unroll
            for (int m = 0; m < 4; ++m)
#pragma unroll
                for (int n = 0; n < 2; ++n) acc[a][b][m][n] = (f32x4){0.f, 0.f, 0.f, 0.f};
    bf16x8 At[4][2], B0[2][2], B1[2][2];
    const char* cA = (const char*)g.A + (size_t)cur.pm * tstepA + cur.offA; const char* cB = (const char*)g.Bt + (size_t)cur.pn * tstepB + cur.offB;
    S.a_ready(cur);
    if constexpr (SP2) {
        PG8_STAGE(PG8_SB(0, 0), cB, voffB); PG8_STAGE(PG8_SB(0, 1), cB + hstepB, voffB); PG8_STAGE(PG8_SA(0, 0), cA, voffA); PG8_STAGE(PG8_SA(0, 1), cA + hstepA, voffA);
        if (wr == 1) PG8_BAR;
        PG8_WAIT_V(2); PG8_BAR;
        PG8_STAGE(PG8_SB(1, 0), cB + kstep, voffB); PG8_STAGE(PG8_SA(1, 0), cA + kstep, voffA); PG8_STAGE(PG8_SB(1, 1), cB + hstepB + kstep, voffB);
        PG8_WAIT_V(6); PG8_BAR;
    } else {
        PG8_STAGE(PG8_SB(0, 0), cB, voffB); PG8_STAGE(PG8_SA(0, 0), cA, voffA); PG8_STAGE(PG8_SB(0, 1), cB + hstepB, voffB); PG8_STAGE(PG8_SA(0, 1), cA + hstepA, voffA);
        if (wr == 1) PG8_BAR;
        PG8_WAIT_V(4); PG8_BAR;
        PG8_STAGE(PG8_SB(1, 0), cB + kstep, voffB); PG8_STAGE(PG8_SA(1, 0), cA + kstep, voffA); PG8_STAGE(PG8_SB(1, 1), cB + hstepB + kstep, voffB);
        PG8_WAIT_V(6); PG8_BAR;
    }
    for (;;) {
        const bool has_next = S.next(ui + 1, nxt);
        const char* nA = has_next ? (const char*)g.A + (size_t)nxt.pm * tstepA + nxt.offA : cA; const char* nB = has_next ? (const char*)g.Bt + (size_t)nxt.pn * tstepB + nxt.offB : cB;
        for (int t = 0; t < nt; t += 2) {
            const bool last = (t == nt - 2);
            const char* a1 = cA + (size_t)(t + 1) * kstep;
            const char* a2 = last ? nA : cA + (size_t)(t + 2) * kstep; const char* b2 = last ? nB : cB + (size_t)(t + 2) * kstep;
            const char* a3 = a2 + kstep; const char* b3 = b2 + kstep;
            if (last && has_next) S.a_ready(nxt);
            if constexpr (SP2) {
            PG8_LDB(B0, 0, 0); PG8_LDB(B1, 0, 1); PG8_SCHED; PG8_LDA(At, 0, 0); PG8_STAGE(PG8_SA(1, 1), a1 + hstepA, voffA);
            PG8_WAIT_V(8); PG8_WAIT_L(0); PG8_BAR; PG8_MMA(0, 0, At, B0); PG8_MMA(0, 1, At, B1); PG8_BAR; PG8_SCHED;
            PG8_LDA(At, 0, 1); PG8_STAGE(PG8_SB(0, 0), b2, voffB); PG8_STAGE(PG8_SB(0, 1), b2 + hstepB, voffB); PG8_STAGE(PG8_SA(0, 0), a2, voffA);
            PG8_WAIT_V(8); PG8_WAIT_L(0); PG8_BAR; PG8_MMA(1, 0, At, B0); PG8_MMA(1, 1, At, B1); PG8_BAR; PG8_SCHED;
            PG8_LDB(B0, 1, 0); PG8_LDB(B1, 1, 1); PG8_SCHED; PG8_LDA(At, 1, 0); PG8_STAGE(PG8_SA(0, 1), a2 + hstepA, voffA);
            PG8_WAIT_V(8); PG8_WAIT_L(0); PG8_BAR; PG8_MMA(0, 0, At, B0); PG8_MMA(0, 1, At, B1); PG8_BAR; PG8_SCHED;
            PG8_LDA(At, 1, 1); PG8_STAGE(PG8_SB(1, 0), b3, voffB); PG8_STAGE(PG8_SB(1, 1), b3 + hstepB, voffB); PG8_STAGE(PG8_SA(1, 0), a3, voffA);
            PG8_WAIT_V(8); PG8_WAIT_L(0); PG8_BAR; PG8_MMA(1, 0, At, B0); PG8_MMA(1, 1, At, B1); PG8_BAR; PG8_SCHED;
            } else {
            PG8_LDB(B0, 0, 0); PG8_SCHED; PG8_LDA(At, 0, 0); PG8_STAGE(PG8_SA(1, 1), a1 + hstepA, voffA);
            PG8_WAIT_L(8); PG8_BAR; PG8_WAIT_L(0); PG8_MMA(0, 0, At, B0); PG8_BAR; PG8_SCHED;
            PG8_LDB(B1, 0, 1); PG8_STAGE(PG8_SB(0, 0), b2, voffB);
            PG8_BAR; PG8_WAIT_L(0); PG8_MMA(0, 1, At, B1); PG8_BAR;
            PG8_LDA(At, 0, 1); PG8_STAGE(PG8_SA(0, 0), a2, voffA);
            PG8_BAR; PG8_WAIT_L(0); PG8_MMA(1, 0, At, B0); PG8_BAR; PG8_SCHED;
            PG8_STAGE(PG8_SB(0, 1), b2 + hstepB, voffB);
            PG8_WAIT_V(6); PG8_BAR; PG8_MMA(1, 1, At, B1); PG8_BAR;
            PG8_LDB(B0, 1, 0); PG8_SCHED; PG8_LDA(At, 1, 0); PG8_STAGE(PG8_SA(0, 1), a2 + hstepA, voffA);
            PG8_WAIT_L(8); PG8_BAR; PG8_WAIT_L(0); PG8_MMA(0, 0, At, B0); PG8_BAR; PG8_SCHED;
            PG8_LDB(B1, 1, 1); PG8_STAGE(PG8_SB(1, 0), b3, voffB);
            PG8_BAR; PG8_WAIT_L(0); PG8_MMA(0, 1, At, B1); PG8_BAR;
            PG8_LDA(At, 1, 1); PG8_STAGE(PG8_SA(1, 0), a3, voffA);
            PG8_BAR; PG8_WAIT_L(0); PG8_MMA(1, 0, At, B0); PG8_BAR; PG8_SCHED;
            PG8_STAGE(PG8_SB(1, 1), b3 + hstepB, voffB);
            PG8_WAIT_V(6); PG8_BAR; PG8_MMA(1, 1, At, B1); PG8_BAR;
            }
        }
        if constexpr (ALIGN_EPI) { if (wr == 0) PG8_BAR; }
        if constexpr (!Epi::AFTER_DRAIN) { E(acc, cur, wr, wc, fr, fq); S.done(cur); }
        if (!has_next) break;
#pragma unroll
        for (int a = 0; a < 2; ++a)
#pragma unroll
            for (int b = 0; b < 2; ++b)
#pragma unroll
                for (int m = 0; m < 4; ++m)
#pragma unroll
                    for (int n = 0; n < 2; ++n) acc[a][b][m][n] = (f32x4){0.f, 0.f, 0.f, 0.f};
        cur = nxt; cA = nA; cB = nB; ++ui;
        if constexpr (ALIGN_EPI) { if (wr == 1) PG8_BAR; }
    }
    PG8_WAIT_V(0);
    if constexpr (!ALIGN_EPI) { if (wr == 0) PG8_BAR; }
    PG8_BAR;
    if constexpr (Epi::AFTER_DRAIN) { E.fused(acc, cur, wr, wc, fr, fq, lds, wid, lane); S.done(cur); }
#undef PG8_SA
#undef PG8_SB
#undef PG8_STAGE
#undef PG8_LDA
#undef PG8_LDB
#undef PG8_MMA
#undef PG8_WAIT_V
#undef PG8_WAIT_L
#undef PG8_BAR
#undef PG8_SCHED
}
}

constexpr int T = 8192, D = 2048, FF = 5504, NGU = 2 * FF, HD = 128, NSEL = 128, NCMP = 511;
constexpr int IN_COLS = 5656, INP = 5888;
constexpr int MEMT = 256, MEMH = 4, MEMD = 512;
constexpr float LN_EPS = 1e-5f, RMS_EPS = 1e-6f;
constexpr float ALPHA = 1.189207115002721f;
constexpr float LOG2E = 1.4426950408889634f;
constexpr float QSCALE = 0.08838834764831845f * LOG2E;
constexpr float MEMQSCALE = 0.04419417382415922f;
constexpr int NWAVES = 8, NTHREADS = 512;

constexpr size_t MiB = 1u << 20;
constexpr size_t WS_CTL = 0, CTL_ZERO_BYTES = 1 * MiB;
constexpr size_t CTL_BIAS1 = 512 * 1024;
constexpr size_t WS_ROPE = 1 * MiB;
constexpr size_t WS_GATES = 5 * MiB;
constexpr size_t WS_KCMP = 6 * MiB;
constexpr size_t WS_VCMPT = 6 * MiB + 256 * 1024;
constexpr size_t WS_W2T = 6 * MiB + 512 * 1024;
constexpr size_t WS_MEMB = 7 * MiB, WS_KMEM = 8 * MiB, WS_VT = 9 * MiB;
constexpr size_t WS_W1T = 10 * MiB;
constexpr size_t WS_PC = 14 * MiB;
constexpr size_t WS_WGU1 = 30 * MiB, WS_WD1 = 73 * MiB, WS_WGU2 = 95 * MiB, WS_WD2 = 138 * MiB, WS_WIN = 160 * MiB, WS_WOUT = 183 * MiB;
constexpr size_t WS_WQ = 191 * MiB, WS_WK = 199 * MiB, WS_WV = 207 * MiB, WS_WO = 215 * MiB;
constexpr size_t WS_X = 224 * MiB;
constexpr size_t WS_XB = 288 * MiB;
constexpr size_t WS_BIG = 320 * MiB, WS_END = 416 * MiB;
constexpr size_t BG_SBQ = 0, BG_SBK = 16 * MiB, BG_SBVT = 32 * MiB, BG_NQ = 48 * MiB, BG_CMPIN = 64 * MiB, BG_KSL = 72 * MiB, BG_VSLT = 76 * MiB, BG_KWN = 80 * MiB, BG_VWNT = 84 * MiB;
constexpr size_t BG_QC = 0, BG_S = 32 * MiB, BG_P = 64 * MiB;
static_assert((size_t)NGU * D * 2 <= WS_WD1 - WS_WGU1 && (size_t)D * FF * 2 <= WS_WGU2 - WS_WD1 && (size_t)INP * D * 2 <= WS_WOUT - WS_WIN && (size_t)T * FF * 2 <= WS_END - WS_BIG, "ws map");
constexpr int CW_TMO = 0, CW_BAR = 4096;

#define GAS __attribute__((address_space(1)))
#define LAS __attribute__((address_space(3)))
typedef unsigned short bf16;
typedef unsigned v4u __attribute__((ext_vector_type(4)));
typedef unsigned v2u __attribute__((ext_vector_type(2)));
typedef float f32x4 __attribute__((ext_vector_type(4)));
typedef float f32x16 __attribute__((ext_vector_type(16)));
typedef short bf16x8 __attribute__((ext_vector_type(8)));
typedef short s16x4 __attribute__((ext_vector_type(4)));
#define LDS_WAIT() asm volatile("s_waitcnt lgkmcnt(0)" ::: "memory")
using pg8::cvt_pk_bf16;
__device__ __forceinline__ int crow(int r, int h) { return (r & 3) + 8 * (r >> 2) + 4 * h; }
__device__ __forceinline__ float ex2(float x) { return __builtin_amdgcn_exp2f(x); }
__device__ __forceinline__ float lg2(float x) { return __builtin_amdgcn_logf(x); }

#define XB_TMO      128
#define XB_XCNT(j)  (256  + 64 * (j))
#define XB_XSUB(j)  (1280 + 64 * (j))
#define XB_XGEN(j)  (2304 + 64 * (j))
#define XB_TOP      3328
#define XB_TOPGEN   3392
#define XCD_BAR_WORDS 3456
#define XB_SPIN_CAP (1u << 20)
__device__ __forceinline__ unsigned xb_ld(unsigned* p)              { return __hip_atomic_load(p, __ATOMIC_RELAXED, __HIP_MEMORY_SCOPE_AGENT); }
__device__ __forceinline__ unsigned xb_add(unsigned* p, unsigned v) { return __hip_atomic_fetch_add(p, v, __ATOMIC_RELAXED, __HIP_MEMORY_SCOPE_AGENT); }
__device__ __forceinline__ unsigned xb_xcc_id() { return (unsigned)__builtin_amdgcn_s_getreg((3 << 11) | 20) & 0xFu; }
#define XB_SPIN(cond, bar) do { unsigned _sp = 0; while (cond) { __builtin_amdgcn_s_sleep(1); \
    if ((++_sp & 255u) == 0u) { if (xb_ld(&(bar)[XB_TMO])) break; if (_sp > XB_SPIN_CAP) { atomicAdd(&(bar)[XB_TMO], 1u); break; } } } } while (0)
struct XcdBarrier { unsigned* bar; unsigned x; volatile LAS unsigned* st; };
__device__ __forceinline__ XcdBarrier xcd_barrier_post(unsigned* bar, volatile LAS unsigned* st) {
    XcdBarrier b; b.bar = bar; b.x = xb_xcc_id(); b.st = st;
    if (threadIdx.x == 0) (void)xb_add(&bar[XB_XCNT(b.x)], 1u);
    return b;
}
__device__ __forceinline__ void xcd_barrier_complete(unsigned* bar, unsigned x, unsigned& nloc, unsigned& nx) {
    const unsigned G = gridDim.x * gridDim.y * gridDim.z;
    unsigned sum, cnt, mine, sp = 0u;
    for (;;) {
        sum = 0u; cnt = 0u; mine = 0u;
#pragma unroll
        for (unsigned j = 0; j < 16; ++j) { const unsigned c = xb_ld(&bar[XB_XCNT(j)]); sum += c; cnt += (c > 0u) ? 1u : 0u; mine = (j == x) ? c : mine; }
        if (sum == G) break;
        __builtin_amdgcn_s_sleep(1);
        if ((++sp & 255u) == 0u) { if (xb_ld(&bar[XB_TMO])) break; if (sp > XB_SPIN_CAP) { atomicAdd(&bar[XB_TMO], 1u); break; } }
    }
    nloc = mine > 0u ? mine : 1u; nx = cnt > 0u ? cnt : 1u;
}
__device__ __forceinline__ void xcd_barrier(const XcdBarrier& b) {
    asm volatile("s_waitcnt vmcnt(0)" ::: "memory");
    __syncthreads();
    if (threadIdx.x == 0) {
        unsigned* bar = b.bar;
        __builtin_amdgcn_s_waitcnt(0);
        unsigned nloc = b.st[0], nx = b.st[1];
        if (nloc == 0u) { xcd_barrier_complete(bar, b.x, nloc, nx); b.st[0] = nloc; b.st[1] = nx; }
        const unsigned old = xb_add(&bar[XB_XSUB(b.x)], 1u);
        const unsigned gen = old / nloc;
        if (old + 1u == (gen + 1u) * nloc) {
            __builtin_amdgcn_fence(__ATOMIC_RELEASE, "agent");
            asm volatile("s_waitcnt vmcnt(0)" ::: "memory");
            const unsigned og = xb_add(&bar[XB_TOP], 1u);
            const unsigned tg = og / nx;
            if (og + 1u == (tg + 1u) * nx) xb_add(&bar[XB_TOPGEN], 1u);
            else XB_SPIN(xb_ld(&bar[XB_TOPGEN]) == tg, bar);
            __builtin_amdgcn_fence(__ATOMIC_ACQUIRE, "agent");
            xb_add(&bar[XB_XGEN(b.x)], 1u);
            asm volatile("s_waitcnt vmcnt(0)" ::: "memory");
        } else {
            XB_SPIN(xb_ld(&bar[XB_XGEN(b.x)]) == gen, bar);
            __builtin_amdgcn_fence(__ATOMIC_ACQUIRE, "agent");
            asm volatile("s_waitcnt vmcnt(0)" ::: "memory");
        }
    }
    __syncthreads();
}

struct Args { const float* in[29]; float* out; unsigned char* ws; double invf[64]; int ph_lo, ph_hi, li, pad; };
struct Ctx {
    const float* const* in; float* out; unsigned char* ws; LAS unsigned char* lds;
    int tid, lane, wave, G, bid, gw, NGW;
};
__device__ __forceinline__ bf16* wsb(const Ctx& C, size_t off) { return (bf16*)(C.ws + off); }
__device__ __forceinline__ float* wsf(const Ctx& C, size_t off) { return (float*)(C.ws + off); }

__device__ __forceinline__ float wave_sum(float v) {
#pragma unroll
    for (int o = 1; o < 64; o <<= 1) v += __shfl_xor(v, o);
    return v;
}
__device__ __forceinline__ float wave_max(float v) {
#pragma unroll
    for (int o = 1; o < 64; o <<= 1) v = fmaxf(v, __shfl_xor(v, o));
    return v;
}

__device__ __forceinline__ void conv_item(const float* __restrict__ src, int ldsrc, int col4, int k0, bf16* dst, int ldd, int drow0, int lane) {
    const int ng = lane & 7, kg = lane >> 3;
    f32x4 v[8];
    if (col4 >= 0) {
#pragma unroll
        for (int i = 0; i < 8; ++i) v[i] = __builtin_nontemporal_load((const f32x4*)(src + (size_t)(k0 + 8 * kg + i) * ldsrc + col4)); }
    else {
#pragma unroll
        for (int i = 0; i < 8; ++i) v[i] = (f32x4){0.f, 0.f, 0.f, 0.f}; }
    bf16* dp = dst + (size_t)(drow0 + 4 * ng) * ldd + k0 + 8 * kg;
#pragma unroll
    for (int j = 0; j < 4; ++j) { v4u o; o.x = cvt_pk_bf16(v[0][j], v[1][j]); o.y = cvt_pk_bf16(v[2][j], v[3][j]); o.z = cvt_pk_bf16(v[4][j], v[5][j]); o.w = cvt_pk_bf16(v[6][j], v[7][j]);
        *(v4u*)(dp + (size_t)j * ldd) = o; }
}
__device__ __forceinline__ int win_srccol(int p) {
    if (p >= IN_COLS) return -1;
    const bool rope = (p >= 3072 && p < 4352) || (p >= 4608 && p < 4864) || (p >= 5120 && p < 5376);
    if (!rope) return p;
    const int hb = p & ~127, pp = p & 127, wc = pp >> 5, n = (pp >> 4) & 1, r = pp & 15;
    return hb + 64 * n + 16 * wc + r;
}
__device__ __forceinline__ int job_items(int job) { return (job == 0 || job == 2) ? 11008 : ((job == 1 || job == 3) ? 5504 : (job == 4 ? 5888 : (job <= 9 ? 2048 : (job <= 11 ? 512 : 16)))); }
__device__ __forceinline__ void conv_job(const Ctx& C, int job, int r) {
    const int lane = C.lane, ng4 = 4 * (lane & 7);
    if (job == 0 || job == 2) { const int f = job == 2; const int ndb = NGU / 32, db = r % ndb, kb = r / ndb, p0 = db * 32, tile = p0 >> 8, rr = p0 & 255;
        const float* src = C.in[rr < 128 ? (f ? 24 : 4) : (f ? 25 : 5)];
        conv_item(src, FF, tile * 128 + (rr & 127) + ng4, kb * 64, wsb(C, f ? WS_WGU2 : WS_WGU1), D, p0, lane); }
    else if (job == 1 || job == 3) { const int f = job == 3; const int db = r % 64, kb = r / 64;
        conv_item(C.in[f ? 26 : 6], D, db * 32 + ng4, kb * 64, wsb(C, f ? WS_WD2 : WS_WD1), FF, db * 32, lane); }
    else if (job == 4) { const int ndb = INP / 32, db = r % ndb, kb = r / ndb;
        conv_item(C.in[7], IN_COLS, win_srccol(db * 32 + ng4), kb * 64, wsb(C, WS_WIN), D, db * 32, lane); }
    else if (job <= 9) { const int w = job - 5, db = r % 64, kb = r / 64;
        const float* src = C.in[w == 0 ? 15 : 17 + w];
        const size_t dst = w == 0 ? WS_WOUT : (w == 1 ? WS_WQ : (w == 2 ? WS_WK : (w == 3 ? WS_WV : WS_WO)));
        conv_item(src, D, db * 32 + ng4, kb * 64, wsb(C, dst), D, db * 32, lane); }
    else if (job <= 11) { const int kv = job - 10, db = r % 8, kb = r / 8;
        conv_item(C.in[kv ? 12 : 9], 256, db * 32 + ng4, kb * 64, wsb(C, WS_W1T) + (size_t)kv * 256 * 4096, 4096, db * 32, lane); }
    else { const int kv = job - 12, db = r % 4, kb = r / 4;
        conv_item(C.in[kv ? 13 : 10], 128, db * 32 + ng4, kb * 64, wsb(C, WS_W2T) + (size_t)kv * 128 * 256, 256, db * 32, lane); }
}
template <unsigned MASK> __device__ __forceinline__ void conv_static(const Ctx& C, int w, int nw) {
    int base = 0;
#pragma unroll 1
    for (int job = 0; job < 14; ++job) { if (!((MASK >> job) & 1u)) continue; const int n = job_items(job);
        int first = (w - base % nw + nw) % nw;
#pragma unroll 1
        for (int r = first; r < n; r += nw) conv_job(C, job, r);
        base += n; }
}
template <unsigned MASK> __device__ __forceinline__ void conv_dynamic(const Ctx& C, unsigned* ctr) {
    int total = 0;
#pragma unroll
    for (int job = 0; job < 14; ++job) if ((MASK >> job) & 1u) total += job_items(job);
    for (;;) {
        unsigned idx = 0; if (C.lane == 0) idx = __hip_atomic_fetch_add(ctr, 8u, __ATOMIC_RELAXED, __HIP_MEMORY_SCOPE_AGENT);
        const int r0 = __builtin_amdgcn_readfirstlane((int)idx); if (r0 >= total) break;
#pragma unroll 1
        for (int k = 0; k < 8; ++k) { int r = r0 + k; if (r >= total) break;
            int job = 0;
#pragma unroll 1
            for (; job < 14; ++job) { if (!((MASK >> job) & 1u)) continue; const int n = job_items(job); if (r < n) break; r -= n; }
            conv_job(C, job, r); }
    }
}
constexpr unsigned JOBS_P0 = (1u << 0) | (1u << 7) | (1u << 8);
constexpr unsigned JOBS_P1 = (1u << 1) | (1u << 4) | (1u << 10) | (1u << 11) | (1u << 12) | (1u << 13);
constexpr unsigned JOBS_P7 = (1u << 2) | (1u << 3) | (1u << 5) | (1u << 6) | (1u << 9);
constexpr int CW_CONVCTR = 1024;

__device__ __forceinline__ void sincos_d(double r, float& c, float& s) {
    const double x = 0.25 * r, x2 = x * x;
    double sn = x * (1.0 + x2 * (-1.0 / 6 + x2 * (1.0 / 120 + x2 * (-1.0 / 5040 + x2 * (1.0 / 362880 + x2 * (-1.0 / 39916800 + x2 * (1.0 / 6227020800.0)))))));
    double cs = 1.0 + x2 * (-0.5 + x2 * (1.0 / 24 + x2 * (-1.0 / 720 + x2 * (1.0 / 40320 + x2 * (-1.0 / 3628800 + x2 * (1.0 / 479001600.0))))));
    double s2 = 2.0 * sn * cs, c2 = 1.0 - 2.0 * sn * sn;
    double s4 = 2.0 * s2 * c2, c4 = 1.0 - 2.0 * s2 * s2;
    c = (float)c4; s = (float)s4;
}
__device__ __forceinline__ void p0_prologue(const Ctx& C, const double* invf, bool first) {
    const int lane = C.lane;
    conv_static<JOBS_P0>(C, C.gw, C.NGW);
    { const int gt = C.gw * 64 + lane, NT = C.NGW * 64;
      const float* x = C.in[0]; bf16* xb = wsb(C, WS_XB);
      for (int i = gt; i < T * D / 8; i += NT) { const f32x4 a = *(const f32x4*)(x + (size_t)i * 8), b = *(const f32x4*)(x + (size_t)i * 8 + 4);
          v4u o; o.x = cvt_pk_bf16(a[0], a[1]); o.y = cvt_pk_bf16(a[2], a[3]); o.z = cvt_pk_bf16(b[0], b[1]); o.w = cvt_pk_bf16(b[2], b[3]); *(v4u*)(xb + (size_t)i * 8) = o; }
      const float* mem = C.in[1]; bf16* mb = wsb(C, WS_MEMB);
      for (int i = gt; i < MEMT * D / 8; i += NT) { const f32x4 a = *(const f32x4*)(mem + (size_t)i * 8), b = *(const f32x4*)(mem + (size_t)i * 8 + 4);
          v4u o; o.x = cvt_pk_bf16(a[0], a[1]); o.y = cvt_pk_bf16(a[2], a[3]); o.z = cvt_pk_bf16(b[0], b[1]); o.w = cvt_pk_bf16(b[2], b[3]); *(v4u*)(mb + (size_t)i * 8) = o; }
      float* rope = wsf(C, WS_ROPE);
      for (int i = gt; i < T * 64; i += NT) { const int pos = i >> 6, fi = i & 63; const double ang = (double)pos * invf[fi];
          const double n = rint(ang * 0.15915494309189535); const double rr = fma(-n, 6.283185307179586, ang) - n * 2.4492935982947064e-16;
          float c, s; sincos_d(rr, c, s); rope[2 * (size_t)i] = c; rope[2 * (size_t)i + 1] = s; }
    }
    if (first) for (int task = C.gw; task < 2 * 4 * 32; task += C.NGW) { const int kv = task >> 7, nch = (task >> 5) & 3, kch = task & 31, n = nch * 64 + lane;
        const float* pos = C.in[kv ? 11 : 8]; const float* w1 = C.in[kv ? 12 : 9]; float acc = 0.f;
#pragma unroll 8
        for (int k = kch * 128; k < kch * 128 + 128; ++k) acc += pos[k] * w1[(size_t)k * 256 + n];
        atomicAdd((float*)(C.ws + CTL_BIAS1) + kv * 256 + n, acc); }
}

__device__ __forceinline__ void ln_rows(const Ctx& C, const float* Y, const float* g, const float* b, float* X, bf16* Xb) {
    for (int row = C.gw; row < T; row += C.NGW) {
        const f32x4* yr = (const f32x4*)(Y + (size_t)row * D) + C.lane;
        f32x4 v[8]; float s = 0.f;
#pragma unroll
        for (int j = 0; j < 8; ++j) { v[j] = yr[64 * j]; s += (v[j][0] + v[j][1]) + (v[j][2] + v[j][3]); }
        const float mean = wave_sum(s) * (1.f / D); float s2 = 0.f;
#pragma unroll
        for (int j = 0; j < 8; ++j) { v[j] = v[j] - mean; s2 += (v[j][0] * v[j][0] + v[j][1] * v[j][1]) + (v[j][2] * v[j][2] + v[j][3] * v[j][3]); }
        const float rstd = 1.f / sqrtf(wave_sum(s2) * (1.f / D) + LN_EPS);
#pragma unroll
        for (int j = 0; j < 8; ++j) { const f32x4 gg = *((const f32x4*)g + C.lane + 64 * j), bb = *((const f32x4*)b + C.lane + 64 * j);
            const f32x4 o = v[j] * rstd * gg + bb;
            *((f32x4*)(X + (size_t)row * D) + C.lane + 64 * j) = o;
            if (Xb) *((v2u*)(Xb + (size_t)row * D) + C.lane + 64 * j) = pg8::pack4(o); }
    }
}
__device__ __forceinline__ void rms_rows(const Ctx& C, const float* O, const float* g, bf16* Yb) {
    const int half = C.lane >> 5, l5 = C.lane & 31;
    for (int row = C.gw; row < T; row += C.NGW) {
        const f32x4* orow = (const f32x4*)(O + (size_t)row * D + half * 1024) + l5;
        f32x4 v[8]; float s2 = 0.f;
#pragma unroll
        for (int j = 0; j < 8; ++j) { v[j] = orow[32 * j]; s2 += (v[j][0] * v[j][0] + v[j][1] * v[j][1]) + (v[j][2] * v[j][2] + v[j][3] * v[j][3]); }
#pragma unroll
        for (int o = 1; o < 32; o <<= 1) s2 += __shfl_xor(s2, o);
        const float rstd = 1.f / sqrtf(s2 * (1.f / 1024.f) + RMS_EPS);
#pragma unroll
        for (int j = 0; j < 8; ++j) { const f32x4 gg = *((const f32x4*)(g + half * 1024) + l5 + 32 * j);
            *((v2u*)(Yb + (size_t)row * D + half * 1024) + l5 + 32 * j) = pg8::pack4(v[j] * rstd * gg); }
    }
}
__device__ __forceinline__ void softmax_rows(const Ctx& C, const float* S, bf16* P) {
    for (int row = C.gw; row < MEMH * T; row += C.NGW) {
        const f32x4 v = *((const f32x4*)(S + (size_t)row * MEMT) + C.lane);
        const float m = wave_max(fmaxf(fmaxf(v[0], v[1]), fmaxf(v[2], v[3])));
        f32x4 e; float s = 0.f;
#pragma unroll
        for (int j = 0; j < 4; ++j) { e[j] = ex2((v[j] - m) * LOG2E); s += e[j]; }
        const float inv = 1.f / wave_sum(s);
        *((v2u*)(P + (size_t)row * MEMT) + C.lane) = pg8::pack4(e * inv);
    }
}

__device__ __forceinline__ float gelu_tanh(float x) {
    const float u = 0.7978845608028654f * (x + 0.044715f * x * x * x);
    const float th = 1.f - 2.f * __builtin_amdgcn_rcpf(1.f + ex2(2.f * LOG2E * u));
    return 0.5f * x * (1.f + th);
}
__device__ __forceinline__ void compress_l2(const Ctx& C) {
    const int lane = C.lane, r32 = lane & 31, h = lane >> 5;
    const float* PC = wsf(C, WS_PC); const float* bias1 = (const float*)(C.ws + CTL_BIAS1);
    for (int task = C.gw; task < 2 * 2 * 16 * 4; task += C.NGW) {
        const int nt = task & 3, rt = (task >> 2) & 15, g = (task >> 6) & 1, kv = task >> 7;
        const bf16* w2 = wsb(C, WS_W2T) + (size_t)kv * 128 * 256 + (size_t)(nt * 32 + r32) * 256 + 8 * h;
        f32x16 acc = {};
#pragma unroll 2
        for (int s = 0; s < 16; ++s) {
            const int k0 = 16 * s + 8 * h; f32x4 a0 = *(const f32x4*)(bias1 + kv * 256 + k0), a1 = *(const f32x4*)(bias1 + kv * 256 + k0 + 4);
#pragma unroll
            for (int kc = 0; kc < 8; ++kc) { const float* p = PC + ((((size_t)kc * 2 + kv) * 2 + g) * 512 + rt * 32 + r32) * 256 + k0;
                a0 = a0 + *(const f32x4*)p; a1 = a1 + *(const f32x4*)(p + 4); }
            v4u aw; aw.x = cvt_pk_bf16(gelu_tanh(a0[0]), gelu_tanh(a0[1])); aw.y = cvt_pk_bf16(gelu_tanh(a0[2]), gelu_tanh(a0[3]));
            aw.z = cvt_pk_bf16(gelu_tanh(a1[0]), gelu_tanh(a1[1])); aw.w = cvt_pk_bf16(gelu_tanh(a1[2]), gelu_tanh(a1[3]));
            const bf16x8 bw = *(const bf16x8*)(w2 + 16 * s);
            acc = __builtin_amdgcn_mfma_f32_32x32x16_bf16(__builtin_bit_cast(bf16x8, aw), bw, acc, 0, 0, 0);
        }
        if (kv == 0) { bf16* o = wsb(C, WS_KCMP) + (size_t)g * 512 * 128; const int d = nt * 32 + r32;
#pragma unroll
            for (int r = 0; r < 16; ++r) { const int row = rt * 32 + crow(r, h); o[(size_t)row * 128 + (((d >> 3) ^ (row & 15)) << 3) + (d & 7)] = row < NCMP ? (bf16)(cvt_pk_bf16(acc[r], 0.f) & 0xffffu) : (bf16)0; } }
        else { const int d = nt * 32 + r32; bf16* o = wsb(C, WS_VCMPT) + ((size_t)g * 16 + rt) * 128 * 32 + (size_t)d * 32;
#pragma unroll
            for (int gq = 0; gq < 4; ++gq) { const int rl = 8 * gq + 4 * h; f32x4 v = {acc[4 * gq], acc[4 * gq + 1], acc[4 * gq + 2], acc[4 * gq + 3]};
#pragma unroll
                for (int i = 0; i < 4; ++i) if (rt * 32 + rl + i >= NCMP) v[i] = 0.f;
                *(v2u*)(o + (((2 * (gq >> 1) + h) ^ ((d >> 2) & 3)) << 3) + (gq & 1) * 4) = pg8::pack4(v); } }
    }
}

__device__ __forceinline__ f32x16 qk_tile_g(const bf16* Ktile, const bf16x8 (&qf)[8], int r32, int h) {
    f32x16 st = {}; const bf16* kr = Ktile + (size_t)r32 * 128; const int sw = (r32 & 15) ^ h;
#pragma unroll
    for (int s = 0; s < 8; ++s) st = __builtin_amdgcn_mfma_f32_32x32x16_bf16(*(const bf16x8*)(kr + ((sw ^ (2 * s)) << 3)), qf[s], st, 0, 0, 0);
    return st;
}
__device__ __forceinline__ bf16x8 ones_frag(int h) { v4u v = {h == 0 ? 0x3F80u : 0u, 0u, 0u, 0u}; return __builtin_bit_cast(bf16x8, v); }
__device__ __forceinline__ bf16x8 neg_frag(float mref, int h) { v4u v = {h == 0 ? ((__builtin_bit_cast(unsigned, -mref)) >> 16) : 0u, 0u, 0u, 0u}; return __builtin_bit_cast(bf16x8, v); }
__device__ __forceinline__ float bf16_round(float x) { return __builtin_bit_cast(float, cvt_pk_bf16(x, 0.f) << 16); }
__device__ __forceinline__ f32x16 qk_tile_lr(const LAS unsigned char* kslot, const bf16x8 (&qf)[8], int r32, int h, bf16x8 mfrag) {
    f32x16 st = __builtin_amdgcn_mfma_f32_32x32x16_bf16(ones_frag(h), mfrag, f32x16{}, 0, 0, 0);
    const LAS unsigned char* kr = kslot + r32 * 256; const int sw = ((r32 & 15) ^ h) << 4;
#pragma unroll
    for (int s = 0; s < 4; ++s) st = __builtin_amdgcn_mfma_f32_32x32x16_bf16(*(const LAS bf16x8*)(kr + (sw ^ (s << 5))), qf[s], st, 0, 0, 0);
#if AT_SB
    __builtin_amdgcn_sched_barrier(0);
#endif
#pragma unroll
    for (int s = 4; s < 8; ++s) st = __builtin_amdgcn_mfma_f32_32x32x16_bf16(*(const LAS bf16x8*)(kr + (sw ^ (s << 5))), qf[s], st, 0, 0, 0);
    return st;
}
__device__ __forceinline__ f32x16 qk_tile_l(const LAS unsigned char* kslot, const bf16x8 (&qf)[8], int r32, int h) {
    f32x16 st = {}; const LAS unsigned char* kr = kslot + r32 * 256; const int sw = ((r32 & 15) ^ h) << 4;
#pragma unroll
    for (int s = 0; s < 8; ++s) st = __builtin_amdgcn_mfma_f32_32x32x16_bf16(*(const LAS bf16x8*)(kr + (sw ^ (s << 5))), qf[s], st, 0, 0, 0);
    return st;
}
__device__ __forceinline__ void pack_w(const float (&w)[16], bf16x8& b0, bf16x8& b1) {
    v4u p0, p1;
    p0.x = cvt_pk_bf16(w[0], w[1]); p0.y = cvt_pk_bf16(w[2], w[3]); p0.z = cvt_pk_bf16(w[4], w[5]); p0.w = cvt_pk_bf16(w[6], w[7]);
    p1.x = cvt_pk_bf16(w[8], w[9]); p1.y = cvt_pk_bf16(w[10], w[11]); p1.z = cvt_pk_bf16(w[12], w[13]); p1.w = cvt_pk_bf16(w[14], w[15]);
    b0 = __builtin_bit_cast(bf16x8, p0); b1 = __builtin_bit_cast(bf16x8, p1);
}
__device__ __forceinline__ void pv_tile_g(f32x16 (&o)[4], const bf16* Vtile, const float (&w)[16], int r32, int h) {
    bf16x8 b0, b1; pack_w(w, b0, b1);
#pragma unroll
    for (int db = 0; db < 4; ++db) { const int d = 32 * db + r32; const bf16* vr = Vtile + (size_t)d * 32; const int sw = ((d >> 2) & 3) ^ h;
        const bf16x8 f0 = *(const bf16x8*)(vr + (sw << 3)), f1 = *(const bf16x8*)(vr + ((sw ^ 2) << 3));
        o[db] = __builtin_amdgcn_mfma_f32_32x32x16_bf16(f0, b0, o[db], 0, 0, 0);
        o[db] = __builtin_amdgcn_mfma_f32_32x32x16_bf16(f1, b1, o[db], 0, 0, 0); }
}
__device__ __forceinline__ void pv_tile_lb(f32x16 (&o)[4], const LAS unsigned char* vslot, bf16x8 b0, bf16x8 b1, int r32, int h) {
    const int sw = (((r32 >> 2) & 3) ^ h) << 4;
#pragma unroll
    for (int db = 0; db < 4; ++db) { const LAS unsigned char* vr = vslot + (32 * db + r32) * 64; if (AT_SB && db == 2) __builtin_amdgcn_sched_barrier(0);
        const bf16x8 f0 = *(const LAS bf16x8*)(vr + sw), f1 = *(const LAS bf16x8*)(vr + (sw ^ 32));
        o[db] = __builtin_amdgcn_mfma_f32_32x32x16_bf16(f0, b0, o[db], 0, 0, 0);
        o[db] = __builtin_amdgcn_mfma_f32_32x32x16_bf16(f1, b1, o[db], 0, 0, 0); }
}
__device__ __forceinline__ void pv_tile_l(f32x16 (&o)[4], const LAS unsigned char* vslot, const float (&w)[16], int r32, int h) { bf16x8 b0, b1; pack_w(w, b0, b1); pv_tile_lb(o, vslot, b0, b1, r32, h); }

__device__ __forceinline__ void sb_item(const Ctx& C, int hd, int qt, float* Oatt) {
    const int lane = C.lane, c = lane & 31, h = lane >> 5, t = 32 * qt + c;
    const bf16* Qp = wsb(C, WS_BIG + BG_SBQ) + ((size_t)hd * T + t) * 128 + 8 * h;
    bf16x8 qf[8];
#pragma unroll
    for (int s = 0; s < 8; ++s) qf[s] = *(const bf16x8*)(Qp + 16 * s);
    const bf16* Kh = wsb(C, WS_BIG + BG_SBK) + (size_t)hd * T * 128; const bf16* Vh = wsb(C, WS_BIG + BG_SBVT) + (size_t)hd * T * 128;
    f32x16 o[4] = {}; float carry = 0.f;
    for (int kt = qt; kt >= 0; --kt) {
        const f32x16 st = qk_tile_g(Kh + (size_t)kt * 4096, qf, c, h);
        float l1m[16], lb[16], w[16];
#pragma unroll
        for (int r = 0; r < 16; ++r) { const int key = 32 * kt + crow(r, h); const float z = st[r];
            const float sp = fmaxf(z, 0.f) + lg2(1.f + ex2(-fabsf(z)));
            const bool valid = key < t; l1m[r] = valid ? -sp : 0.f; lb[r] = z - sp; }
        float G[4], PG[4], TT[4];
#pragma unroll
        for (int q = 0; q < 4; ++q) { G[q] = (l1m[4 * q] + l1m[4 * q + 1]) + (l1m[4 * q + 2] + l1m[4 * q + 3]); PG[q] = __shfl_xor(G[q], 32); TT[q] = G[q] + PG[q]; }
        const float SS[4] = {TT[3] + TT[2] + TT[1], TT[3] + TT[2], TT[3], 0.f};
#pragma unroll
        for (int q = 0; q < 4; ++q) { const float before = carry + SS[q] + (h == 0 ? PG[q] : 0.f);
            const float l3 = before, l2 = l3 + l1m[4 * q + 3], l1 = l2 + l1m[4 * q + 2], l0 = l1 + l1m[4 * q + 1];
            const float ls[4] = {l0, l1, l2, l3};
#pragma unroll
            for (int i = 0; i < 4; ++i) { const int r = 4 * q + i; const int key = 32 * kt + crow(r, h); w[r] = key < t ? ex2(lb[r] + ls[i]) : 0.f; } }
        carry += (TT[0] + TT[1]) + (TT[2] + TT[3]);
        pv_tile_g(o, Vh + (size_t)kt * 4096, w, c, h);
        if (__all(carry < -150.f)) break;
    }
    float* op = Oatt + (size_t)t * D + hd * 128 + 4 * h;
#pragma unroll
    for (int db = 0; db < 4; ++db)
#pragma unroll
        for (int q = 0; q < 4; ++q) *(f32x4*)(op + 32 * db + 8 * q) = (f32x4){o[db][4 * q], o[db][4 * q + 1], o[db][4 * q + 2], o[db][4 * q + 3]};
}

constexpr int AT_NS = 4, AT_SLOT = 16384, AT_RING = AT_NS * AT_SLOT;
#ifndef AT_PINGPONG
#define AT_PINGPONG 0
#endif
#ifndef AT_SB
#define AT_SB 1
#endif
__device__ __forceinline__ void glds16s(const void* sbase, unsigned voff, unsigned lds_dst) { unsigned keep;
    asm volatile("s_mov_b32 %0, m0\n\ts_mov_b32 m0, %3\n\ts_nop 0\n\tglobal_load_lds_dwordx4 %1, %2\n\ts_mov_b32 m0, %0" : "=&s"(keep) : "v"(voff), "s"(sbase), "s"(lds_dst) : "memory"); }
__device__ __forceinline__ const bf16* uni_ptr(const bf16* p) { const unsigned long long v = (unsigned long long)(uintptr_t)p;
    return (const bf16*)(uintptr_t)(((unsigned long long)(unsigned)__builtin_amdgcn_readfirstlane((int)(v >> 32)) << 32) | (unsigned)__builtin_amdgcn_readfirstlane((int)v)); }
#define AT_WAITBAR(N) asm volatile("s_waitcnt vmcnt(" #N ") lgkmcnt(0)\n\ts_barrier" ::: "memory")
template <bool HASV, class BodyA, class BodyB>
__device__ __forceinline__ void stream_tiles(unsigned ring0, const bf16* Kt0, const bf16* Vt0, int ntiles, int wave, int lane, BodyA bodyA, BodyB bodyB) {
    const bf16* kb = uni_ptr(Kt0); const bf16* vb = uni_ptr(Vt0);
    const unsigned voff = (unsigned)(wave * 1024 + lane * 16);
    const unsigned kdst = ring0 + wave * 1024, vdst = kdst + 8192;
    const int grp = wave >> 2;
    AT_WAITBAR(0);
#pragma unroll
    for (int j = 0; j < AT_NS - 1; ++j) if (j < ntiles) {
        glds16s(kb + (size_t)j * 4096, voff, (unsigned)__builtin_amdgcn_readfirstlane(kdst + j * AT_SLOT));
        if (HASV) glds16s(vb + (size_t)j * 4096, voff, (unsigned)__builtin_amdgcn_readfirstlane(vdst + j * AT_SLOT)); }
#if AT_PINGPONG
#pragma unroll 1
    for (int hs = 0; hs <= 2 * ntiles; ++hs) {
        const int i = hs >> 1;
        if (!(hs & 1)) {
            const int rem = ntiles - 1 - i;
            if (rem >= 2) { if (HASV) AT_WAITBAR(4); else AT_WAITBAR(2); }
            else if (rem == 1) { if (HASV) AT_WAITBAR(2); else AT_WAITBAR(1); }
            else AT_WAITBAR(0);
        } else {
            asm volatile("s_waitcnt lgkmcnt(0)\n\ts_barrier" ::: "memory");
            const int jn = i + AT_NS - 1;
            if (jn < ntiles) { const int sl = (jn & (AT_NS - 1)) * AT_SLOT;
                glds16s(kb + (size_t)jn * 4096, voff, (unsigned)__builtin_amdgcn_readfirstlane(kdst + sl));
                if (HASV) glds16s(vb + (size_t)jn * 4096, voff, (unsigned)__builtin_amdgcn_readfirstlane(vdst + sl)); }
        }
        if ((hs & 1) == grp) { if (i < ntiles) bodyA(i, (i & (AT_NS - 1)) * AT_SLOT); }
        else { const int ib = grp ? i - 1 : i; if (ib >= 0 && ib < ntiles) bodyB(ib, (ib & (AT_NS - 1)) * AT_SLOT); }
    }
#else
    (void)grp;
#pragma unroll 1
    for (int i = 0; i < ntiles; ++i) {
        const int rem = ntiles - 1 - i;
        if (rem >= 2) { if (HASV) AT_WAITBAR(4); else AT_WAITBAR(2); }
        else if (rem == 1) { if (HASV) AT_WAITBAR(2); else AT_WAITBAR(1); }
        else AT_WAITBAR(0);
        const int jn = i + AT_NS - 1;
        if (jn < ntiles) { const int sl = (jn & (AT_NS - 1)) * AT_SLOT;
            glds16s(kb + (size_t)jn * 4096, voff, (unsigned)__builtin_amdgcn_readfirstlane(kdst + sl));
            if (HASV) glds16s(vb + (size_t)jn * 4096, voff, (unsigned)__builtin_amdgcn_readfirstlane(vdst + sl)); }
        bodyA(i, (i & (AT_NS - 1)) * AT_SLOT); bodyB(i, (i & (AT_NS - 1)) * AT_SLOT);
    }
#endif
}

constexpr float AT_THR = 10.f;
__device__ __forceinline__ float max3f(float a, float b, float c) { return fmaxf(fmaxf(a, b), c); }
__device__ __forceinline__ void xhalf_pair(float v, float& lo, float& hi) { unsigned a = __builtin_bit_cast(unsigned, v), b2;
    asm volatile("s_nop 1\n\tv_mov_b32 %1, %0\n\ts_nop 1\n\tv_permlane32_swap_b32 %0, %1\n\ts_nop 1" : "+v"(a), "=&v"(b2));
    lo = __builtin_bit_cast(float, a); hi = __builtin_bit_cast(float, b2); }
__device__ __forceinline__ float xhalf_max(float v) { float lo, hi; xhalf_pair(v, lo, hi); return fmaxf(lo, hi); }
__device__ __forceinline__ float xhalf_sum(float v) { float lo, hi; xhalf_pair(v, lo, hi); return lo + hi; }
template <bool MASKED, class MaskF>
__device__ __forceinline__ void flash_B(f32x16& st, float& mref, float& l, f32x16 (&o)[4], const LAS unsigned char* vslot, int c, int h, bool lane_on, MaskF valid) {
    if (MASKED) {
#pragma unroll
        for (int r = 0; r < 16; ++r) st[r] = valid(r) ? st[r] : -INFINITY; }
    float tm = max3f(st[0], st[1], st[2]);
#pragma unroll
    for (int r = 3; r < 15; r += 2) tm = max3f(tm, st[r], st[r + 1]);
    tm = fmaxf(tm, st[15]);
    tm = lane_on ? tm : -INFINITY;
    tm = xhalf_max(tm);
    const bool trig = tm > AT_THR || (tm < -AT_THR && tm > -INFINITY);
    if (__any(trig)) {
        const float ltot = xhalf_sum(l); const bool need = tm > AT_THR || (trig && ltot == 0.f);
        const float mnew = need ? bf16_round(mref + tm) : mref, dl = mnew - mref, f = ex2(-dl);
        mref = mnew; l *= f;
#pragma unroll
        for (int r = 0; r < 16; ++r) st[r] -= dl;
#pragma unroll
        for (int db = 0; db < 4; ++db) o[db] = o[db] * f;
    }
    float w[16]; float ps = 0.f;
#pragma unroll
    for (int r = 0; r < 16; ++r) { w[r] = ex2(st[r]); ps += w[r]; }
    l += lane_on ? ps : 0.f;
    bf16x8 b0, b1; pack_w(w, b0, b1);
    if (!lane_on) { b0 = bf16x8{}; b1 = bf16x8{}; }
    pv_tile_lb(o, vslot, b0, b1, c, h);
}

constexpr int AB_SLOT = 32768, AB_NS = 4;
template <class Body>
__device__ __forceinline__ void stream_blocks(unsigned ring0, const bf16* Kb0, const bf16* Vb0, int nblocks, int wave, int lane, Body body) {
    const bf16* kb = uni_ptr(Kb0); const bf16* vb = uni_ptr(Vb0);
    const unsigned voff = (unsigned)(wave * 1024 + lane * 16);
    const unsigned dst = ring0 + wave * 1024;
#define AB_ISSUE(j, sl) do { const bf16* ks_ = kb + (size_t)(j) * 8192; const bf16* vs_ = vb + (size_t)(j) * 8192; const unsigned d_ = (unsigned)__builtin_amdgcn_readfirstlane(dst + (sl)); \
        glds16s(ks_, voff, d_); glds16s(ks_ + 4096, voff, d_ + 8192); glds16s(vs_, voff, d_ + 16384); glds16s(vs_ + 4096, voff, d_ + 24576); } while (0)
    AT_WAITBAR(0);
#pragma unroll
    for (int j = 0; j < AB_NS - 1; ++j) if (j < nblocks) AB_ISSUE(j, j * AB_SLOT);
#pragma unroll 1
    for (int i = 0; i < nblocks; ++i) {
        const int rem = nblocks - 1 - i;
        if (rem >= 2) AT_WAITBAR(8); else if (rem == 1) AT_WAITBAR(4); else AT_WAITBAR(0);
        const int jn = i + AB_NS - 1;
        if (jn < nblocks) AB_ISSUE(jn, (jn & (AB_NS - 1)) * AB_SLOT);
        body(i, (i & (AB_NS - 1)) * AB_SLOT);
    }
#undef AB_ISSUE
}
#define FB_SB() __builtin_amdgcn_sched_barrier(0)
#define FB_MF(acc, a, b) acc = __builtin_amdgcn_mfma_f32_32x32x16_bf16(a, b, acc, 0, 0, 0)
#define FB_KF(tile, s) (*(const LAS bf16x8*)(slot + (tile) * 8192 + c * 256 + (swk ^ ((s) << 5))))
#define FB_VF(tile, db, k) (*(const LAS bf16x8*)(slot + 16384 + (tile) * 8192 + (32 * (db) + c) * 64 + (swv ^ ((k) << 5))))
template <class MaskF>
__device__ __forceinline__ void flash_block(float& mref, float& l, f32x16 (&o)[4], const bf16x8 (&qf)[8], const LAS unsigned char* slot, int c, int h, bool lane_on, bool MASKED  , MaskF valid) {
    const int swk = ((c & 15) ^ h) << 4, swv = (((c >> 2) & 3) ^ h) << 4;
    f32x16 s0, s1; bf16x8 ka[4];
#pragma unroll
    for (int s = 0; s < 4; ++s) ka[s] = FB_KF(0, s);
    s0 = __builtin_amdgcn_mfma_f32_32x32x16_bf16(ones_frag(h), neg_frag(mref, h), f32x16{}, 0, 0, 0);
#pragma unroll
    for (int s = 0; s < 4; ++s) FB_MF(s0, ka[s], qf[s]);
    FB_SB();
#pragma unroll
    for (int s = 0; s < 4; ++s) ka[s] = FB_KF(0, 4 + s);
#pragma unroll
    for (int s = 0; s < 4; ++s) FB_MF(s0, ka[s], qf[4 + s]);
    FB_SB();
#pragma unroll
    for (int s = 0; s < 4; ++s) ka[s] = FB_KF(1, s);
    if (MASKED) {
#pragma unroll
        for (int r = 0; r < 16; ++r) s0[r] = valid(0, r) ? s0[r] : -INFINITY; }
    s1 = __builtin_amdgcn_mfma_f32_32x32x16_bf16(ones_frag(h), neg_frag(mref, h), f32x16{}, 0, 0, 0);
    float t0 = max3f(s0[0], s0[1], s0[2]); t0 = max3f(t0, s0[3], s0[4]); FB_SB();
    FB_MF(s1, ka[0], qf[0]); t0 = max3f(t0, s0[5], s0[6]); t0 = max3f(t0, s0[7], s0[8]); t0 = max3f(t0, s0[9], s0[10]); FB_SB();
    FB_MF(s1, ka[1], qf[1]); t0 = max3f(t0, s0[11], s0[12]); t0 = max3f(t0, s0[13], s0[14]); t0 = fmaxf(t0, s0[15]); t0 = lane_on ? t0 : -INFINITY; FB_SB();
    FB_MF(s1, ka[2], qf[2]); t0 = xhalf_max(t0); FB_SB();
    FB_MF(s1, ka[3], qf[3]); FB_SB();
#pragma unroll
    for (int s = 0; s < 4; ++s) ka[s] = FB_KF(1, 4 + s);
    float pend = 0.f;
    { const bool trig = t0 > AT_THR || (t0 < -AT_THR && t0 > -INFINITY);
      if (__any(trig)) { const float ltot = xhalf_sum(l); const bool need = t0 > AT_THR || (trig && ltot == 0.f);
          const float mnew = need ? bf16_round(mref + t0) : mref, dl = mnew - mref, f = ex2(-dl); mref = mnew; l *= f; pend = dl;
#pragma unroll
          for (int r = 0; r < 16; ++r) s0[r] -= dl;
#pragma unroll
          for (int db = 0; db < 4; ++db) o[db] = o[db] * f; } }
    FB_SB();
    float ps = 0.f; v4u p0, p1;
    FB_MF(s1, ka[0], qf[4]);
#pragma unroll
    for (int r = 0; r < 4; ++r) { s0[r] = ex2(s0[r]); ps += s0[r]; }
    p0.x = cvt_pk_bf16(s0[0], s0[1]); p0.y = cvt_pk_bf16(s0[2], s0[3]); FB_SB();
    FB_MF(s1, ka[1], qf[5]);
#pragma unroll
    for (int r = 4; r < 8; ++r) { s0[r] = ex2(s0[r]); ps += s0[r]; }
    p0.z = cvt_pk_bf16(s0[4], s0[5]); p0.w = cvt_pk_bf16(s0[6], s0[7]); FB_SB();
    FB_MF(s1, ka[2], qf[6]);
#pragma unroll
    for (int r = 8; r < 12; ++r) { s0[r] = ex2(s0[r]); ps += s0[r]; }
    p1.x = cvt_pk_bf16(s0[8], s0[9]); p1.y = cvt_pk_bf16(s0[10], s0[11]); FB_SB();
    FB_MF(s1, ka[3], qf[7]);
#pragma unroll
    for (int r = 12; r < 16; ++r) { s0[r] = ex2(s0[r]); ps += s0[r]; }
    p1.z = cvt_pk_bf16(s0[12], s0[13]); p1.w = cvt_pk_bf16(s0[14], s0[15]); FB_SB();
    if (!lane_on) { p0 = v4u{0u, 0u, 0u, 0u}; p1 = v4u{0u, 0u, 0u, 0u}; ps = 0.f; }
    l += ps;
    ka[0] = FB_VF(0, 0, 0); ka[1] = FB_VF(0, 0, 1); ka[2] = FB_VF(0, 1, 0); ka[3] = FB_VF(0, 1, 1);
    if (MASKED) {
#pragma unroll
        for (int r = 0; r < 16; ++r) s1[r] = valid(1, r) ? s1[r] : -INFINITY; }
    float t1 = max3f(s1[0], s1[1], s1[2]);
#pragma unroll
    for (int r = 3; r < 15; r += 2) t1 = max3f(t1, s1[r], s1[r + 1]);
    t1 = fmaxf(t1, s1[15]); t1 = lane_on ? t1 : -INFINITY; t1 = xhalf_max(t1) - pend;
    { const bool trig = t1 > AT_THR || (t1 < -AT_THR && t1 > -INFINITY);
      if (__any(trig || pend != 0.f)) { const float ltot = xhalf_sum(l); const bool need = t1 > AT_THR || (trig && ltot == 0.f);
          const float mnew = need ? bf16_round(mref + t1) : mref, dl = mnew - mref, f = ex2(-dl), d1 = dl + pend; mref = mnew; l *= f;
#pragma unroll
          for (int r = 0; r < 16; ++r) s1[r] -= d1;
#pragma unroll
          for (int db = 0; db < 4; ++db) o[db] = o[db] * f; } }
    FB_SB();
    const bf16x8 b00 = __builtin_bit_cast(bf16x8, p0), b01 = __builtin_bit_cast(bf16x8, p1);
    float pt = 0.f; v4u q0, q1;
    FB_MF(o[0], ka[0], b00);
#pragma unroll
    for (int r = 0; r < 2; ++r) { s1[r] = ex2(s1[r]); pt += s1[r]; }
    q0.x = cvt_pk_bf16(s1[0], s1[1]); FB_SB();
    FB_MF(o[1], ka[2], b00);
#pragma unroll
    for (int r = 2; r < 4; ++r) { s1[r] = ex2(s1[r]); pt += s1[r]; }
    q0.y = cvt_pk_bf16(s1[2], s1[3]); FB_SB();
    FB_MF(o[0], ka[1], b01);
#pragma unroll
    for (int r = 4; r < 6; ++r) { s1[r] = ex2(s1[r]); pt += s1[r]; }
    q0.z = cvt_pk_bf16(s1[4], s1[5]); FB_SB();
    FB_MF(o[1], ka[3], b01);
#pragma unroll
    for (int r = 6; r < 8; ++r) { s1[r] = ex2(s1[r]); pt += s1[r]; }
    q0.w = cvt_pk_bf16(s1[6], s1[7]); FB_SB();
    ka[0] = FB_VF(0, 2, 0); ka[1] = FB_VF(0, 2, 1); ka[2] = FB_VF(0, 3, 0); ka[3] = FB_VF(0, 3, 1);
#pragma unroll
    for (int r = 8; r < 10; ++r) { s1[r] = ex2(s1[r]); pt += s1[r]; }
    q1.x = cvt_pk_bf16(s1[8], s1[9]); FB_SB();
    FB_MF(o[2], ka[0], b00);
#pragma unroll
    for (int r = 10; r < 12; ++r) { s1[r] = ex2(s1[r]); pt += s1[r]; }
    q1.y = cvt_pk_bf16(s1[10], s1[11]); FB_SB();
    FB_MF(o[3], ka[2], b00);
#pragma unroll
    for (int r = 12; r < 14; ++r) { s1[r] = ex2(s1[r]); pt += s1[r]; }
    q1.z = cvt_pk_bf16(s1[12], s1[13]); FB_SB();
    FB_MF(o[2], ka[1], b01);
#pragma unroll
    for (int r = 14; r < 16; ++r) { s1[r] = ex2(s1[r]); pt += s1[r]; }
    q1.w = cvt_pk_bf16(s1[14], s1[15]); FB_SB();
    FB_MF(o[3], ka[3], b01); FB_SB();
    if (!lane_on) { q0 = v4u{0u, 0u, 0u, 0u}; q1 = v4u{0u, 0u, 0u, 0u}; pt = 0.f; }
    l += pt;
    const bf16x8 b10 = __builtin_bit_cast(bf16x8, q0), b11 = __builtin_bit_cast(bf16x8, q1);
    ka[0] = FB_VF(1, 0, 0); ka[1] = FB_VF(1, 0, 1); ka[2] = FB_VF(1, 1, 0); ka[3] = FB_VF(1, 1, 1);
    FB_MF(o[0], ka[0], b10); FB_MF(o[1], ka[2], b10); FB_MF(o[0], ka[1], b11); FB_MF(o[1], ka[3], b11); FB_SB();
    ka[0] = FB_VF(1, 2, 0); ka[1] = FB_VF(1, 2, 1); ka[2] = FB_VF(1, 3, 0); ka[3] = FB_VF(1, 3, 1);
    FB_MF(o[2], ka[0], b10); FB_MF(o[3], ka[2], b10); FB_MF(o[2], ka[1], b11); FB_MF(o[3], ka[3], b11); FB_SB();
}
#undef FB_SB
#undef FB_MF
#undef FB_KF
#undef FB_VF

constexpr int NSA_WLDS = 8192;
static_assert(AT_RING + NWAVES * NSA_WLDS <= 131072 && 132096 + NWAVES * 128 <= 147200 && AB_NS * AB_SLOT <= 131072, "attention LDS map (selection masks at 132096, MISC words at 147200)");
__device__ __forceinline__ void nsa_unit(const Ctx& C, int g, int qt, float* Oatt, int mode = 31) {
    const int lane = C.lane, wave = C.wave, c = lane & 31, h = lane >> 5, qi = c >> 2, hh = c & 3, head = 4 * g + hh, t0 = 64 * qt + 8 * wave, t = t0 + qi;
    const LAS unsigned char* ring = C.lds; const unsigned ring0 = (unsigned)(uintptr_t)C.lds;
    LAS unsigned char* wl = C.lds + AT_RING + wave * NSA_WLDS;
    LAS float* impA = (LAS float*)wl; LAS float* impB = impA + 8 * 128; LAS unsigned long long* selm = (LAS unsigned long long*)(C.lds + 132096 + wave * 128);
    const bf16* Qp = wsb(C, WS_BIG + BG_NQ) + ((size_t)head * T + t) * 128 + 8 * h;
    bf16x8 qf[8];
#pragma unroll
    for (int s = 0; s < 8; ++s) qf[s] = *(const bf16x8*)(Qp + 16 * s);
#define NSA_OP() (Oatt + (size_t)t * D + 1024 + head * 128 + 4 * h)
#define NSA_GATE(k) (wsf(C, WS_GATES)[(size_t)t * 24 + head * 3 + (k)])
#pragma unroll
    for (int i = 0; i < 32; ++i) impA[i * 64 + lane] = 0.f;
    const int tq = 64 * qt + 63, ncmp = (tq >= 31) ? ((tq - 31) >> 4) + 1 : 0, ntile = (ncmp + 31) >> 5;
    const int cmax = (t >= 31) ? ((t - 31) >> 4) : -1;
    const int wcmax = (t0 + 7 >= 31) ? ((t0 + 7 - 31) >> 4) : -1;
    const bf16* Kc = wsb(C, WS_KCMP) + (size_t)g * 512 * 128; const bf16* Vc = wsb(C, WS_VCMPT) + (size_t)g * 16 * 128 * 32;
    if (ntile > 0 && (mode & 1)) {
        const int wcmin = (t0 >= 31) ? ((t0 - 31) >> 4) : -1;
        float mref = 0.f, l = 0.f;
        f32x16 st; bool act = false;
        stream_tiles<false>(ring0, Kc, Vc, ntile, wave, lane,
            [&](int i, int so) { act = 32 * i <= wcmax; if (act) st = qk_tile_lr(ring + so, qf, c, h, neg_frag(mref, h)); },
            [&](int i, int) {
            if (32 * i > wcmax) return;
            if (32 * i + 31 > wcmin) {
#pragma unroll
                for (int r = 0; r < 16; ++r) st[r] = (32 * i + crow(r, h) <= cmax) ? st[r] : -INFINITY; }
            float tm = max3f(st[0], st[1], st[2]);
#pragma unroll
            for (int r = 3; r < 15; r += 2) tm = max3f(tm, st[r], st[r + 1]);
            tm = fmaxf(tm, st[15]); tm = xhalf_max(tm);
            const bool trig = tm > AT_THR || (tm < -AT_THR && tm > -INFINITY);
            if (__any(trig)) { const float ltot = xhalf_sum(l); const bool need = tm > AT_THR || (trig && ltot == 0.f);
                const float mnew = need ? bf16_round(mref + tm) : mref, dl = mnew - mref; mref = mnew; l *= ex2(-dl);
#pragma unroll
                for (int r = 0; r < 16; ++r) st[r] -= dl; }
            float ps = 0.f;
#pragma unroll
            for (int r = 0; r < 16; ++r) ps += ex2(st[r]);
            l += ps; });
        l = xhalf_sum(l);
        const float nrm = l > 0.f ? -(mref + lg2(l)) : -INFINITY;
        f32x16 o[4] = {};
        stream_tiles<true>(ring0, Kc, Vc, ntile, wave, lane,
            [&](int i, int so) { if (32 * i <= wcmax) st = qk_tile_l(ring + so, qf, c, h); },
            [&](int i, int so) {
            if (32 * i > wcmax) return;
            float w[16];
            if (32 * i + 31 > wcmin) {
#pragma unroll
                for (int r = 0; r < 16; ++r) w[r] = (32 * i + crow(r, h) <= cmax) ? ex2(st[r] + nrm) : 0.f; }
            else {
#pragma unroll
                for (int r = 0; r < 16; ++r) w[r] = ex2(st[r] + nrm); }
#pragma unroll
            for (int q = 0; q < 4; ++q) { float a = (w[4 * q] + w[4 * q + 1]) + (w[4 * q + 2] + 0.5f * w[4 * q + 3]), b = 0.5f * w[4 * q + 3];
                a += __shfl_xor(a, 1); a += __shfl_xor(a, 2); b += __shfl_xor(b, 1); b += __shfl_xor(b, 2);
                const int n = 8 * i + 2 * q + h;
                if (hh == 0) { impA[qi * 128 + n] = a; if (n + 1 < NSEL) impB[qi * 128 + n + 1] = b; } }
            pv_tile_l(o, ring + so + 8192, w, c, h); });
        if (mode & 16) { float* op = NSA_OP(); const float g_c = NSA_GATE(0);
#pragma unroll
        for (int db = 0; db < 4; ++db)
#pragma unroll
            for (int q = 0; q < 4; ++q) *(f32x4*)(op + 32 * db + 8 * q) = (f32x4){o[db][4 * q], o[db][4 * q + 1], o[db][4 * q + 2], o[db][4 * q + 3]} * g_c; }
    } else if (mode & 16) {
        float* op = NSA_OP();
#pragma unroll
        for (int db = 0; db < 4; ++db)
#pragma unroll
            for (int q = 0; q < 4; ++q) *(f32x4*)(op + 32 * db + 8 * q) = (f32x4){0.f, 0.f, 0.f, 0.f};
    }
    const int nb = qt;
    LDS_WAIT(); asm volatile("" ::: "memory");
    for (int q = 0; q < 8; ++q) {
        unsigned long long mlo = 0ull, mhi = 0ull;
        if (nb < 16 || !(mode & 2)) { mlo = nb < 63 ? (2ull << nb) - 1ull : ~0ull; mhi = nb < 64 ? 0ull : (nb < 127 ? (2ull << (nb - 64)) - 1ull : ~0ull); }
        else {
            float v0 = impA[q * 128 + lane] + impB[q * 128 + lane], v1 = impA[q * 128 + 64 + lane] + impB[q * 128 + 64 + lane];
            const int i0 = lane, i1 = lane + 64;
            v0 = (i0 == 0 || i0 == nb) ? INFINITY : (i0 <= nb ? v0 : -INFINITY);
            v1 = (i1 == nb) ? INFINITY : (i1 <= nb ? v1 : -INFINITY);
            for (int rd = 0; rd < 16; ++rd) {
                const float mx = wave_max(fmaxf(v0, v1));
                const unsigned long long b0 = __ballot(v0 == mx), b1 = __ballot(v1 == mx);
                int sel;
                if (b0) { sel = __ffsll((long long)b0) - 1; mlo |= 1ull << sel; if (lane == sel) v0 = -INFINITY; }
                else { sel = __ffsll((long long)b1) - 1; mhi |= 1ull << sel; if (lane == sel) v1 = -INFINITY; }
            }
        }
        if (lane == 0) { selm[2 * q] = mlo; selm[2 * q + 1] = mhi; }
    }
    LDS_WAIT(); asm volatile("" ::: "memory");
    unsigned long long u_lo = 0ull, u_hi = 0ull;
#pragma unroll
    for (int q = 0; q < 8; ++q) { u_lo |= selm[2 * q]; u_hi |= selm[2 * q + 1]; }
    u_lo = ((unsigned long long)__builtin_amdgcn_readfirstlane((unsigned)(u_lo >> 32)) << 32) | (unsigned)__builtin_amdgcn_readfirstlane((unsigned)u_lo);
    u_hi = ((unsigned long long)__builtin_amdgcn_readfirstlane((unsigned)(u_hi >> 32)) << 32) | (unsigned)__builtin_amdgcn_readfirstlane((unsigned)u_hi);
    if (mode & 4) {
        const bf16* Ks = wsb(C, WS_BIG + BG_KSL) + (size_t)g * T * 128; const bf16* Vs = wsb(C, WS_BIG + BG_VSLT) + (size_t)g * T * 128;
        float mref = 0.f, l = 0.f; f32x16 o[4] = {};
        stream_blocks(ring0, Ks, Vs, nb + 1, wave, lane, [&](int n, int so) {
            const unsigned long long uu = n < 64 ? u_lo : u_hi;
            if (!((uu >> (n & 63)) & 1ull)) return;
            const bool sel = (selm[2 * qi + (n >> 6)] >> (n & 63)) & 1ull;
            flash_block(mref, l, o, qf, ring + so, c, h, sel, n == nb, [&](int tt, int r) { return 64 * n + 32 * tt + crow(r, h) <= t; }); });
        l = xhalf_sum(l);
        const float sc = l > 0.f ? NSA_GATE(1) / l : 0.f; float* op = NSA_OP();
        if (mode & 16)
#pragma unroll
        for (int db = 0; db < 4; ++db)
#pragma unroll
            for (int q = 0; q < 4; ++q) { f32x4* p = (f32x4*)(op + 32 * db + 8 * q); *p = *p + (f32x4){o[db][4 * q], o[db][4 * q + 1], o[db][4 * q + 2], o[db][4 * q + 3]} * sc; }
    }
    if (mode & 8) {
        const bf16* Kw = wsb(C, WS_BIG + BG_KWN) + (size_t)g * T * 128; const bf16* Vw = wsb(C, WS_BIG + BG_VWNT) + (size_t)g * T * 128;
        float mref = 0.f, l = 0.f; f32x16 o[4] = {};
        const int blo = (64 * qt - 511 > 0 ? 64 * qt - 511 : 0) >> 6, bhi = qt;
        stream_blocks(ring0, Kw + (size_t)blo * 8192, Vw + (size_t)blo * 8192, bhi - blo + 1, wave, lane, [&](int i, int so) {
            const int key0 = 64 * (blo + i);
            if (key0 + 63 < t0 - 511 || key0 > t0 + 7) return;
            flash_block(mref, l, o, qf, ring + so, c, h, true, !(key0 >= t0 + 7 - 511 && key0 + 63 <= t0)  ,
                        [&](int tt, int r) { const int key = key0 + 32 * tt + crow(r, h); return key <= t && key > t - 512; }); });
        l = xhalf_sum(l);
        const float sc = l > 0.f ? NSA_GATE(2) / l : 0.f; float* op = NSA_OP();
        if (mode & 16)
#pragma unroll
        for (int db = 0; db < 4; ++db)
#pragma unroll
            for (int q = 0; q < 4; ++q) { f32x4* p = (f32x4*)(op + 32 * db + 8 * q); *p = *p + (f32x4){o[db][4 * q], o[db][4 * q + 1], o[db][4 * q + 2], o[db][4 * q + 3]} * sc; }
    }
    AT_WAITBAR(0);
#undef NSA_OP
#undef NSA_GATE
}
constexpr int CW_SBCTR = 2048;

constexpr int RING_BYTES = 131072, LDS_BYTES = 147456, MISC_OFF = LDS_BYTES - 256;
constexpr int N_PHASES = 20;
#ifndef MK_ONE_LAUNCH
#define MK_ONE_LAUNCH 1
#endif

__global__ void __launch_bounds__(NTHREADS, 2) fwd_kernel(Args args) {
    extern __shared__ __attribute__((aligned(16))) unsigned char lds_raw[];
    Ctx C;
    C.in = args.in; C.out = args.out; C.ws = args.ws; C.lds = (LAS unsigned char*)lds_raw;
    C.tid = threadIdx.x; C.lane = C.tid & 63; C.wave = __builtin_amdgcn_readfirstlane(C.tid >> 6);
    C.G = gridDim.x; C.bid = blockIdx.x; C.gw = C.bid * NWAVES + C.wave; C.NGW = C.G * NWAVES;
    volatile LAS unsigned* MISC = (volatile LAS unsigned*)(C.lds + MISC_OFF);
    for (int u = C.tid; u < (LDS_BYTES - RING_BYTES) / 4; u += NTHREADS) ((LAS unsigned*)(C.lds + RING_BYTES))[u] = 0u;
    __syncthreads();
    unsigned* barw = (unsigned*)(C.ws + WS_CTL) + CW_BAR + args.li * XCD_BAR_WORDS;
    XcdBarrier bar; bar.bar = barw; bar.x = 0; bar.st = nullptr;
    const int lo = args.ph_lo, hi = args.ph_hi;
    if (hi - lo > 1) bar = xcd_barrier_post(barw, MISC + 8);
#ifndef MK_MASK
#define MK_MASK 0xFFFFFu
#endif
#define IN(k) (((MK_MASK >> (k)) & 1u) && lo <= (k) && (k) < hi)
#define SEAM(k) do { if (IN(k) && IN((k) + 1)) xcd_barrier(bar); } while (0)
    LAS unsigned char* ring = C.lds;
#if defined(MK_PROBE_ATT)
    if (lo >= 100) {
        const int mode = lo - 100;
        if (mode & 31) nsa_unit(C, C.bid & 1, C.bid >> 1, C.out, mode);
        if (mode & 32) { unsigned* sbctr = (unsigned*)(C.ws + WS_CTL) + CW_SBCTR + 64 * args.li;
            for (;;) { unsigned idx = 0; if (C.lane == 0) idx = __hip_atomic_fetch_add(sbctr, 1u, __ATOMIC_RELAXED, __HIP_MEMORY_SCOPE_AGENT);
                const int item = __builtin_amdgcn_readfirstlane((int)idx); if (item >= 2048) break;
                sb_item(C, item & 7, item >> 3, C.out); } }
        if (mode & 64) conv_dynamic<JOBS_P7>(C, (unsigned*)(C.ws + WS_CTL) + CW_CONVCTR + 64 * args.li);
        return;
    }
#endif
    float* Yout = C.out;
    float* X = wsf(C, WS_X); bf16* XB = wsb(C, WS_XB); bf16* Hb = wsb(C, WS_BIG);

    if (IN(0)) { p0_prologue(C, args.invf, args.li == 0); } SEAM(0);
    if (IN(1)) {
        { pg8::Gemm gm{XB, wsb(C, WS_WGU1), D, D, D}; pg8::StaticOrder S; S.init(T, NGU, C.G, C.bid); pg8::EpiSwiGLU E{Hb, FF};
          pg8::gemm_phase<pg8::EpiSwiGLU, pg8::StaticOrder, true, true>(ring, gm, S, E); }
        { pg8::Gemm gm{wsb(C, WS_MEMB), wsb(C, WS_WK), D, D, D}; pg8::ListOrder S; S.init(1, 1, 8, C.G, C.bid, 96, 0, 0); pg8::EpiBf16S E{wsb(C, WS_KMEM), D, 1.f, 0};
          pg8::gemm_phase<pg8::EpiBf16S, pg8::ListOrder, true, true>(ring, gm, S, E); }
        { pg8::Gemm gm{wsb(C, WS_WV), wsb(C, WS_MEMB), D, D, D}; pg8::ListOrder S; S.init(1, 8, 1, C.G, C.bid, 104, 0, 0); pg8::EpiBf16S E{wsb(C, WS_VT), MEMT, 1.f, 0};
          pg8::gemm_phase<pg8::EpiBf16S, pg8::ListOrder, true, true>(ring, gm, S, E); }
        if (C.G == 256 && C.bid >= 112) conv_static<JOBS_P1>(C, (C.bid - 112) * NWAVES + C.wave, 144 * NWAVES);
        else if (C.G != 256) conv_static<JOBS_P1>(C, C.gw, C.NGW);
    } SEAM(1);
    if (IN(2)) { pg8::Gemm gm{Hb, wsb(C, WS_WD1), FF, FF, FF}; pg8::StaticOrder S; S.init(T, D, C.G, C.bid); pg8::EpiF32 E{Yout, D, C.in[0], ALPHA, 0.5f, 0};
        pg8::gemm_phase<pg8::EpiF32, pg8::StaticOrder, true, true>(ring, gm, S, E); } SEAM(2);
    if (IN(3)) { ln_rows(C, Yout, C.in[2], C.in[3], X, XB); } SEAM(3);
    if (IN(4)) { pg8::Gemm gm{XB, wsb(C, WS_WIN), D, D, D}; pg8::StaticOrder S; S.init(T, INP, C.G, C.bid);
        pg8::EpiWin E{wsb(C, WS_BIG + BG_SBQ), wsb(C, WS_BIG + BG_SBK), wsb(C, WS_BIG + BG_SBVT), wsb(C, WS_BIG + BG_NQ), wsb(C, WS_BIG + BG_CMPIN), wsb(C, WS_BIG + BG_KSL), wsb(C, WS_BIG + BG_VSLT),
                      wsb(C, WS_BIG + BG_KWN), wsb(C, WS_BIG + BG_VWNT), wsf(C, WS_GATES), wsf(C, WS_ROPE), T, QSCALE};
        pg8::gemm_phase<pg8::EpiWin, pg8::StaticOrder, true, true>(ring, gm, S, E); } SEAM(4);
    if (IN(5)) { pg8::Gemm gm{wsb(C, WS_BIG + BG_CMPIN), wsb(C, WS_W1T), 16 * 128, 4096, 512}; pg8::CmpOrder S{C.G, C.bid, (size_t)T * 128 * 2, (size_t)256 * 4096 * 2};
        pg8::EpiF32 E{wsf(C, WS_PC), 256, nullptr, 0.f, 1.f, (size_t)512 * 256};
        pg8::gemm_phase<pg8::EpiF32, pg8::CmpOrder, true, true>(ring, gm, S, E); } SEAM(5);
    if (IN(6)) { compress_l2(C); } SEAM(6);
    if (IN(7)) {
        if (C.G == 256) {
            nsa_unit(C, C.bid & 1, C.bid >> 1, Yout);
            unsigned* sbctr = (unsigned*)(C.ws + WS_CTL) + CW_SBCTR + 64 * args.li;
            for (;;) { unsigned idx = 0; if (C.lane == 0) idx = __hip_atomic_fetch_add(sbctr, 1u, __ATOMIC_RELAXED, __HIP_MEMORY_SCOPE_AGENT);
                const int item = __builtin_amdgcn_readfirstlane((int)idx); if (item >= 2048) break;
                sb_item(C, item & 7, item >> 3, Yout); }
        }
        conv_dynamic<JOBS_P7>(C, (unsigned*)(C.ws + WS_CTL) + CW_CONVCTR + 64 * args.li);
    } SEAM(7);
    if (IN(8)) { rms_rows(C, Yout, C.in[14], XB); } SEAM(8);
    if (IN(9)) { pg8::Gemm gm{XB, wsb(C, WS_WOUT), D, D, D}; pg8::StaticOrder S; S.init(T, D, C.G, C.bid); pg8::EpiF32 E{Yout, D, X, ALPHA, 1.f, 0};
        pg8::gemm_phase<pg8::EpiF32, pg8::StaticOrder, true, true>(ring, gm, S, E); } SEAM(9);
    if (IN(10)) { ln_rows(C, Yout, C.in[16], C.in[17], X, XB); } SEAM(10);
    if (IN(11)) { pg8::Gemm gm{XB, wsb(C, WS_WQ), D, D, D}; pg8::StaticOrder S; S.init(T, D, C.G, C.bid); pg8::EpiBf16S E{wsb(C, WS_BIG + BG_QC), D, MEMQSCALE, 0};
        pg8::gemm_phase<pg8::EpiBf16S, pg8::StaticOrder, true, true>(ring, gm, S, E); } SEAM(11);
    if (IN(12)) { pg8::Gemm gm{wsb(C, WS_BIG + BG_QC), wsb(C, WS_KMEM), D, D, MEMD}; pg8::ListOrder S; S.init(MEMH, T / 256, 1, C.G, C.bid, 0, (size_t)MEMD * 2, (size_t)MEMD * 2);
        pg8::EpiF32 E{wsf(C, WS_BIG + BG_S), MEMT, nullptr, 0.f, 1.f, (size_t)T * MEMT};
        pg8::gemm_phase<pg8::EpiF32, pg8::ListOrder, true, true>(ring, gm, S, E); } SEAM(12);
    if (IN(13)) { softmax_rows(C, wsf(C, WS_BIG + BG_S), wsb(C, WS_BIG + BG_P)); } SEAM(13);
    if (IN(14)) { pg8::Gemm gm{wsb(C, WS_BIG + BG_P), wsb(C, WS_VT), MEMT, MEMT, MEMT}; pg8::ListOrder S; S.init(MEMH, T / 256, 2, C.G, C.bid, 0, (size_t)T * MEMT * 2, (size_t)MEMD * MEMT * 2);
        pg8::EpiBf16S E{wsb(C, WS_BIG + BG_QC), D, 1.f, MEMD};
        pg8::gemm_phase<pg8::EpiBf16S, pg8::ListOrder, true, true>(ring, gm, S, E); } SEAM(14);
    if (IN(15)) { pg8::Gemm gm{wsb(C, WS_BIG + BG_QC), wsb(C, WS_WO), D, D, D}; pg8::StaticOrder S; S.init(T, D, C.G, C.bid); pg8::EpiF32 E{Yout, D, X, ALPHA, 1.f, 0};
        pg8::gemm_phase<pg8::EpiF32, pg8::StaticOrder, true, true>(ring, gm, S, E); } SEAM(15);
    if (IN(16)) { ln_rows(C, Yout, C.in[22], C.in[23], X, XB); } SEAM(16);
    if (IN(17)) { pg8::Gemm gm{XB, wsb(C, WS_WGU2), D, D, D}; pg8::StaticOrder S; S.init(T, NGU, C.G, C.bid); pg8::EpiSwiGLU E{Hb, FF};
        pg8::gemm_phase<pg8::EpiSwiGLU, pg8::StaticOrder, true, true>(ring, gm, S, E); } SEAM(17);
    if (IN(18)) { pg8::Gemm gm{Hb, wsb(C, WS_WD2), FF, FF, FF}; pg8::StaticOrder S; S.init(T, D, C.G, C.bid); pg8::EpiF32 E{Yout, D, X, ALPHA, 0.5f, 0};
        pg8::gemm_phase<pg8::EpiF32, pg8::StaticOrder, true, true>(ring, gm, S, E); } SEAM(18);
    if (IN(19)) { ln_rows(C, Yout, C.in[27], C.in[28], Yout, nullptr); }
#undef IN
#undef SEAM
}

extern "C" void kernel_launch(void* const* d_in, const int* in_sizes, int n_in, void* d_out, int out_size, void* d_ws, size_t ws_size, hipStream_t stream) {
    static int grid = 0;
    if (grid == 0) {
        if (n_in != 29 || in_sizes[0] != T * D || out_size != T * D || ws_size < WS_END) { fprintf(stderr, "kernel_launch: unexpected shapes (n_in %d, in0 %d, out %d, ws %zu < %zu); nothing launched\n", n_in, n_in > 0 ? in_sizes[0] : -1, out_size, ws_size, (size_t)WS_END); grid = -1; return; }
        int dev = 0, cus = 0, per_cu = 0;
        if (hipGetDevice(&dev) != hipSuccess || hipDeviceGetAttribute(&cus, hipDeviceAttributeMultiprocessorCount, dev) != hipSuccess) { grid = -1; return; }
        if (hipFuncSetAttribute((const void*)fwd_kernel, hipFuncAttributeMaxDynamicSharedMemorySize, LDS_BYTES) != hipSuccess) { fprintf(stderr, "kernel_launch: hipFuncSetAttribute failed\n"); grid = -1; return; }
        if (hipOccupancyMaxActiveBlocksPerMultiprocessor(&per_cu, (const void*)fwd_kernel, NTHREADS, LDS_BYTES) != hipSuccess || per_cu < 1) { fprintf(stderr, "kernel_launch: occupancy query says %d blocks per CU\n", per_cu); per_cu = 1; }
        (void)hipGetLastError();
        grid = cus;
        if (grid != 256) fprintf(stderr, "kernel_launch: %d CUs; the attention phase is laid out for 256\n", grid);
    }
    if (grid < 0) return;
    (void)hipMemsetAsync((char*)d_ws + WS_CTL, 0, CTL_ZERO_BYTES, stream);
    Args a{};
    for (int i = 0; i < 29; ++i) a.in[i] = (const float*)d_in[i];
    a.out = (float*)d_out; a.ws = (unsigned char*)d_ws;
    for (int i = 0; i < 64; ++i) a.invf[i] = std::pow(10000.0, -(double)i / 64.0);
#if defined(MK_PROBE_ATT)
    a.ph_lo = 0; a.ph_hi = 8; a.li = 0; hipLaunchKernelGGL(fwd_kernel, dim3(grid), dim3(NTHREADS), LDS_BYTES, stream, a);
    a.ph_lo = 100 + MK_PROBE_ATT; a.ph_hi = 100 + MK_PROBE_ATT + 1; a.li = 1; hipLaunchKernelGGL(fwd_kernel, dim3(grid), dim3(NTHREADS), LDS_BYTES, stream, a);
    a.ph_lo = 8; a.ph_hi = N_PHASES; a.li = 2; hipLaunchKernelGGL(fwd_kernel, dim3(grid), dim3(NTHREADS), LDS_BYTES, stream, a);
#elif defined(MK_PROBE_PHASE)
    a.ph_lo = 0; a.ph_hi = MK_PROBE_PHASE + 1; a.li = 0; hipLaunchKernelGGL(fwd_kernel, dim3(grid), dim3(NTHREADS), LDS_BYTES, stream, a);
    a.ph_lo = MK_PROBE_PHASE; a.ph_hi = MK_PROBE_PHASE + 1; a.li = 1; hipLaunchKernelGGL(fwd_kernel, dim3(grid), dim3(NTHREADS), LDS_BYTES, stream, a);
    a.ph_lo = MK_PROBE_PHASE + 1; a.ph_hi = N_PHASES; a.li = 2; hipLaunchKernelGGL(fwd_kernel, dim3(grid), dim3(NTHREADS), LDS_BYTES, stream, a);
#elif MK_ONE_LAUNCH
    a.ph_lo = 0; a.ph_hi = N_PHASES; a.li = 0;
    hipLaunchKernelGGL(fwd_kernel, dim3(grid), dim3(NTHREADS), LDS_BYTES, stream, a);
#else
    for (int p = 0; p < N_PHASES; ++p) { a.ph_lo = p; a.ph_hi = p + 1; a.li = 0; hipLaunchKernelGGL(fwd_kernel, dim3(grid), dim3(NTHREADS), LDS_BYTES, stream, a); }
#endif
}
```

```cpp
#define AT_SB 0
#include <hip/hip_runtime.h>
#include <cstdio>
#include <cstdint>
#include <cmath>

namespace pg8 {
#define PG8_LAS __attribute__((address_space(3)))
typedef unsigned short bf16_t;
typedef short bf16x8 __attribute__((ext_vector_type(8)));
typedef float f32x4 __attribute__((ext_vector_type(4)));
typedef unsigned u32x4 __attribute__((ext_vector_type(4)));
typedef unsigned u32x2 __attribute__((ext_vector_type(2)));
constexpr int BM = 256, BK = 64, HALF = 128, HTB = HALF * BK * 2  , STAGE_BYTES = 8 * HTB, NXCD = 8, WGM = 8;

__host__ __device__ __forceinline__ int lds_byte(int r, int c) { const int st = (r >> 4) * 2 + (c >> 5), rr = r & 15, cc = c & 31, ob = rr * 64 + cc * 2; return st * 1024 + (ob ^ (((ob >> 9) & 1) << 5)); }
__host__ __device__ __forceinline__ void stage_rc(int b, int& R, int& C) { const int st = b / 1024, sb = b % 1024, swz = sb ^ (((sb >> 9) & 1) << 5); R = (st >> 1) * 16 + swz / 64; C = (st & 1) * 32 + (swz % 64) / 2; }
__host__ __device__ __forceinline__ int perm32(int rho) { const int n = rho >> 4, i = rho & 15; return 8 * (i >> 2) + 4 * n + (i & 3); }

struct Unit { int pm, pn, z; size_t offA, offB; };
struct Gemm { const bf16_t* A; const bf16_t* Bt; int lda, ldb, K; };

struct StaticOrder {
    int nM, nN, nwg, G, c;
    __host__ __device__ void init(int M, int N, int G_, int c_) { nM = M / BM; nN = N / BM; nwg = nM * nN; G = G_; c = c_; }
    __host__ __device__ bool next(int i, Unit& u) const {
        const long L = (long)i * G + c; if (L >= nwg) return false;
        int wgid = (int)L; { const int q = nwg / NXCD, r = nwg % NXCD, xcd = wgid % NXCD, off = wgid / NXCD; wgid = (xcd < r ? xcd * (q + 1) : r * (q + 1) + (xcd - r) * q) + off; }
        const int nig = WGM * nN, gid = wgid / nig, fm = gid * WGM, gsz = (nM - fm) < WGM ? (nM - fm) : WGM;
        u.pm = fm + ((wgid % nig) % gsz); u.pn = (wgid % nig) / gsz; u.z = 0; u.offA = 0; u.offB = 0; return true;
    }
    __device__ __forceinline__ void a_ready(const Unit&) const {}
    __device__ __forceinline__ void done(const Unit&) const {}
};
struct ListOrder {
    int nM, nN, nwg, G, c; size_t zA, zB;
    __host__ __device__ void init(int nZ, int nM_, int nN_, int G_, int c_, int c0, size_t zA_, size_t zB_) { nM = nM_; nN = nN_; nwg = nZ * nM_ * nN_; G = G_; c = (c_ - c0 + G_) % G_; zA = zA_; zB = zB_; }
    __host__ __device__ bool next(int i, Unit& u) const {
        const long L = (long)i * G + c; if (L >= nwg) return false;
        const int l = (int)L; u.pn = l % nN; u.pm = (l / nN) % nM; u.z = l / (nN * nM); u.offA = (size_t)u.z * zA; u.offB = (size_t)u.z * zB; return true;
    }
    __device__ __forceinline__ void a_ready(const Unit&) const {}
    __device__ __forceinline__ void done(const Unit&) const {}
};

typedef float f32x2_t __attribute__((ext_vector_type(2))); typedef __bf16 bf16x2_t __attribute__((ext_vector_type(2)));
struct CmpOrder {
    int G, c; size_t grpA, kvB;
    __host__ __device__ bool next(int i, Unit& u) const {
        const long L = (long)i * G + c; if (L >= 64) return false;
        const int l = (int)L, kc = l & 7, pm = (l >> 3) & 1, g = (l >> 4) & 1, kv = l >> 5;
        u.pm = pm; u.pn = 0; u.z = (kc * 2 + kv) * 2 + g; u.offA = (size_t)(kv * 2 + g) * grpA + (size_t)kc * 1024; u.offB = (size_t)kv * kvB + (size_t)kc * 1024; return true;
    }
    __device__ __forceinline__ void a_ready(const Unit&) const {}
    __device__ __forceinline__ void done(const Unit&) const {}
};
__device__ __forceinline__ unsigned cvt_pk_bf16(float lo, float hi) { f32x2_t v = {lo, hi}; bf16x2_t b = __builtin_convertvector(v, bf16x2_t); return __builtin_bit_cast(unsigned, b); }
__device__ __forceinline__ u32x2 pack4(f32x4 v) { u32x2 w; w.x = cvt_pk_bf16(v[0], v[1]); w.y = cvt_pk_bf16(v[2], v[3]); return w; }

struct EpiSwiGLU {
    static constexpr bool PERM = false, AFTER_DRAIN = false;
    bf16_t* H; int ldh;
    __device__ __forceinline__ void operator()(const f32x4 (&acc)[2][2][4][2], const Unit& u, int wr, int wc, int fr, int fq) const {
        const int row0 = u.pm * BM + wr * 64 + fr, col0 = u.pn * HALF + wc * 32 + 4 * fq;
#pragma unroll
        for (int ai = 0; ai < 2; ++ai)
#pragma unroll
            for (int m = 0; m < 4; ++m) { bf16_t* rowp = H + (size_t)(row0 + ai * HALF + m * 16) * ldh + col0;
#pragma unroll
                for (int n = 0; n < 2; ++n) { const f32x4 g = acc[ai][0][m][n], up = acc[ai][1][m][n]; f32x4 h;
#pragma unroll
                    for (int j = 0; j < 4; ++j) { const float e = __builtin_amdgcn_exp2f(-1.4426950408889634f * g[j]); h[j] = g[j] * __builtin_amdgcn_rcpf(1.0f + e) * up[j]; }
                    *(u32x2*)(rowp + 16 * n) = pack4(h); } }
    }
};
struct EpiF32 {
    static constexpr bool PERM = false, AFTER_DRAIN = false;
    float* O; int ldc; const float* R; float alpha, beta; size_t zO;
    __device__ __forceinline__ void operator()(const f32x4 (&acc)[2][2][4][2], const Unit& u, int wr, int wc, int fr, int fq) const {
        const int row0 = u.pm * BM + wr * 64 + fr, col0 = u.pn * BM + wc * 32 + 4 * fq;
        float* base = O + (size_t)u.z * zO;
#pragma unroll
        for (int ai = 0; ai < 2; ++ai)
#pragma unroll
            for (int m = 0; m < 4; ++m) { const size_t off = (size_t)(row0 + ai * HALF + m * 16) * ldc + col0;
#pragma unroll
                for (int bj = 0; bj < 2; ++bj)
#pragma unroll
                    for (int n = 0; n < 2; ++n) { f32x4 v = acc[ai][bj][m][n] * beta; if (R) { const f32x4 r = *(const f32x4*)(R + off + bj * HALF + n * 16); v = v + r * alpha; }
                        *(f32x4*)(base + off + bj * HALF + n * 16) = v; } }
    }
};
struct EpiBf16S {
    static constexpr bool PERM = false, AFTER_DRAIN = false;
    bf16_t* O; int ldc; float scale; int zcol, zrow;
    __device__ __forceinline__ void operator()(const f32x4 (&acc)[2][2][4][2], const Unit& u, int wr, int wc, int fr, int fq) const {
        const int row0 = u.z * zrow + u.pm * BM + wr * 64 + fr, col0 = u.z * zcol + u.pn * BM + wc * 32 + 4 * fq;
#pragma unroll
        for (int ai = 0; ai < 2; ++ai)
#pragma unroll
            for (int m = 0; m < 4; ++m) { bf16_t* rowp = O + (size_t)(row0 + ai * HALF + m * 16) * ldc + col0;
#pragma unroll
                for (int bj = 0; bj < 2; ++bj)
#pragma unroll
                    for (int n = 0; n < 2; ++n) *(u32x2*)(rowp + bj * HALF + n * 16) = pack4(acc[ai][bj][m][n] * scale); }
    }
};
struct EpiSoftmaxP {
    static constexpr bool PERM = false, AFTER_DRAIN = true;
    bf16_t* P; int ldp;
    __device__ __forceinline__ void fused(f32x4 (&acc)[2][2][4][2], const Unit& u, int wr, int wc, int fr, int fq, PG8_LAS unsigned char* lds, int wid, int lane) const {
        PG8_LAS float* MX = (PG8_LAS float*)lds; PG8_LAS float* SM = MX + 1024;
        (void)wid; (void)lane;
#pragma unroll
        for (int ai = 0; ai < 2; ++ai)
#pragma unroll
            for (int m = 0; m < 4; ++m) { float mx = -INFINITY;
#pragma unroll
                for (int bj = 0; bj < 2; ++bj)
#pragma unroll
                    for (int n = 0; n < 2; ++n) { const f32x4 v = acc[ai][bj][m][n]; mx = fmaxf(fmaxf(mx, fmaxf(v[0], v[1])), fmaxf(v[2], v[3])); }
                mx = fmaxf(mx, __shfl_xor(mx, 16)); mx = fmaxf(mx, __shfl_xor(mx, 32));
                if (fq == 0) MX[(ai * HALF + wr * 64 + m * 16 + fr) * 4 + wc] = mx; }
        asm volatile("s_waitcnt lgkmcnt(0)" ::: "memory"); __builtin_amdgcn_s_barrier(); asm volatile("" ::: "memory");
#pragma unroll
        for (int ai = 0; ai < 2; ++ai)
#pragma unroll
            for (int m = 0; m < 4; ++m) { const int r = ai * HALF + wr * 64 + m * 16 + fr; const f32x4 mm = *(const PG8_LAS f32x4*)(MX + r * 4);
                const float gm = fmaxf(fmaxf(mm[0], mm[1]), fmaxf(mm[2], mm[3])); float s = 0.f;
#pragma unroll
                for (int bj = 0; bj < 2; ++bj)
#pragma unroll
                    for (int n = 0; n < 2; ++n) { f32x4 v = acc[ai][bj][m][n];
#pragma unroll
                        for (int j = 0; j < 4; ++j) { v[j] = __builtin_amdgcn_exp2f(v[j] - gm); s += v[j]; }
                        acc[ai][bj][m][n] = v; }
                s += __shfl_xor(s, 16); s += __shfl_xor(s, 32);
                if (fq == 0) SM[r * 4 + wc] = s; }
        asm volatile("s_waitcnt lgkmcnt(0)" ::: "memory"); __builtin_amdgcn_s_barrier(); asm volatile("" ::: "memory");
        const int row0 = u.pm * BM + wr * 64 + fr, col0 = u.pn * BM + wc * 32 + 4 * fq;
#pragma unroll
        for (int ai = 0; ai < 2; ++ai)
#pragma unroll
            for (int m = 0; m < 4; ++m) { const int r = ai * HALF + wr * 64 + m * 16 + fr; const f32x4 ss = *(const PG8_LAS f32x4*)(SM + r * 4);
                const float inv = 1.0f / ((ss[0] + ss[1]) + (ss[2] + ss[3])); bf16_t* rowp = P + (size_t)(row0 + ai * HALF + m * 16) * ldp + col0;
#pragma unroll
                for (int bj = 0; bj < 2; ++bj)
#pragma unroll
                    for (int n = 0; n < 2; ++n) *(u32x2*)(rowp + bj * HALF + n * 16) = pack4(acc[ai][bj][m][n] * inv); }
        asm volatile("s_waitcnt lgkmcnt(0)" ::: "memory"); __builtin_amdgcn_s_barrier(); asm volatile("" ::: "memory");
    }
};
struct EpiWin {
    static constexpr bool PERM = false, AFTER_DRAIN = false;
    bf16_t *SBQ, *SBK, *SBVT, *NQ, *CMPIN, *KSL, *VSLT, *KWN, *VWNT; float* GATES; const float* ROPE; int T; float qscale;
    template <bool SWZ> __device__ __forceinline__ void st_plain(bf16_t* dst, int head0, const f32x4 (&acc)[2][2][4][2], const Unit& u, int wr, int wc, int fr, int fq, float sc) const {
        const int row0 = u.pm * BM + wr * 64 + fr, c0 = wc * 32 + 4 * fq;
#pragma unroll
        for (int bj = 0; bj < 2; ++bj)
#pragma unroll
            for (int ai = 0; ai < 2; ++ai)
#pragma unroll
                for (int m = 0; m < 4; ++m) { const int tok = row0 + ai * HALF + m * 16; bf16_t* rowp = dst + ((size_t)(head0 + bj) * T + tok) * 128;
#pragma unroll
                    for (int n = 0; n < 2; ++n) { const int c = c0 + 16 * n; const int off = SWZ ? ((((c >> 3) ^ (tok & 15)) << 3) + (c & 7)) : c;
                        *(u32x2*)(rowp + off) = pack4(acc[ai][bj][m][n] * sc); } }
    }
    template <bool SWZ> __device__ __forceinline__ void st_rope(bf16_t* dst, int head0, const f32x4 (&acc)[2][2][4][2], const Unit& u, int wr, int wc, int fr, int fq, float sc) const {
        const int row0 = u.pm * BM + wr * 64 + fr, i0 = wc * 16 + 4 * fq;
#pragma unroll
        for (int ai = 0; ai < 2; ++ai)
#pragma unroll
            for (int m = 0; m < 4; ++m) { const int tok = row0 + ai * HALF + m * 16;
                const f32x4 cs0 = *(const f32x4*)(ROPE + ((size_t)tok * 64 + i0) * 2), cs1 = *(const f32x4*)(ROPE + ((size_t)tok * 64 + i0) * 2 + 4);
                const f32x4 co = {cs0[0], cs0[2], cs1[0], cs1[2]}, si = {cs0[1], cs0[3], cs1[1], cs1[3]};
                const int olo_off = SWZ ? ((((i0 >> 3) ^ (tok & 15)) << 3) + (i0 & 7)) : i0, ohi_off = SWZ ? (((((i0 >> 3) + 8) ^ (tok & 15)) << 3) + (i0 & 7)) : i0 + 64;
#pragma unroll
                for (int bj = 0; bj < 2; ++bj) { const f32x4 lo = acc[ai][bj][m][0], hi = acc[ai][bj][m][1];
                    const f32x4 olo = (lo * co - hi * si) * sc, ohi = (lo * si + hi * co) * sc;
                    bf16_t* rowp = dst + ((size_t)(head0 + bj) * T + tok) * 128;
                    *(u32x2*)(rowp + olo_off) = pack4(olo); *(u32x2*)(rowp + ohi_off) = pack4(ohi); } }
    }
    __device__ __forceinline__ void st_vt(bf16_t* dst, int head0, const f32x4 (&acc)[2][2][4][2], const Unit& u, int wr, int wc, int fr, int fq) const {
        const int row0 = u.pm * BM + wr * 64 + fr, c0 = wc * 32 + 4 * fq;
#pragma unroll
        for (int bj = 0; bj < 2; ++bj)
#pragma unroll
            for (int ai = 0; ai < 2; ++ai)
#pragma unroll
                for (int m = 0; m < 4; ++m) { const int tok = row0 + ai * HALF + m * 16, kk = tok & 31, p16 = 2 * (kk >> 4) + ((kk >> 2) & 1), sub = ((kk >> 3) & 1) * 4 + (kk & 3);
                    bf16_t* tb = dst + ((size_t)(head0 + bj) * T + (tok & ~31)) * 128 + sub;
#pragma unroll
                    for (int n = 0; n < 2; ++n) { const u32x2 w = pack4(acc[ai][bj][m][n]); const int d = c0 + 16 * n;
                        bf16_t* p = tb + d * 32 + ((p16 ^ ((d >> 2) & 3)) << 3);
                        p[0] = (bf16_t)(w.x & 0xffffu); p[32] = (bf16_t)(w.x >> 16); p[64] = (bf16_t)(w.y & 0xffffu); p[96] = (bf16_t)(w.y >> 16); } }
    }
    __device__ __forceinline__ void operator()(const f32x4 (&acc)[2][2][4][2], const Unit& u, int wr, int wc, int fr, int fq) const {
        asm volatile("" : "+v"(fr), "+v"(fq));
        const int pn = u.pn;
        if (pn < 4) st_plain<false>(SBQ, 2 * pn, acc, u, wr, wc, fr, fq, qscale);
        else if (pn < 8) st_plain<true>(SBK, 2 * (pn - 4), acc, u, wr, wc, fr, fq, 1.f);
        else if (pn < 12) st_vt(SBVT, 2 * (pn - 8), acc, u, wr, wc, fr, fq);
        else if (pn < 16) st_rope<false>(NQ, 2 * (pn - 12), acc, u, wr, wc, fr, fq, qscale);
        else if (pn == 16) st_rope<false>(CMPIN, 0, acc, u, wr, wc, fr, fq, 1.f);
        else if (pn == 17) st_plain<false>(CMPIN, 2, acc, u, wr, wc, fr, fq, 1.f);
        else if (pn == 18) st_rope<true>(KSL, 0, acc, u, wr, wc, fr, fq, 1.f);
        else if (pn == 19) st_vt(VSLT, 0, acc, u, wr, wc, fr, fq);
        else if (pn == 20) st_rope<true>(KWN, 0, acc, u, wr, wc, fr, fq, 1.f);
        else if (pn == 21) st_vt(VWNT, 0, acc, u, wr, wc, fr, fq);
        else {
            if (wc == 0) { const int row0 = u.pm * BM + wr * 64 + fr;
#pragma unroll
                for (int ai = 0; ai < 2; ++ai)
#pragma unroll
                    for (int m = 0; m < 4; ++m) { float* gp = GATES + (size_t)(row0 + ai * HALF + m * 16) * 24;
#pragma unroll
                        for (int n = 0; n < 2; ++n) { const int c = 16 * n + 4 * fq; if (c < 24) { const f32x4 v = acc[ai][0][m][n]; f32x4 s;
#pragma unroll
                                for (int j = 0; j < 4; ++j) s[j] = __builtin_amdgcn_rcpf(1.0f + __builtin_amdgcn_exp2f(-1.4426950408889634f * v[j]));
                                *(f32x4*)(gp + c) = s; } } } }
        }
    }
};

template <class Epi, class Sched, bool ALIGN_EPI = false, bool SP2 = false>
__device__ __forceinline__ void gemm_phase(PG8_LAS unsigned char* lds, const Gemm g, const Sched& S, const Epi& E) {
    const int tid = threadIdx.x, wid = __builtin_amdgcn_readfirstlane(tid >> 6), lane = tid & 63, wr = wid >> 2, wc = wid & 3, fr = lane & 15, fq = lane >> 4;
    const int K = g.K, nt = K / BK, lda = g.lda, ldb = g.ldb;
    unsigned voffA[2], voffB[2];
#pragma unroll
    for (int i = 0; i < 2; ++i) { int R, C; stage_rc(tid * 16 + i * 8192, R, C); const int Rb = Epi::PERM ? ((R & ~31) + perm32(R & 31)) : R;
        voffA[i] = (unsigned)(R * lda + C) * 2u; voffB[i] = (unsigned)(Rb * ldb + C) * 2u; }
    const size_t kstep = (size_t)(BK * 2);
    const size_t hstepA = (size_t)HALF * lda * 2, hstepB = (size_t)HALF * ldb * 2;
    const size_t tstepA = 2 * hstepA, tstepB = 2 * hstepB;
    const unsigned ldsw = (unsigned)wid * 1024u;
    const int aoff = lds_byte(wr * 64 + fr, fq * 8), boff = lds_byte(wc * 32 + fr, fq * 8);
#define PG8_SA(b, h) (((b) * 2 + (h)) * HTB)
#define PG8_SB(b, h) ((4 + (b) * 2 + (h)) * HTB)
#define PG8_STAGE(bufoff, gbase, voff) do { _Pragma("unroll") for (int _i = 0; _i < 2; ++_i) \
        __builtin_amdgcn_global_load_lds((const unsigned*)((const char*)(gbase) + (voff)[_i]), (PG8_LAS unsigned*)(lds + (bufoff) + ldsw + _i * 8192), 16, 0, 0); } while (0)
#define PG8_LDA(dst, b, h) do { _Pragma("unroll") for (int m = 0; m < 4; ++m) _Pragma("unroll") for (int k = 0; k < 2; ++k) dst[m][k] = *(const PG8_LAS bf16x8*)(lds + PG8_SA(b, h) + aoff + m * 2048 + k * 1024); } while (0)
#define PG8_LDB(dst, b, h) do { _Pragma("unroll") for (int n = 0; n < 2; ++n) _Pragma("unroll") for (int k = 0; k < 2; ++k) dst[n][k] = *(const PG8_LAS bf16x8*)(lds + PG8_SB(b, h) + boff + n * 2048 + k * 1024); } while (0)
#define PG8_MMA(ai, bj, At, Bt) do { __builtin_amdgcn_s_setprio(1); _Pragma("unroll") for (int m = 0; m < 4; ++m) _Pragma("unroll") for (int n = 0; n < 2; ++n) _Pragma("unroll") for (int k = 0; k < 2; ++k) \
        acc[ai][bj][m][n] = __builtin_amdgcn_mfma_f32_16x16x32_bf16(Bt[n][k], At[m][k], acc[ai][bj][m][n], 0, 0, 0); __builtin_amdgcn_s_setprio(0); } while (0)
#define PG8_WAIT_V(n) asm volatile("s_waitcnt vmcnt(" #n ")" ::: "memory")
#define PG8_WAIT_L(n) asm volatile("s_waitcnt lgkmcnt(" #n ")" ::: "memory")
#define PG8_BAR __builtin_amdgcn_s_barrier()
#define PG8_SCHED __builtin_amdgcn_sched_barrier(0)
    Unit cur, nxt; int ui = 0;
    if (!S.next(0, cur)) return;
    f32x4 acc[2][2][4][2];
#pragma unroll
    for (int a = 0; a < 2; ++a)
#pragma unroll
        for (int b = 0; b < 2; ++b)
#pragma unroll
            for (int m = 0; m < 4; ++m)
#pragma unroll
                for (int n = 0; n < 2; ++n) acc[a][b][m][n] = (f32x4){0.f, 0.f, 0.f, 0.f};
    bf16x8 At[4][2], B0[2][2], B1[2][2];
    const char* cA = (const char*)g.A + (size_t)cur.pm * tstepA + cur.offA; const char* cB = (const char*)g.Bt + (size_t)cur.pn * tstepB + cur.offB;
    S.a_ready(cur);
    if constexpr (SP2) {
        PG8_STAGE(PG8_SB(0, 0), cB, voffB); PG8_STAGE(PG8_SB(0, 1), cB + hstepB, voffB); PG8_STAGE(PG8_SA(0, 0), cA, voffA); PG8_STAGE(PG8_SA(0, 1), cA + hstepA, voffA);
        if (wr == 1) PG8_BAR;
        PG8_WAIT_V(2); PG8_BAR;
        PG8_STAGE(PG8_SB(1, 0), cB + kstep, voffB); PG8_STAGE(PG8_SA(1, 0), cA + kstep, voffA); PG8_STAGE(PG8_SB(1, 1), cB + hstepB + kstep, voffB);
        PG8_WAIT_V(6); PG8_BAR;
    } else {
        PG8_STAGE(PG8_SB(0, 0), cB, voffB); PG8_STAGE(PG8_SA(0, 0), cA, voffA); PG8_STAGE(PG8_SB(0, 1), cB + hstepB, voffB); PG8_STAGE(PG8_SA(0, 1), cA + hstepA, voffA);
        if (wr == 1) PG8_BAR;
        PG8_WAIT_V(4); PG8_BAR;
        PG8_STAGE(PG8_SB(1, 0), cB + kstep, voffB); PG8_STAGE(PG8_SA(1, 0), cA + kstep, voffA); PG8_STAGE(PG8_SB(1, 1), cB + hstepB + kstep, voffB);
        PG8_WAIT_V(6); PG8_BAR;
    }
    for (;;) {
        const bool has_next = S.next(ui + 1, nxt);
        const char* nA = has_next ? (const char*)g.A + (size_t)nxt.pm * tstepA + nxt.offA : cA; const char* nB = has_next ? (const char*)g.Bt + (size_t)nxt.pn * tstepB + nxt.offB : cB;
        for (int t = 0; t < nt; t += 2) {
            const bool last = (t == nt - 2);
            const char* a1 = cA + (size_t)(t + 1) * kstep;
            const char* a2 = last ? nA : cA + (size_t)(t + 2) * kstep; const char* b2 = last ? nB : cB + (size_t)(t + 2) * kstep;
            const char* a3 = a2 + kstep; const char* b3 = b2 + kstep;
            if (last && has_next) S.a_ready(nxt);
            if constexpr (SP2) {
            PG8_LDB(B0, 0, 0); PG8_LDB(B1, 0, 1); PG8_SCHED; PG8_LDA(At, 0, 0); PG8_STAGE(PG8_SA(1, 1), a1 + hstepA, voffA);
            PG8_WAIT_V(8); PG8_WAIT_L(0); PG8_BAR; PG8_MMA(0, 0, At, B0); PG8_MMA(0, 1, At, B1); PG8_BAR; PG8_SCHED;
            PG8_LDA(At, 0, 1); PG8_STAGE(PG8_SB(0, 0), b2, voffB); PG8_STAGE(PG8_SB(0, 1), b2 + hstepB, voffB); PG8_STAGE(PG8_SA(0, 0), a2, voffA);
            PG8_WAIT_V(8); PG8_WAIT_L(0); PG8_BAR; PG8_MMA(1, 0, At, B0); PG8_MMA(1, 1, At, B1); PG8_BAR; PG8_SCHED;
            PG8_LDB(B0, 1, 0); PG8_LDB(B1, 1, 1); PG8_SCHED; PG8_LDA(At, 1, 0); PG8_STAGE(PG8_SA(0, 1), a2 + hstepA, voffA);
            PG8_WAIT_V(8); PG8_WAIT_L(0); PG8_BAR; PG8_MMA(0, 0, At, B0); PG8_MMA(0, 1, At, B1); PG8_BAR; PG8_SCHED;
            PG8_LDA(At, 1, 1); PG8_STAGE(PG8_SB(1, 0), b3, voffB); PG8_STAGE(PG8_SB(1, 1), b3 + hstepB, voffB); PG8_STAGE(PG8_SA(1, 0), a3, voffA);
            PG8_WAIT_V(8); PG8_WAIT_L(0); PG8_BAR; PG8_MMA(1, 0, At, B0); PG8_MMA(1, 1, At, B1); PG8_BAR; PG8_SCHED;
            } else {
            PG8_LDB(B0, 0, 0); PG8_SCHED; PG8_LDA(At, 0, 0); PG8_STAGE(PG8_SA(1, 1), a1 + hstepA, voffA);
            PG8_WAIT_L(8); PG8_BAR; PG8_WAIT_L(0); PG8_MMA(0, 0, At, B0); PG8_BAR; PG8_SCHED;
            PG8_LDB(B1, 0, 1); PG8_STAGE(PG8_SB(0, 0), b2, voffB);
            PG8_BAR; PG8_WAIT_L(0); PG8_MMA(0, 1, At, B1); PG8_BAR;
            PG8_LDA(At, 0, 1); PG8_STAGE(PG8_SA(0, 0), a2, voffA);
            PG8_BAR; PG8_WAIT_L(0); PG8_MMA(1, 0, At, B0); PG8_BAR; PG8_SCHED;
            PG8_STAGE(PG8_SB(0, 1), b2 + hstepB, voffB);
            PG8_WAIT_V(6); PG8_BAR; PG8_MMA(1, 1, At, B1); PG8_BAR;
            PG8_LDB(B0, 1, 0); PG8_SCHED; PG8_LDA(At, 1, 0); PG8_STAGE(PG8_SA(0, 1), a2 + hstepA, voffA);
            PG8_WAIT_L(8); PG8_BAR; PG8_WAIT_L(0); PG8_MMA(0, 0, At, B0); PG8_BAR; PG8_SCHED;
            PG8_LDB(B1, 1, 1); PG8_STAGE(PG8_SB(1, 0), b3, voffB);
            PG8_BAR; PG8_WAIT_L(0); PG8_MMA(0, 1, At, B1); PG8_BAR;
            PG8_LDA(At, 1, 1); PG8_STAGE(PG8_SA(1, 0), a3, voffA);
            PG8_BAR; PG8_WAIT_L(0); PG8_MMA(1, 0, At, B0); PG8_BAR; PG8_SCHED;
            PG8_STAGE(PG8_SB(1, 1), b3 + hstepB, voffB);
            PG8_WAIT_V(6); PG8_BAR; PG8_MMA(1, 1, At, B1); PG8_BAR;
            }
        }
        if constexpr (ALIGN_EPI) { if (wr == 0) PG8_BAR; }
        if constexpr (!Epi::AFTER_DRAIN) { E(acc, cur, wr, wc, fr, fq); S.done(cur); }
        if (!has_next) break;
#pragma unroll
        for (int a = 0; a < 2; ++a)
#pragma unroll
            for (int b = 0; b < 2; ++b)
#pragma unroll
                for (int m = 0; m < 4; ++m)
#pragma unroll
                    for (int n = 0; n < 2; ++n) acc[a][b][m][n] = (f32x4){0.f, 0.f, 0.f, 0.f};
        cur = nxt; cA = nA; cB = nB; ++ui;
        if constexpr (ALIGN_EPI) { if (wr == 1) PG8_BAR; }
    }
    PG8_WAIT_V(0);
    if constexpr (!ALIGN_EPI) { if (wr == 0) PG8_BAR; }
    PG8_BAR;
    if constexpr (Epi::AFTER_DRAIN) { E.fused(acc, cur, wr, wc, fr, fq, lds, wid, lane); S.done(cur); }
#undef PG8_SA
#undef PG8_SB
#undef PG8_STAGE
#undef PG8_LDA
#undef PG8_LDB
#undef PG8_MMA
#undef PG8_WAIT_V
#undef PG8_WAIT_L
#undef PG8_BAR
#undef PG8_SCHED
}
}

constexpr int T = 8192, D = 2048, FF = 5504, NGU = 2 * FF, HD = 128, NSEL = 128, NCMP = 511;
constexpr int IN_COLS = 5656, INP = 5888;
constexpr int MEMT = 256, MEMH = 4, MEMD = 512;
constexpr float LN_EPS = 1e-5f, RMS_EPS = 1e-6f;
constexpr float ALPHA = 1.189207115002721f;
constexpr float LOG2E = 1.4426950408889634f;
constexpr float QSCALE = 0.08838834764831845f * LOG2E;
constexpr float MEMQSCALE = 0.04419417382415922f * LOG2E;
constexpr int NWAVES = 8, NTHREADS = 512;

constexpr size_t MiB = 1u << 20;
constexpr size_t WS_CTL = 0, CTL_ZERO_BYTES = 1 * MiB;
constexpr size_t CTL_BIAS1 = 512 * 1024;
constexpr size_t WS_ROPE = 1 * MiB;
constexpr size_t WS_GATES = 5 * MiB;
constexpr size_t WS_KCMP = 6 * MiB;
constexpr size_t WS_VCMPT = 6 * MiB + 256 * 1024;
constexpr size_t WS_W2T = 6 * MiB + 512 * 1024;
constexpr size_t WS_MEMB = 7 * MiB, WS_KMEM = 8 * MiB, WS_VT = 9 * MiB;
constexpr size_t WS_W1T = 10 * MiB;
constexpr size_t WS_PC = 14 * MiB;
constexpr size_t WS_WGU1 = 30 * MiB, WS_WD1 = 73 * MiB, WS_WGU2 = 95 * MiB, WS_WD2 = 138 * MiB, WS_WIN = 160 * MiB, WS_WOUT = 183 * MiB;
constexpr size_t WS_WQ = 191 * MiB, WS_WK = 199 * MiB, WS_WV = 207 * MiB, WS_WO = 215 * MiB;
constexpr size_t WS_X = 224 * MiB;
constexpr size_t WS_XB = 288 * MiB;
constexpr size_t WS_BIG = 320 * MiB, WS_END = 416 * MiB;
constexpr size_t BG_SBQ = 0, BG_SBK = 16 * MiB, BG_SBVT = 32 * MiB, BG_NQ = 48 * MiB, BG_CMPIN = 64 * MiB, BG_KSL = 72 * MiB, BG_VSLT = 76 * MiB, BG_KWN = 80 * MiB, BG_VWNT = 84 * MiB;
constexpr size_t BG_P = 0;
constexpr size_t WS_WQK = WS_WK, WS_VOT = WS_WV;
static_assert((size_t)NGU * D * 2 <= WS_WD1 - WS_WGU1 && (size_t)D * FF * 2 <= WS_WGU2 - WS_WD1 && (size_t)INP * D * 2 <= WS_WOUT - WS_WIN && (size_t)T * FF * 2 <= WS_END - WS_BIG, "ws map");
constexpr int CW_TMO = 0, CW_BAR = 4096;

#define GAS __attribute__((address_space(1)))
#define LAS __attribute__((address_space(3)))
typedef unsigned short bf16;
typedef unsigned v4u __attribute__((ext_vector_type(4)));
typedef unsigned v2u __attribute__((ext_vector_type(2)));
typedef float f32x4 __attribute__((ext_vector_type(4)));
typedef float f32x16 __attribute__((ext_vector_type(16)));
typedef short bf16x8 __attribute__((ext_vector_type(8)));
typedef short s16x4 __attribute__((ext_vector_type(4)));
#define LDS_WAIT() asm volatile("s_waitcnt lgkmcnt(0)" ::: "memory")
using pg8::cvt_pk_bf16;
__device__ __forceinline__ int crow(int r, int h) { return (r & 3) + 8 * (r >> 2) + 4 * h; }
__device__ __forceinline__ float ex2(float x) { return __builtin_amdgcn_exp2f(x); }
__device__ __forceinline__ float lg2(float x) { return __builtin_amdgcn_logf(x); }

#define XB_TMO      128
#define XB_XCNT(j)  (256  + 64 * (j))
#define XB_XSUB(j)  (1280 + 64 * (j))
#define XB_XGEN(j)  (2304 + 64 * (j))
#define XB_TOP      3328
#define XB_TOPGEN   3392
#define XCD_BAR_WORDS 3456
#define XB_SPIN_CAP (1u << 20)
__device__ __forceinline__ unsigned xb_ld(unsigned* p)              { return __hip_atomic_load(p, __ATOMIC_RELAXED, __HIP_MEMORY_SCOPE_AGENT); }
__device__ __forceinline__ unsigned xb_add(unsigned* p, unsigned v) { return __hip_atomic_fetch_add(p, v, __ATOMIC_RELAXED, __HIP_MEMORY_SCOPE_AGENT); }
__device__ __forceinline__ unsigned xb_xcc_id() { return (unsigned)__builtin_amdgcn_s_getreg((3 << 11) | 20) & 0xFu; }
#define XB_SPIN(cond, bar) do { unsigned _sp = 0; while (cond) { __builtin_amdgcn_s_sleep(1); \
    if ((++_sp & 255u) == 0u) { if (xb_ld(&(bar)[XB_TMO])) break; if (_sp > XB_SPIN_CAP) { atomicAdd(&(bar)[XB_TMO], 1u); break; } } } } while (0)
struct XcdBarrier { unsigned* bar; unsigned x; volatile LAS unsigned* st; };
__device__ __forceinline__ XcdBarrier xcd_barrier_post(unsigned* bar, volatile LAS unsigned* st) {
    XcdBarrier b; b.bar = bar; b.x = xb_xcc_id(); b.st = st;
    if (threadIdx.x == 0) (void)xb_add(&bar[XB_XCNT(b.x)], 1u);
    return b;
}
__device__ __forceinline__ void xcd_barrier_complete(unsigned* bar, unsigned x, unsigned& nloc, unsigned& nx) {
    const unsigned G = gridDim.x * gridDim.y * gridDim.z;
    unsigned sum, cnt, mine, sp = 0u;
    for (;;) {
        sum = 0u; cnt = 0u; mine = 0u;
#pragma unroll
        for (unsigned j = 0; j < 16; ++j) { const unsigned c = xb_ld(&bar[XB_XCNT(j)]); sum += c; cnt += (c > 0u) ? 1u : 0u; mine = (j == x) ? c : mine; }
        if (sum == G) break;
        __builtin_amdgcn_s_sleep(1);
        if ((++sp & 255u) == 0u) { if (xb_ld(&bar[XB_TMO])) break; if (sp > XB_SPIN_CAP) { atomicAdd(&bar[XB_TMO], 1u); break; } }
    }
    nloc = mine > 0u ? mine : 1u; nx = cnt > 0u ? cnt : 1u;
}
__device__ __forceinline__ void xcd_barrier(const XcdBarrier& b) {
    asm volatile("s_waitcnt vmcnt(0)" ::: "memory");
    __syncthreads();
    if (threadIdx.x == 0) {
        unsigned* bar = b.bar;
        __builtin_amdgcn_s_waitcnt(0);
        unsigned nloc = b.st[0], nx = b.st[1];
        if (nloc == 0u) { xcd_barrier_complete(bar, b.x, nloc, nx); b.st[0] = nloc; b.st[1] = nx; }
        const unsigned old = xb_add(&bar[XB_XSUB(b.x)], 1u);
        const unsigned gen = old / nloc;
        if (old + 1u == (gen + 1u) * nloc) {
            __builtin_amdgcn_fence(__ATOMIC_RELEASE, "agent");
            asm volatile("s_waitcnt vmcnt(0)" ::: "memory");
            const unsigned og = xb_add(&bar[XB_TOP], 1u);
            const unsigned tg = og / nx;
            if (og + 1u == (tg + 1u) * nx) xb_add(&bar[XB_TOPGEN], 1u);
            else XB_SPIN(xb_ld(&bar[XB_TOPGEN]) == tg, bar);
            __builtin_amdgcn_fence(__ATOMIC_ACQUIRE, "agent");
            xb_add(&bar[XB_XGEN(b.x)], 1u);
            asm volatile("s_waitcnt vmcnt(0)" ::: "memory");
        } else {
            XB_SPIN(xb_ld(&bar[XB_XGEN(b.x)]) == gen, bar);
            __builtin_amdgcn_fence(__ATOMIC_ACQUIRE, "agent");
            asm volatile("s_waitcnt vmcnt(0)" ::: "memory");
        }
    }
    __syncthreads();
}

struct Args { const float* in[29]; float* out; unsigned char* ws; double invf[64]; int ph_lo, ph_hi, li, pad; };
struct Ctx {
    const float* const* in; float* out; unsigned char* ws; LAS unsigned char* lds;
    int tid, lane, wave, G, bid, gw, NGW;
};
__device__ __forceinline__ bf16* wsb(const Ctx& C, size_t off) { return (bf16*)(C.ws + off); }
__device__ __forceinline__ float* wsf(const Ctx& C, size_t off) { return (float*)(C.ws + off); }

__device__ __forceinline__ float wave_sum(float v) {
#pragma unroll
    for (int o = 1; o < 64; o <<= 1) v += __shfl_xor(v, o);
    return v;
}
__device__ __forceinline__ float wave_max(float v) {
#pragma unroll
    for (int o = 1; o < 64; o <<= 1) v = fmaxf(v, __shfl_xor(v, o));
    return v;
}

__device__ __forceinline__ void conv_item(const float* __restrict__ src, int ldsrc, int col4, int k0, bf16* dst, int ldd, int drow0, int lane) {
    const int ng = lane & 7, kg = lane >> 3;
    f32x4 v[8];
    if (col4 >= 0) {
#pragma unroll
        for (int i = 0; i < 8; ++i) v[i] = __builtin_nontemporal_load((const f32x4*)(src + (size_t)(k0 + 8 * kg + i) * ldsrc + col4)); }
    else {
#pragma unroll
        for (int i = 0; i < 8; ++i) v[i] = (f32x4){0.f, 0.f, 0.f, 0.f}; }
    bf16* dp = dst + (size_t)(drow0 + 4 * ng) * ldd + k0 + 8 * kg;
#pragma unroll
    for (int j = 0; j < 4; ++j) { v4u o; o.x = cvt_pk_bf16(v[0][j], v[1][j]); o.y = cvt_pk_bf16(v[2][j], v[3][j]); o.z = cvt_pk_bf16(v[4][j], v[5][j]); o.w = cvt_pk_bf16(v[6][j], v[7][j]);
        *(v4u*)(dp + (size_t)j * ldd) = o; }
}
__device__ __forceinline__ int win_srccol(int p) {
    if (p >= IN_COLS) return -1;
    const bool rope = (p >= 3072 && p < 4352) || (p >= 4608 && p < 4864) || (p >= 5120 && p < 5376);
    if (!rope) return p;
    const int hb = p & ~127, pp = p & 127, wc = pp >> 5, n = (pp >> 4) & 1, r = pp & 15;
    return hb + 64 * n + 16 * wc + r;
}
__device__ __forceinline__ int job_items(int job) { return (job == 0 || job == 2) ? 11008 : ((job == 1 || job == 3) ? 5504 : (job == 4 ? 5888 : (job <= 9 ? 2048 : (job <= 11 ? 512 : 16)))); }
__device__ __forceinline__ void conv_job(const Ctx& C, int job, int r) {
    const int lane = C.lane, ng4 = 4 * (lane & 7);
    if (job == 0 || job == 2) { const int f = job == 2; const int ndb = NGU / 32, db = r % ndb, kb = r / ndb, p0 = db * 32, tile = p0 >> 8, rr = p0 & 255;
        const float* src = C.in[rr < 128 ? (f ? 24 : 4) : (f ? 25 : 5)];
        conv_item(src, FF, tile * 128 + (rr & 127) + ng4, kb * 64, wsb(C, f ? WS_WGU2 : WS_WGU1), D, p0, lane); }
    else if (job == 1 || job == 3) { const int f = job == 3; const int db = r % 64, kb = r / 64;
        conv_item(C.in[f ? 26 : 6], D, db * 32 + ng4, kb * 64, wsb(C, f ? WS_WD2 : WS_WD1), FF, db * 32, lane); }
    else if (job == 4) { const int ndb = INP / 32, db = r % ndb, kb = r / ndb;
        conv_item(C.in[7], IN_COLS, win_srccol(db * 32 + ng4), kb * 64, wsb(C, WS_WIN), D, db * 32, lane); }
    else if (job == 6) { const int db = r % 64, kb = r / 64; const int ng = lane & 7, kg = lane >> 3;
        const float* src = C.in[18] + (size_t)(kb * 64 + 8 * kg) * D + db * 32 + 4 * ng; bf16* dst = wsb(C, WS_WQ) + (size_t)(kb * 64 + 8 * kg) * D + db * 32 + 4 * ng;
#pragma unroll
        for (int i = 0; i < 8; ++i) *(v2u*)(dst + (size_t)i * D) = pg8::pack4(__builtin_nontemporal_load((const f32x4*)(src + (size_t)i * D))); }
    else if (job <= 9) { const int w = job - 5, db = r % 64, kb = r / 64;
        const float* src = C.in[w == 0 ? 15 : 17 + w];
        const size_t dst = w == 0 ? WS_WOUT : (w == 1 ? WS_WQ : (w == 2 ? WS_WK : (w == 3 ? WS_WV : WS_WO)));
        conv_item(src, D, db * 32 + ng4, kb * 64, wsb(C, dst), D, db * 32, lane); }
    else if (job <= 11) { const int kv = job - 10, db = r % 8, kb = r / 8;
        conv_item(C.in[kv ? 12 : 9], 256, db * 32 + ng4, kb * 64, wsb(C, WS_W1T) + (size_t)kv * 256 * 4096, 4096, db * 32, lane); }
    else { const int kv = job - 12, db = r % 4, kb = r / 4;
        conv_item(C.in[kv ? 13 : 10], 128, db * 32 + ng4, kb * 64, wsb(C, WS_W2T) + (size_t)kv * 128 * 256, 256, db * 32, lane); }
}
template <unsigned MASK> __device__ __forceinline__ void conv_static(const Ctx& C, int w, int nw) {
    int base = 0;
#pragma unroll 1
    for (int job = 0; job < 14; ++job) { if (!((MASK >> job) & 1u)) continue; const int n = job_items(job);
        int first = (w - base % nw + nw) % nw;
#pragma unroll 1
        for (int r = first; r < n; r += nw) conv_job(C, job, r);
        base += n; }
}
template <unsigned MASK> __device__ __forceinline__ void conv_dynamic(const Ctx& C, unsigned* ctr) {
    int total = 0;
#pragma unroll
    for (int job = 0; job < 14; ++job) if ((MASK >> job) & 1u) total += job_items(job);
    for (;;) {
        unsigned idx = 0; if (C.lane == 0) idx = __hip_atomic_fetch_add(ctr, 8u, __ATOMIC_RELAXED, __HIP_MEMORY_SCOPE_AGENT);
        const int r0 = __builtin_amdgcn_readfirstlane((int)idx); if (r0 >= total) break;
#pragma unroll 1
        for (int k = 0; k < 8; ++k) { int r = r0 + k; if (r >= total) break;
            int job = 0;
#pragma unroll 1
            for (; job < 14; ++job) { if (!((MASK >> job) & 1u)) continue; const int n = job_items(job); if (r < n) break; r -= n; }
            conv_job(C, job, r); }
    }
}
constexpr unsigned JOBS_P0 = (1u << 0) | (1u << 7) | (1u << 8);
constexpr unsigned JOBS_P1 = (1u << 1) | (1u << 4) | (1u << 6) | (1u << 9) | (1u << 10) | (1u << 11) | (1u << 12) | (1u << 13);
constexpr unsigned JOBS_P7 = (1u << 2) | (1u << 3) | (1u << 5);
constexpr int CW_CONVCTR = 1024;

__device__ __forceinline__ void sincos_d(double r, float& c, float& s) {
    const double x = 0.25 * r, x2 = x * x;
    double sn = x * (1.0 + x2 * (-1.0 / 6 + x2 * (1.0 / 120 + x2 * (-1.0 / 5040 + x2 * (1.0 / 362880 + x2 * (-1.0 / 39916800 + x2 * (1.0 / 6227020800.0)))))));
    double cs = 1.0 + x2 * (-0.5 + x2 * (1.0 / 24 + x2 * (-1.0 / 720 + x2 * (1.0 / 40320 + x2 * (-1.0 / 3628800 + x2 * (1.0 / 479001600.0))))));
    double s2 = 2.0 * sn * cs, c2 = 1.0 - 2.0 * sn * sn;
    double s4 = 2.0 * s2 * c2, c4 = 1.0 - 2.0 * s2 * s2;
    c = (float)c4; s = (float)s4;
}
__device__ __forceinline__ void p0_prologue(const Ctx& C, const double* invf, bool first) {
    const int lane = C.lane;
    conv_static<JOBS_P0>(C, C.gw, C.NGW);
    { const int gt = C.gw * 64 + lane, NT = C.NGW * 64;
      const float* x = C.in[0]; bf16* xb = wsb(C, WS_XB);
      for (int i = gt; i < T * D / 8; i += NT) { const f32x4 a = *(const f32x4*)(x + (size_t)i * 8), b = *(const f32x4*)(x + (size_t)i * 8 + 4);
          v4u o; o.x = cvt_pk_bf16(a[0], a[1]); o.y = cvt_pk_bf16(a[2], a[3]); o.z = cvt_pk_bf16(b[0], b[1]); o.w = cvt_pk_bf16(b[2], b[3]); *(v4u*)(xb + (size_t)i * 8) = o; }
      const float* mem = C.in[1]; bf16* mb = wsb(C, WS_MEMB);
      for (int i = gt; i < MEMT * D / 8; i += NT) { const f32x4 a = *(const f32x4*)(mem + (size_t)i * 8), b = *(const f32x4*)(mem + (size_t)i * 8 + 4);
          v4u o; o.x = cvt_pk_bf16(a[0], a[1]); o.y = cvt_pk_bf16(a[2], a[3]); o.z = cvt_pk_bf16(b[0], b[1]); o.w = cvt_pk_bf16(b[2], b[3]); *(v4u*)(mb + (size_t)i * 8) = o; }
      float* rope = wsf(C, WS_ROPE);
      for (int i = gt; i < T * 64; i += NT) { const int pos = i >> 6, fi = i & 63; const double ang = (double)pos * invf[fi];
          const double n = rint(ang * 0.15915494309189535); const double rr = fma(-n, 6.283185307179586, ang) - n * 2.4492935982947064e-16;
          float c, s; sincos_d(rr, c, s); rope[2 * (size_t)i] = c; rope[2 * (size_t)i + 1] = s; }
    }
    if (first) for (int task = C.gw; task < 2 * 4 * 32; task += C.NGW) { const int kv = task >> 7, nch = (task >> 5) & 3, kch = task & 31, n = nch * 64 + lane;
        const float* pos = C.in[kv ? 11 : 8]; const float* w1 = C.in[kv ? 12 : 9]; float acc = 0.f;
#pragma unroll 8
        for (int k = kch * 128; k < kch * 128 + 128; ++k) acc += pos[k] * w1[(size_t)k * 256 + n];
        atomicAdd((float*)(C.ws + CTL_BIAS1) + kv * 256 + n, acc); }
}

__device__ __forceinline__ void ln_rows(const Ctx& C, const float* Y, const float* g, const float* b, float* X, bf16* Xb) {
    for (int row = C.gw; row < T; row += C.NGW) {
        const f32x4* yr = (const f32x4*)(Y + (size_t)row * D) + C.lane;
        f32x4 v[8]; float s = 0.f;
#pragma unroll
        for (int j = 0; j < 8; ++j) { v[j] = yr[64 * j]; s += (v[j][0] + v[j][1]) + (v[j][2] + v[j][3]); }
        const float mean = wave_sum(s) * (1.f / D); float s2 = 0.f;
#pragma unroll
        for (int j = 0; j < 8; ++j) { v[j] = v[j] - mean; s2 += (v[j][0] * v[j][0] + v[j][1] * v[j][1]) + (v[j][2] * v[j][2] + v[j][3] * v[j][3]); }
        const float rstd = 1.f / sqrtf(wave_sum(s2) * (1.f / D) + LN_EPS);
#pragma unroll
        for (int j = 0; j < 8; ++j) { const f32x4 gg = *((const f32x4*)g + C.lane + 64 * j), bb = *((const f32x4*)b + C.lane + 64 * j);
            const f32x4 o = v[j] * rstd * gg + bb;
            *((f32x4*)(X + (size_t)row * D) + C.lane + 64 * j) = o;
            if (Xb) *((v2u*)(Xb + (size_t)row * D) + C.lane + 64 * j) = pg8::pack4(o); }
    }
}
__device__ __forceinline__ void rms_rows(const Ctx& C, const float* O, const float* g, bf16* Yb) {
    const int half = C.lane >> 5, l5 = C.lane & 31;
    for (int row = C.gw; row < T; row += C.NGW) {
        const f32x4* orow = (const f32x4*)(O + (size_t)row * D + half * 1024) + l5;
        f32x4 v[8]; float s2 = 0.f;
#pragma unroll
        for (int j = 0; j < 8; ++j) { v[j] = orow[32 * j]; s2 += (v[j][0] * v[j][0] + v[j][1] * v[j][1]) + (v[j][2] * v[j][2] + v[j][3] * v[j][3]); }
#pragma unroll
        for (int o = 1; o < 32; o <<= 1) s2 += __shfl_xor(s2, o);
        const float rstd = 1.f / sqrtf(s2 * (1.f / 1024.f) + RMS_EPS);
#pragma unroll
        for (int j = 0; j < 8; ++j) { const f32x4 gg = *((const f32x4*)(g + half * 1024) + l5 + 32 * j);
            *((v2u*)(Yb + (size_t)row * D + half * 1024) + l5 + 32 * j) = pg8::pack4(v[j] * rstd * gg); }
    }
}
__device__ __forceinline__ void softmax_rows(const Ctx& C, const float* S, bf16* P) {
    for (int row = C.gw; row < MEMH * T; row += C.NGW) {
        const f32x4 v = *((const f32x4*)(S + (size_t)row * MEMT) + C.lane);
        const float m = wave_max(fmaxf(fmaxf(v[0], v[1]), fmaxf(v[2], v[3])));
        f32x4 e; float s = 0.f;
#pragma unroll
        for (int j = 0; j < 4; ++j) { e[j] = ex2((v[j] - m) * LOG2E); s += e[j]; }
        const float inv = 1.f / wave_sum(s);
        *((v2u*)(P + (size_t)row * MEMT) + C.lane) = pg8::pack4(e * inv);
    }
}

__device__ __forceinline__ float gelu_tanh(float x) {
    const float u = 0.7978845608028654f * (x + 0.044715f * x * x * x);
    const float th = 1.f - 2.f * __builtin_amdgcn_rcpf(1.f + ex2(2.f * LOG2E * u));
    return 0.5f * x * (1.f + th);
}
__device__ __forceinline__ void compress_l2(const Ctx& C) {
    const int lane = C.lane, r32 = lane & 31, h = lane >> 5;
    const float* PC = wsf(C, WS_PC); const float* bias1 = (const float*)(C.ws + CTL_BIAS1);
    for (int task = C.gw; task < 2 * 2 * 16 * 4; task += C.NGW) {
        const int nt = task & 3, rt = (task >> 2) & 15, g = (task >> 6) & 1, kv = task >> 7;
        const bf16* w2 = wsb(C, WS_W2T) + (size_t)kv * 128 * 256 + (size_t)(nt * 32 + r32) * 256 + 8 * h;
        f32x16 acc = {};
#pragma unroll 2
        for (int s = 0; s < 16; ++s) {
            const int k0 = 16 * s + 8 * h; f32x4 a0 = *(const f32x4*)(bias1 + kv * 256 + k0), a1 = *(const f32x4*)(bias1 + kv * 256 + k0 + 4);
#pragma unroll
            for (int kc = 0; kc < 8; ++kc) { const float* p = PC + ((((size_t)kc * 2 + kv) * 2 + g) * 512 + rt * 32 + r32) * 256 + k0;
                a0 = a0 + *(const f32x4*)p; a1 = a1 + *(const f32x4*)(p + 4); }
            v4u aw; aw.x = cvt_pk_bf16(gelu_tanh(a0[0]), gelu_tanh(a0[1])); aw.y = cvt_pk_bf16(gelu_tanh(a0[2]), gelu_tanh(a0[3]));
            aw.z = cvt_pk_bf16(gelu_tanh(a1[0]), gelu_tanh(a1[1])); aw.w = cvt_pk_bf16(gelu_tanh(a1[2]), gelu_tanh(a1[3]));
            const bf16x8 bw = *(const bf16x8*)(w2 + 16 * s);
            acc = __builtin_amdgcn_mfma_f32_32x32x16_bf16(__builtin_bit_cast(bf16x8, aw), bw, acc, 0, 0, 0);
        }
        if (kv == 0) { bf16* o = wsb(C, WS_KCMP) + (size_t)g * 512 * 128; const int d = nt * 32 + r32;
#pragma unroll
            for (int r = 0; r < 16; ++r) { const int row = rt * 32 + crow(r, h); o[(size_t)row * 128 + (((d >> 3) ^ (row & 15)) << 3) + (d & 7)] = row < NCMP ? (bf16)(cvt_pk_bf16(acc[r], 0.f) & 0xffffu) : (bf16)0; } }
        else { const int d = nt * 32 + r32; bf16* o = wsb(C, WS_VCMPT) + ((size_t)g * 16 + rt) * 128 * 32 + (size_t)d * 32;
#pragma unroll
            for (int gq = 0; gq < 4; ++gq) { const int rl = 8 * gq + 4 * h; f32x4 v = {acc[4 * gq], acc[4 * gq + 1], acc[4 * gq + 2], acc[4 * gq + 3]};
#pragma unroll
                for (int i = 0; i < 4; ++i) if (rt * 32 + rl + i >= NCMP) v[i] = 0.f;
                *(v2u*)(o + (((2 * (gq >> 1) + h) ^ ((d >> 2) & 3)) << 3) + (gq & 1) * 4) = pg8::pack4(v); } }
    }
}

__device__ __forceinline__ f32x16 qk_tile_g(const bf16* Ktile, const bf16x8 (&qf)[8], int r32, int h) {
    f32x16 st = {}; const bf16* kr = Ktile + (size_t)r32 * 128; const int sw = (r32 & 15) ^ h;
#pragma unroll
    for (int s = 0; s < 8; ++s) st = __builtin_amdgcn_mfma_f32_32x32x16_bf16(*(const bf16x8*)(kr + ((sw ^ (2 * s)) << 3)), qf[s], st, 0, 0, 0);
    return st;
}
__device__ __forceinline__ bf16x8 ones_frag(int h) { v4u v = {h == 0 ? 0x3F80u : 0u, 0u, 0u, 0u}; return __builtin_bit_cast(bf16x8, v); }
__device__ __forceinline__ bf16x8 neg_frag(float mref, int h) { v4u v = {h == 0 ? ((__builtin_bit_cast(unsigned, -mref)) >> 16) : 0u, 0u, 0u, 0u}; return __builtin_bit_cast(bf16x8, v); }
__device__ __forceinline__ float bf16_round(float x) { return __builtin_bit_cast(float, cvt_pk_bf16(x, 0.f) << 16); }
__device__ __forceinline__ f32x16 qk_tile_lr(const LAS unsigned char* kslot, const bf16x8 (&qf)[8], int r32, int h, bf16x8 mfrag) {
    f32x16 st = __builtin_amdgcn_mfma_f32_32x32x16_bf16(ones_frag(h), mfrag, f32x16{}, 0, 0, 0);
    const LAS unsigned char* kr = kslot + r32 * 256; const int sw = ((r32 & 15) ^ h) << 4;
#pragma unroll
    for (int s = 0; s < 4; ++s) st = __builtin_amdgcn_mfma_f32_32x32x16_bf16(*(const LAS bf16x8*)(kr + (sw ^ (s << 5))), qf[s], st, 0, 0, 0);
#if AT_SB
    __builtin_amdgcn_sched_barrier(0);
#endif
#pragma unroll
    for (int s = 4; s < 8; ++s) st = __builtin_amdgcn_mfma_f32_32x32x16_bf16(*(const LAS bf16x8*)(kr + (sw ^ (s << 5))), qf[s], st, 0, 0, 0);
    return st;
}
__device__ __forceinline__ f32x16 qk_tile_l(const LAS unsigned char* kslot, const bf16x8 (&qf)[8], int r32, int h) {
    f32x16 st = {}; const LAS unsigned char* kr = kslot + r32 * 256; const int sw = ((r32 & 15) ^ h) << 4;
#pragma unroll
    for (int s = 0; s < 8; ++s) st = __builtin_amdgcn_mfma_f32_32x32x16_bf16(*(const LAS bf16x8*)(kr + (sw ^ (s << 5))), qf[s], st, 0, 0, 0);
    return st;
}
__device__ __forceinline__ void pack_w(const float (&w)[16], bf16x8& b0, bf16x8& b1) {
    v4u p0, p1;
    p0.x = cvt_pk_bf16(w[0], w[1]); p0.y = cvt_pk_bf16(w[2], w[3]); p0.z = cvt_pk_bf16(w[4], w[5]); p0.w = cvt_pk_bf16(w[6], w[7]);
    p1.x = cvt_pk_bf16(w[8], w[9]); p1.y = cvt_pk_bf16(w[10], w[11]); p1.z = cvt_pk_bf16(w[12], w[13]); p1.w = cvt_pk_bf16(w[14], w[15]);
    b0 = __builtin_bit_cast(bf16x8, p0); b1 = __builtin_bit_cast(bf16x8, p1);
}
__device__ __forceinline__ void pv_tile_g(f32x16 (&o)[4], const bf16* Vtile, const float (&w)[16], int r32, int h) {
    bf16x8 b0, b1; pack_w(w, b0, b1);
#pragma unroll
    for (int db = 0; db < 4; ++db) { const int d = 32 * db + r32; const bf16* vr = Vtile + (size_t)d * 32; const int sw = ((d >> 2) & 3) ^ h;
        const bf16x8 f0 = *(const bf16x8*)(vr + (sw << 3)), f1 = *(const bf16x8*)(vr + ((sw ^ 2) << 3));
        o[db] = __builtin_amdgcn_mfma_f32_32x32x16_bf16(f0, b0, o[db], 0, 0, 0);
        o[db] = __builtin_amdgcn_mfma_f32_32x32x16_bf16(f1, b1, o[db], 0, 0, 0); }
}
__device__ __forceinline__ void pv_tile_lb(f32x16 (&o)[4], const LAS unsigned char* vslot, bf16x8 b0, bf16x8 b1, int r32, int h) {
    const int sw = (((r32 >> 2) & 3) ^ h) << 4;
#pragma unroll
    for (int db = 0; db < 4; ++db) { const LAS unsigned char* vr = vslot + (32 * db + r32) * 64; if (AT_SB && db == 2) __builtin_amdgcn_sched_barrier(0);
        const bf16x8 f0 = *(const LAS bf16x8*)(vr + sw), f1 = *(const LAS bf16x8*)(vr + (sw ^ 32));
        o[db] = __builtin_amdgcn_mfma_f32_32x32x16_bf16(f0, b0, o[db], 0, 0, 0);
        o[db] = __builtin_amdgcn_mfma_f32_32x32x16_bf16(f1, b1, o[db], 0, 0, 0); }
}
__device__ __forceinline__ void pv_tile_l(f32x16 (&o)[4], const LAS unsigned char* vslot, const float (&w)[16], int r32, int h) { bf16x8 b0, b1; pack_w(w, b0, b1); pv_tile_lb(o, vslot, b0, b1, r32, h); }

__device__ __forceinline__ void sb_item(const Ctx& C, int hd, int qt, float* Oatt) {
    const int lane = C.lane, c = lane & 31, h = lane >> 5, t = 32 * qt + c;
    const bf16* Qp = wsb(C, WS_BIG + BG_SBQ) + ((size_t)hd * T + t) * 128 + 8 * h;
    bf16x8 qf[8];
#pragma unroll
    for (int s = 0; s < 8; ++s) qf[s] = *(const bf16x8*)(Qp + 16 * s);
    const bf16* Kh = wsb(C, WS_BIG + BG_SBK) + (size_t)hd * T * 128; const bf16* Vh = wsb(C, WS_BIG + BG_SBVT) + (size_t)hd * T * 128;
    f32x16 o[4] = {}; float carry = 0.f;
    for (int kt = qt; kt >= 0; --kt) {
        const f32x16 st = qk_tile_g(Kh + (size_t)kt * 4096, qf, c, h);
        float l1m[16], lb[16], w[16];
#pragma unroll
        for (int r = 0; r < 16; ++r) { const int key = 32 * kt + crow(r, h); const float z = st[r];
            const float sp = fmaxf(z, 0.f) + lg2(1.f + ex2(-fabsf(z)));
            const bool valid = key < t; l1m[r] = valid ? -sp : 0.f; lb[r] = z - sp; }
        float G[4], PG[4], TT[4];
#pragma unroll
        for (int q = 0; q < 4; ++q) { G[q] = (l1m[4 * q] + l1m[4 * q + 1]) + (l1m[4 * q + 2] + l1m[4 * q + 3]); PG[q] = __shfl_xor(G[q], 32); TT[q] = G[q] + PG[q]; }
        const float SS[4] = {TT[3] + TT[2] + TT[1], TT[3] + TT[2], TT[3], 0.f};
#pragma unroll
        for (int q = 0; q < 4; ++q) { const float before = carry + SS[q] + (h == 0 ? PG[q] : 0.f);
            const float l3 = before, l2 = l3 + l1m[4 * q + 3], l1 = l2 + l1m[4 * q + 2], l0 = l1 + l1m[4 * q + 1];
            const float ls[4] = {l0, l1, l2, l3};
#pragma unroll
            for (int i = 0; i < 4; ++i) { const int r = 4 * q + i; const int key = 32 * kt + crow(r, h); w[r] = key < t ? ex2(lb[r] + ls[i]) : 0.f; } }
        carry += (TT[0] + TT[1]) + (TT[2] + TT[3]);
        pv_tile_g(o, Vh + (size_t)kt * 4096, w, c, h);
        if (__all(carry < -150.f)) break;
    }
    float* op = Oatt + (size_t)t * D + hd * 128 + 4 * h;
#pragma unroll
    for (int db = 0; db < 4; ++db)
#pragma unroll
        for (int q = 0; q < 4; ++q) *(f32x4*)(op + 32 * db + 8 * q) = (f32x4){o[db][4 * q], o[db][4 * q + 1], o[db][4 * q + 2], o[db][4 * q + 3]};
}

constexpr int AT_NS = 4, AT_SLOT = 16384, AT_RING = AT_NS * AT_SLOT;
#ifndef AT_PINGPONG
#define AT_PINGPONG 0
#endif
#ifndef AT_SB
#define AT_SB 1
#endif
__device__ __forceinline__ void glds16s(const void* sbase, unsigned voff, unsigned lds_dst) { unsigned keep;
    asm volatile("s_mov_b32 %0, m0\n\ts_mov_b32 m0, %3\n\ts_nop 0\n\tglobal_load_lds_dwordx4 %1, %2\n\ts_mov_b32 m0, %0" : "=&s"(keep) : "v"(voff), "s"(sbase), "s"(lds_dst) : "memory"); }
__device__ __forceinline__ const bf16* uni_ptr(const bf16* p) { const unsigned long long v = (unsigned long long)(uintptr_t)p;
    return (const bf16*)(uintptr_t)(((unsigned long long)(unsigned)__builtin_amdgcn_readfirstlane((int)(v >> 32)) << 32) | (unsigned)__builtin_amdgcn_readfirstlane((int)v)); }
#define AT_WAITBAR(N) asm volatile("s_waitcnt vmcnt(" #N ") lgkmcnt(0)\n\ts_barrier" ::: "memory")
template <bool HASV, class BodyA, class BodyB>
__device__ __forceinline__ void stream_tiles(unsigned ring0, const bf16* Kt0, const bf16* Vt0, int ntiles, int wave, int lane, BodyA bodyA, BodyB bodyB) {
    const bf16* kb = uni_ptr(Kt0); const bf16* vb = uni_ptr(Vt0);
    const unsigned voff = (unsigned)(wave * 1024 + lane * 16);
    const unsigned kdst = ring0 + wave * 1024, vdst = kdst + 8192;
    const int grp = wave >> 2;
    AT_WAITBAR(0);
#pragma unroll
    for (int j = 0; j < AT_NS - 1; ++j) if (j < ntiles) {
        glds16s(kb + (size_t)j * 4096, voff, (unsigned)__builtin_amdgcn_readfirstlane(kdst + j * AT_SLOT));
        if (HASV) glds16s(vb + (size_t)j * 4096, voff, (unsigned)__builtin_amdgcn_readfirstlane(vdst + j * AT_SLOT)); }
#if AT_PINGPONG
#pragma unroll 1
    for (int hs = 0; hs <= 2 * ntiles; ++hs) {
        const int i = hs >> 1;
        if (!(hs & 1)) {
            const int rem = ntiles - 1 - i;
            if (rem >= 2) { if (HASV) AT_WAITBAR(4); else AT_WAITBAR(2); }
            else if (rem == 1) { if (HASV) AT_WAITBAR(2); else AT_WAITBAR(1); }
            else AT_WAITBAR(0);
        } else {
            asm volatile("s_waitcnt lgkmcnt(0)\n\ts_barrier" ::: "memory");
            const int jn = i + AT_NS - 1;
            if (jn < ntiles) { const int sl = (jn & (AT_NS - 1)) * AT_SLOT;
                glds16s(kb + (size_t)jn * 4096, voff, (unsigned)__builtin_amdgcn_readfirstlane(kdst + sl));
                if (HASV) glds16s(vb + (size_t)jn * 4096, voff, (unsigned)__builtin_amdgcn_readfirstlane(vdst + sl)); }
        }
        if ((hs & 1) == grp) { if (i < ntiles) bodyA(i, (i & (AT_NS - 1)) * AT_SLOT); }
        else { const int ib = grp ? i - 1 : i; if (ib >= 0 && ib < ntiles) bodyB(ib, (ib & (AT_NS - 1)) * AT_SLOT); }
    }
#else
    (void)grp;
#pragma unroll 1
    for (int i = 0; i < ntiles; ++i) {
        const int rem = ntiles - 1 - i;
        if (rem >= 2) { if (HASV) AT_WAITBAR(4); else AT_WAITBAR(2); }
        else if (rem == 1) { if (HASV) AT_WAITBAR(2); else AT_WAITBAR(1); }
        else AT_WAITBAR(0);
        const int jn = i + AT_NS - 1;
        if (jn < ntiles) { const int sl = (jn & (AT_NS - 1)) * AT_SLOT;
            glds16s(kb + (size_t)jn * 4096, voff, (unsigned)__builtin_amdgcn_readfirstlane(kdst + sl));
            if (HASV) glds16s(vb + (size_t)jn * 4096, voff, (unsigned)__builtin_amdgcn_readfirstlane(vdst + sl)); }
        bodyA(i, (i & (AT_NS - 1)) * AT_SLOT); bodyB(i, (i & (AT_NS - 1)) * AT_SLOT);
    }
#endif
}

constexpr float AT_THR = 10.f;
__device__ __forceinline__ float max3f(float a, float b, float c) { return fmaxf(fmaxf(a, b), c); }
__device__ __forceinline__ void xhalf_pair(float v, float& lo, float& hi) { unsigned a = __builtin_bit_cast(unsigned, v), b2;
    asm volatile("s_nop 1\n\tv_mov_b32 %1, %0\n\ts_nop 1\n\tv_permlane32_swap_b32 %0, %1\n\ts_nop 1" : "+v"(a), "=&v"(b2));
    lo = __builtin_bit_cast(float, a); hi = __builtin_bit_cast(float, b2); }
__device__ __forceinline__ float xhalf_max(float v) { float lo, hi; xhalf_pair(v, lo, hi); return fmaxf(lo, hi); }
__device__ __forceinline__ float xhalf_sum(float v) { float lo, hi; xhalf_pair(v, lo, hi); return lo + hi; }
template <bool MASKED, class MaskF>
__device__ __forceinline__ void flash_B(f32x16& st, float& mref, float& l, f32x16 (&o)[4], const LAS unsigned char* vslot, int c, int h, bool lane_on, MaskF valid) {
    if (MASKED) {
#pragma unroll
        for (int r = 0; r < 16; ++r) st[r] = valid(r) ? st[r] : -INFINITY; }
    float tm = max3f(st[0], st[1], st[2]);
#pragma unroll
    for (int r = 3; r < 15; r += 2) tm = max3f(tm, st[r], st[r + 1]);
    tm = fmaxf(tm, st[15]);
    tm = lane_on ? tm : -INFINITY;
    tm = xhalf_max(tm);
    const bool trig = tm > AT_THR || (tm < -AT_THR && tm > -INFINITY);
    if (__any(trig)) {
        const float ltot = xhalf_sum(l); const bool need = tm > AT_THR || (trig && ltot == 0.f);
        const float mnew = need ? bf16_round(mref + tm) : mref, dl = mnew - mref, f = ex2(-dl);
        mref = mnew; l *= f;
#pragma unroll
        for (int r = 0; r < 16; ++r) st[r] -= dl;
#pragma unroll
        for (int db = 0; db < 4; ++db) o[db] = o[db] * f;
    }
    float w[16]; float ps = 0.f;
#pragma unroll
    for (int r = 0; r < 16; ++r) { w[r] = ex2(st[r]); ps += w[r]; }
    l += lane_on ? ps : 0.f;
    bf16x8 b0, b1; pack_w(w, b0, b1);
    if (!lane_on) { b0 = bf16x8{}; b1 = bf16x8{}; }
    pv_tile_lb(o, vslot, b0, b1, c, h);
}

constexpr int AB_SLOT = 32768, AB_NS = 4;
template <class Body>
__device__ __forceinline__ void stream_blocks(unsigned ring0, const bf16* Kb0, const bf16* Vb0, int nblocks, int wave, int lane, Body body) {
    const bf16* kb = uni_ptr(Kb0); const bf16* vb = uni_ptr(Vb0);
    const unsigned voff = (unsigned)(wave * 1024 + lane * 16);
    const unsigned dst = ring0 + wave * 1024;
#define AB_ISSUE(j, sl) do { const bf16* ks_ = kb + (size_t)(j) * 8192; const bf16* vs_ = vb + (size_t)(j) * 8192; const unsigned d_ = (unsigned)__builtin_amdgcn_readfirstlane(dst + (sl)); \
        glds16s(ks_, voff, d_); glds16s(ks_ + 4096, voff, d_ + 8192); glds16s(vs_, voff, d_ + 16384); glds16s(vs_ + 4096, voff, d_ + 24576); } while (0)
    AT_WAITBAR(0);
#pragma unroll
    for (int j = 0; j < AB_NS - 1; ++j) if (j < nblocks) AB_ISSUE(j, j * AB_SLOT);
#pragma unroll 1
    for (int i = 0; i < nblocks; ++i) {
        const int rem = nblocks - 1 - i;
        if (rem >= 2) AT_WAITBAR(8); else if (rem == 1) AT_WAITBAR(4); else AT_WAITBAR(0);
        const int jn = i + AB_NS - 1;
        if (jn < nblocks) AB_ISSUE(jn, (jn & (AB_NS - 1)) * AB_SLOT);
        body(i, (i & (AB_NS - 1)) * AB_SLOT);
    }
#undef AB_ISSUE
}
#define FB_SB() __builtin_amdgcn_sched_barrier(0)
#define FB_MF(acc, a, b) acc = __builtin_amdgcn_mfma_f32_32x32x16_bf16(a, b, acc, 0, 0, 0)
#define FB_KF(tile, s) (*(const LAS bf16x8*)(slot + (tile) * 8192 + c * 256 + (swk ^ ((s) << 5))))
#define FB_VF(tile, db, k) (*(const LAS bf16x8*)(slot + 16384 + (tile) * 8192 + (32 * (db) + c) * 64 + (swv ^ ((k) << 5))))
template <class MaskF>
__device__ __forceinline__ void flash_block(float& mref, float& l, f32x16 (&o)[4], const bf16x8 (&qf)[8], const LAS unsigned char* slot, int c, int h, bool lane_on, bool MASKED  , MaskF valid) {
    const int swk = ((c & 15) ^ h) << 4, swv = (((c >> 2) & 3) ^ h) << 4;
    f32x16 s0, s1; bf16x8 ka[4];
#pragma unroll
    for (int s = 0; s < 4; ++s) ka[s] = FB_KF(0, s);
    s0 = __builtin_amdgcn_mfma_f32_32x32x16_bf16(ones_frag(h), neg_frag(mref, h), f32x16{}, 0, 0, 0);
#pragma unroll
    for (int s = 0; s < 4; ++s) FB_MF(s0, ka[s], qf[s]);
    FB_SB();
#pragma unroll
    for (int s = 0; s < 4; ++s) ka[s] = FB_KF(0, 4 + s);
#pragma unroll
    for (int s = 0; s < 4; ++s) FB_MF(s0, ka[s], qf[4 + s]);
    FB_SB();
#pragma unroll
    for (int s = 0; s < 4; ++s) ka[s] = FB_KF(1, s);
    if (MASKED) {
#pragma unroll
        for (int r = 0; r < 16; ++r) s0[r] = valid(0, r) ? s0[r] : -INFINITY; }
    s1 = __builtin_amdgcn_mfma_f32_32x32x16_bf16(ones_frag(h), neg_frag(mref, h), f32x16{}, 0, 0, 0);
    float t0 = max3f(s0[0], s0[1], s0[2]); t0 = max3f(t0, s0[3], s0[4]); FB_SB();
    FB_MF(s1, ka[0], qf[0]); t0 = max3f(t0, s0[5], s0[6]); t0 = max3f(t0, s0[7], s0[8]); t0 = max3f(t0, s0[9], s0[10]); FB_SB();
    FB_MF(s1, ka[1], qf[1]); t0 = max3f(t0, s0[11], s0[12]); t0 = max3f(t0, s0[13], s0[14]); t0 = fmaxf(t0, s0[15]); t0 = lane_on ? t0 : -INFINITY; FB_SB();
    FB_MF(s1, ka[2], qf[2]); t0 = xhalf_max(t0); FB_SB();
    FB_MF(s1, ka[3], qf[3]); FB_SB();
#pragma unroll
    for (int s = 0; s < 4; ++s) ka[s] = FB_KF(1, 4 + s);
    float pend = 0.f;
    { const bool trig = t0 > AT_THR || (t0 < -AT_THR && t0 > -INFINITY);
      if (__any(trig)) { const float ltot = xhalf_sum(l); const bool need = t0 > AT_THR || (trig && ltot == 0.f);
          const float mnew = need ? bf16_round(mref + t0) : mref, dl = mnew - mref, f = ex2(-dl); mref = mnew; l *= f; pend = dl;
#pragma unroll
          for (int r = 0; r < 16; ++r) s0[r] -= dl;
#pragma unroll
          for (int db = 0; db < 4; ++db) o[db] = o[db] * f; } }
    FB_SB();
    float ps = 0.f; v4u p0, p1;
    FB_MF(s1, ka[0], qf[4]);
#pragma unroll
    for (int r = 0; r < 4; ++r) { s0[r] = ex2(s0[r]); ps += s0[r]; }
    p0.x = cvt_pk_bf16(s0[0], s0[1]); p0.y = cvt_pk_bf16(s0[2], s0[3]); FB_SB();
    FB_MF(s1, ka[1], qf[5]);
#pragma unroll
    for (int r = 4; r < 8; ++r) { s0[r] = ex2(s0[r]); ps += s0[r]; }
    p0.z = cvt_pk_bf16(s0[4], s0[5]); p0.w = cvt_pk_bf16(s0[6], s0[7]); FB_SB();
    FB_MF(s1, ka[2], qf[6]);
#pragma unroll
    for (int r = 8; r < 12; ++r) { s0[r] = ex2(s0[r]); ps += s0[r]; }
    p1.x = cvt_pk_bf16(s0[8], s0[9]); p1.y = cvt_pk_bf16(s0[10], s0[11]); FB_SB();
    FB_MF(s1, ka[3], qf[7]);
#pragma unroll
    for (int r = 12; r < 16; ++r) { s0[r] = ex2(s0[r]); ps += s0[r]; }
    p1.z = cvt_pk_bf16(s0[12], s0[13]); p1.w = cvt_pk_bf16(s0[14], s0[15]); FB_SB();
    if (!lane_on) { p0 = v4u{0u, 0u, 0u, 0u}; p1 = v4u{0u, 0u, 0u, 0u}; ps = 0.f; }
    l += ps;
    ka[0] = FB_VF(0, 0, 0); ka[1] = FB_VF(0, 0, 1); ka[2] = FB_VF(0, 1, 0); ka[3] = FB_VF(0, 1, 1);
    if (MASKED) {
#pragma unroll
        for (int r = 0; r < 16; ++r) s1[r] = valid(1, r) ? s1[r] : -INFINITY; }
    float t1 = max3f(s1[0], s1[1], s1[2]);
#pragma unroll
    for (int r = 3; r < 15; r += 2) t1 = max3f(t1, s1[r], s1[r + 1]);
    t1 = fmaxf(t1, s1[15]); t1 = lane_on ? t1 : -INFINITY; t1 = xhalf_max(t1) - pend;
    { const bool trig = t1 > AT_THR || (t1 < -AT_THR && t1 > -INFINITY);
      if (__any(trig || pend != 0.f)) { const float ltot = xhalf_sum(l); const bool need = t1 > AT_THR || (trig && ltot == 0.f);
          const float mnew = need ? bf16_round(mref + t1) : mref, dl = mnew - mref, f = ex2(-dl), d1 = dl + pend; mref = mnew; l *= f;
#pragma unroll
          for (int r = 0; r < 16; ++r) s1[r] -= d1;
#pragma unroll
          for (int db = 0; db < 4; ++db) o[db] = o[db] * f; } }
    FB_SB();
    const bf16x8 b00 = __builtin_bit_cast(bf16x8, p0), b01 = __builtin_bit_cast(bf16x8, p1);
    float pt = 0.f; v4u q0, q1;
    FB_MF(o[0], ka[0], b00);
#pragma unroll
    for (int r = 0; r < 2; ++r) { s1[r] = ex2(s1[r]); pt += s1[r]; }
    q0.x = cvt_pk_bf16(s1[0], s1[1]); FB_SB();
    FB_MF(o[1], ka[2], b00);
#pragma unroll
    for (int r = 2; r < 4; ++r) { s1[r] = ex2(s1[r]); pt += s1[r]; }
    q0.y = cvt_pk_bf16(s1[2], s1[3]); FB_SB();
    FB_MF(o[0], ka[1], b01);
#pragma unroll
    for (int r = 4; r < 6; ++r) { s1[r] = ex2(s1[r]); pt += s1[r]; }
    q0.z = cvt_pk_bf16(s1[4], s1[5]); FB_SB();
    FB_MF(o[1], ka[3], b01);
#pragma unroll
    for (int r = 6; r < 8; ++r) { s1[r] = ex2(s1[r]); pt += s1[r]; }
    q0.w = cvt_pk_bf16(s1[6], s1[7]); FB_SB();
    ka[0] = FB_VF(0, 2, 0); ka[1] = FB_VF(0, 2, 1); ka[2] = FB_VF(0, 3, 0); ka[3] = FB_VF(0, 3, 1);
#pragma unroll
    for (int r = 8; r < 10; ++r) { s1[r] = ex2(s1[r]); pt += s1[r]; }
    q1.x = cvt_pk_bf16(s1[8], s1[9]); FB_SB();
    FB_MF(o[2], ka[0], b00);
#pragma unroll
    for (int r = 10; r < 12; ++r) { s1[r] = ex2(s1[r]); pt += s1[r]; }
    q1.y = cvt_pk_bf16(s1[10], s1[11]); FB_SB();
    FB_MF(o[3], ka[2], b00);
#pragma unroll
    for (int r = 12; r < 14; ++r) { s1[r] = ex2(s1[r]); pt += s1[r]; }
    q1.z = cvt_pk_bf16(s1[12], s1[13]); FB_SB();
    FB_MF(o[2], ka[1], b01);
#pragma unroll
    for (int r = 14; r < 16; ++r) { s1[r] = ex2(s1[r]); pt += s1[r]; }
    q1.w = cvt_pk_bf16(s1[14], s1[15]); FB_SB();
    FB_MF(o[3], ka[3], b01); FB_SB();
    if (!lane_on) { q0 = v4u{0u, 0u, 0u, 0u}; q1 = v4u{0u, 0u, 0u, 0u}; pt = 0.f; }
    l += pt;
    const bf16x8 b10 = __builtin_bit_cast(bf16x8, q0), b11 = __builtin_bit_cast(bf16x8, q1);
    ka[0] = FB_VF(1, 0, 0); ka[1] = FB_VF(1, 0, 1); ka[2] = FB_VF(1, 1, 0); ka[3] = FB_VF(1, 1, 1);
    FB_MF(o[0], ka[0], b10); FB_MF(o[1], ka[2], b10); FB_MF(o[0], ka[1], b11); FB_MF(o[1], ka[3], b11); FB_SB();
    ka[0] = FB_VF(1, 2, 0); ka[1] = FB_VF(1, 2, 1); ka[2] = FB_VF(1, 3, 0); ka[3] = FB_VF(1, 3, 1);
    FB_MF(o[2], ka[0], b10); FB_MF(o[3], ka[2], b10); FB_MF(o[2], ka[1], b11); FB_MF(o[3], ka[3], b11); FB_SB();
}
#undef FB_SB
#undef FB_MF
#undef FB_KF
#undef FB_VF

constexpr int NSA_WLDS = 8192;
static_assert(AT_RING + NWAVES * NSA_WLDS <= 131072 && 132096 + NWAVES * 128 <= 147200 && AB_NS * AB_SLOT <= 131072, "attention LDS map (selection masks at 132096, MISC words at 147200)");
__device__ __forceinline__ void nsa_unit(const Ctx& C, int g, int qt, float* Oatt, int mode = 31) {
    const int lane = C.lane, wave = C.wave, c = lane & 31, h = lane >> 5, qi = c >> 2, hh = c & 3, head = 4 * g + hh, t0 = 64 * qt + 8 * wave, t = t0 + qi;
    const LAS unsigned char* ring = C.lds; const unsigned ring0 = (unsigned)(uintptr_t)C.lds;
    LAS unsigned char* wl = C.lds + AT_RING + wave * NSA_WLDS;
    LAS float* impA = (LAS float*)wl; LAS float* impB = impA + 8 * 128; LAS unsigned long long* selm = (LAS unsigned long long*)(C.lds + 132096 + wave * 128);
    const bf16* Qp = wsb(C, WS_BIG + BG_NQ) + ((size_t)head * T + t) * 128 + 8 * h;
    bf16x8 qf[8];
#pragma unroll
    for (int s = 0; s < 8; ++s) qf[s] = *(const bf16x8*)(Qp + 16 * s);
#define NSA_OP() (Oatt + (size_t)t * D + 1024 + head * 128 + 4 * h)
#define NSA_GATE(k) (wsf(C, WS_GATES)[(size_t)t * 24 + head * 3 + (k)])
#pragma unroll
    for (int i = 0; i < 32; ++i) impA[i * 64 + lane] = 0.f;
    const int tq = 64 * qt + 63, ncmp = (tq >= 31) ? ((tq - 31) >> 4) + 1 : 0, ntile = (ncmp + 31) >> 5;
    const int cmax = (t >= 31) ? ((t - 31) >> 4) : -1;
    const int wcmax = (t0 + 7 >= 31) ? ((t0 + 7 - 31) >> 4) : -1;
    const bf16* Kc = wsb(C, WS_KCMP) + (size_t)g * 512 * 128; const bf16* Vc = wsb(C, WS_VCMPT) + (size_t)g * 16 * 128 * 32;
    if (ntile > 0 && (mode & 1)) {
        const int wcmin = (t0 >= 31) ? ((t0 - 31) >> 4) : -1;
        float mref = 0.f, l = 0.f;
        f32x16 st; bool act = false;
        stream_tiles<false>(ring0, Kc, Vc, ntile, wave, lane,
            [&](int i, int so) { act = 32 * i <= wcmax; if (act) st = qk_tile_lr(ring + so, qf, c, h, neg_frag(mref, h)); },
            [&](int i, int) {
            if (32 * i > wcmax) return;
            if (32 * i + 31 > wcmin) {
#pragma unroll
                for (int r = 0; r < 16; ++r) st[r] = (32 * i + crow(r, h) <= cmax) ? st[r] : -INFINITY; }
            float tm = max3f(st[0], st[1], st[2]);
#pragma unroll
            for (int r = 3; r < 15; r += 2) tm = max3f(tm, st[r], st[r + 1]);
            tm = fmaxf(tm, st[15]); tm = xhalf_max(tm);
            const bool trig = tm > AT_THR || (tm < -AT_THR && tm > -INFINITY);
            if (__any(trig)) { const float ltot = xhalf_sum(l); const bool need = tm > AT_THR || (trig && ltot == 0.f);
                const float mnew = need ? bf16_round(mref + tm) : mref, dl = mnew - mref; mref = mnew; l *= ex2(-dl);
#pragma unroll
                for (int r = 0; r < 16; ++r) st[r] -= dl; }
            float ps = 0.f;
#pragma unroll
            for (int r = 0; r < 16; ++r) ps += ex2(st[r]);
            l += ps; });
        l = xhalf_sum(l);
        const float nrm = l > 0.f ? -(mref + lg2(l)) : -INFINITY;
        f32x16 o[4] = {};
        stream_tiles<true>(ring0, Kc, Vc, ntile, wave, lane,
            [&](int i, int so) { if (32 * i <= wcmax) st = qk_tile_l(ring + so, qf, c, h); },
            [&](int i, int so) {
            if (32 * i > wcmax) return;
            float w[16];
            if (32 * i + 31 > wcmin) {
#pragma unroll
                for (int r = 0; r < 16; ++r) w[r] = (32 * i + crow(r, h) <= cmax) ? ex2(st[r] + nrm) : 0.f; }
            else {
#pragma unroll
                for (int r = 0; r < 16; ++r) w[r] = ex2(st[r] + nrm); }
#pragma unroll
            for (int q = 0; q < 4; ++q) { float a = (w[4 * q] + w[4 * q + 1]) + (w[4 * q + 2] + 0.5f * w[4 * q + 3]), b = 0.5f * w[4 * q + 3];
                a += __shfl_xor(a, 1); a += __shfl_xor(a, 2); b += __shfl_xor(b, 1); b += __shfl_xor(b, 2);
                const int n = 8 * i + 2 * q + h;
                if (hh == 0) { impA[qi * 128 + n] = a; if (n + 1 < NSEL) impB[qi * 128 + n + 1] = b; } }
            pv_tile_l(o, ring + so + 8192, w, c, h); });
        if (mode & 16) { float* op = NSA_OP(); const float g_c = NSA_GATE(0);
#pragma unroll
        for (int db = 0; db < 4; ++db)
#pragma unroll
            for (int q = 0; q < 4; ++q) *(f32x4*)(op + 32 * db + 8 * q) = (f32x4){o[db][4 * q], o[db][4 * q + 1], o[db][4 * q + 2], o[db][4 * q + 3]} * g_c; }
    } else if (mode & 16) {
        float* op = NSA_OP();
#pragma unroll
        for (int db = 0; db < 4; ++db)
#pragma unroll
            for (int q = 0; q < 4; ++q) *(f32x4*)(op + 32 * db + 8 * q) = (f32x4){0.f, 0.f, 0.f, 0.f};
    }
    const int nb = qt;
    LDS_WAIT(); asm volatile("" ::: "memory");
    for (int q = 0; q < 8; ++q) {
        unsigned long long mlo = 0ull, mhi = 0ull;
        if (nb < 16 || !(mode & 2)) { mlo = nb < 63 ? (2ull << nb) - 1ull : ~0ull; mhi = nb < 64 ? 0ull : (nb < 127 ? (2ull << (nb - 64)) - 1ull : ~0ull); }
        else {
            float v0 = impA[q * 128 + lane] + impB[q * 128 + lane], v1 = impA[q * 128 + 64 + lane] + impB[q * 128 + 64 + lane];
            const int i0 = lane, i1 = lane + 64;
            v0 = (i0 == 0 || i0 == nb) ? INFINITY : (i0 <= nb ? v0 : -INFINITY);
            v1 = (i1 == nb) ? INFINITY : (i1 <= nb ? v1 : -INFINITY);
            for (int rd = 0; rd < 16; ++rd) {
                const float mx = wave_max(fmaxf(v0, v1));
                const unsigned long long b0 = __ballot(v0 == mx), b1 = __ballot(v1 == mx);
                int sel;
                if (b0) { sel = __ffsll((long long)b0) - 1; mlo |= 1ull << sel; if (lane == sel) v0 = -INFINITY; }
                else { sel = __ffsll((long long)b1) - 1; mhi |= 1ull << sel; if (lane == sel) v1 = -INFINITY; }
            }
        }
        if (lane == 0) { selm[2 * q] = mlo; selm[2 * q + 1] = mhi; }
    }
    LDS_WAIT(); asm volatile("" ::: "memory");
    unsigned long long u_lo = 0ull, u_hi = 0ull;
#pragma unroll
    for (int q = 0; q < 8; ++q) { u_lo |= selm[2 * q]; u_hi |= selm[2 * q + 1]; }
    u_lo = ((unsigned long long)__builtin_amdgcn_readfirstlane((unsigned)(u_lo >> 32)) << 32) | (unsigned)__builtin_amdgcn_readfirstlane((unsigned)u_lo);
    u_hi = ((unsigned long long)__builtin_amdgcn_readfirstlane((unsigned)(u_hi >> 32)) << 32) | (unsigned)__builtin_amdgcn_readfirstlane((unsigned)u_hi);
    if (mode & 4) {
        const bf16* Ks = wsb(C, WS_BIG + BG_KSL) + (size_t)g * T * 128; const bf16* Vs = wsb(C, WS_BIG + BG_VSLT) + (size_t)g * T * 128;
        float mref = 0.f, l = 0.f; f32x16 o[4] = {};
        stream_blocks(ring0, Ks, Vs, nb + 1, wave, lane, [&](int n, int so) {
            const unsigned long long uu = n < 64 ? u_lo : u_hi;
            if (!((uu >> (n & 63)) & 1ull)) return;
            const bool sel = (selm[2 * qi + (n >> 6)] >> (n & 63)) & 1ull;
            flash_block(mref, l, o, qf, ring + so, c, h, sel, n == nb, [&](int tt, int r) { return 64 * n + 32 * tt + crow(r, h) <= t; }); });
        l = xhalf_sum(l);
        const float sc = l > 0.f ? NSA_GATE(1) / l : 0.f; float* op = NSA_OP();
        if (mode & 16)
#pragma unroll
        for (int db = 0; db < 4; ++db)
#pragma unroll
            for (int q = 0; q < 4; ++q) { f32x4* p = (f32x4*)(op + 32 * db + 8 * q); *p = *p + (f32x4){o[db][4 * q], o[db][4 * q + 1], o[db][4 * q + 2], o[db][4 * q + 3]} * sc; }
    }
    if (mode & 8) {
        const bf16* Kw = wsb(C, WS_BIG + BG_KWN) + (size_t)g * T * 128; const bf16* Vw = wsb(C, WS_BIG + BG_VWNT) + (size_t)g * T * 128;
        float mref = 0.f, l = 0.f; f32x16 o[4] = {};
        const int blo = (64 * qt - 511 > 0 ? 64 * qt - 511 : 0) >> 6, bhi = qt;
        stream_blocks(ring0, Kw + (size_t)blo * 8192, Vw + (size_t)blo * 8192, bhi - blo + 1, wave, lane, [&](int i, int so) {
            const int key0 = 64 * (blo + i);
            if (key0 + 63 < t0 - 511 || key0 > t0 + 7) return;
            flash_block(mref, l, o, qf, ring + so, c, h, true, !(key0 >= t0 + 7 - 511 && key0 + 63 <= t0)  ,
                        [&](int tt, int r) { const int key = key0 + 32 * tt + crow(r, h); return key <= t && key > t - 512; }); });
        l = xhalf_sum(l);
        const float sc = l > 0.f ? NSA_GATE(2) / l : 0.f; float* op = NSA_OP();
        if (mode & 16)
#pragma unroll
        for (int db = 0; db < 4; ++db)
#pragma unroll
            for (int q = 0; q < 4; ++q) { f32x4* p = (f32x4*)(op + 32 * db + 8 * q); *p = *p + (f32x4){o[db][4 * q], o[db][4 * q + 1], o[db][4 * q + 2], o[db][4 * q + 3]} * sc; }
    }
    AT_WAITBAR(0);
#undef NSA_OP
#undef NSA_GATE
}
constexpr int CW_SBCTR = 2048;

constexpr int RING_BYTES = 131072, LDS_BYTES = 147456, MISC_OFF = LDS_BYTES - 256;
constexpr int N_PHASES = 17;
#ifndef MK_ONE_LAUNCH
#define MK_ONE_LAUNCH 1
#endif

__global__ void __launch_bounds__(NTHREADS, 2) fwd_kernel(Args args) {
    extern __shared__ __attribute__((aligned(16))) unsigned char lds_raw[];
    Ctx C;
    C.in = args.in; C.out = args.out; C.ws = args.ws; C.lds = (LAS unsigned char*)lds_raw;
    C.tid = threadIdx.x; C.lane = C.tid & 63; C.wave = __builtin_amdgcn_readfirstlane(C.tid >> 6);
    C.G = gridDim.x; C.bid = blockIdx.x; C.gw = C.bid * NWAVES + C.wave; C.NGW = C.G * NWAVES;
    volatile LAS unsigned* MISC = (volatile LAS unsigned*)(C.lds + MISC_OFF);
    for (int u = C.tid; u < (LDS_BYTES - RING_BYTES) / 4; u += NTHREADS) ((LAS unsigned*)(C.lds + RING_BYTES))[u] = 0u;
    __syncthreads();
    unsigned* barw = (unsigned*)(C.ws + WS_CTL) + CW_BAR + args.li * XCD_BAR_WORDS;
    XcdBarrier bar; bar.bar = barw; bar.x = 0; bar.st = nullptr;
    const int lo = args.ph_lo, hi = args.ph_hi;
    if (hi - lo > 1) bar = xcd_barrier_post(barw, MISC + 8);
#ifndef MK_MASK
#define MK_MASK 0x1FFFFu
#endif
#define IN(k) (((MK_MASK >> (k)) & 1u) && lo <= (k) && (k) < hi)
#define SEAM(k) do { if (IN(k) && IN((k) + 1)) xcd_barrier(bar); } while (0)
    LAS unsigned char* ring = C.lds;
#if defined(MK_PROBE_ATT)
    if (lo >= 100) {
        const int mode = lo - 100;
        if (mode & 31) nsa_unit(C, C.bid & 1, C.bid >> 1, C.out, mode);
        if (mode & 32) { unsigned* sbctr = (unsigned*)(C.ws + WS_CTL) + CW_SBCTR + 64 * args.li;
            for (;;) { unsigned idx = 0; if (C.lane == 0) idx = __hip_atomic_fetch_add(sbctr, 1u, __ATOMIC_RELAXED, __HIP_MEMORY_SCOPE_AGENT);
                const int item = __builtin_amdgcn_readfirstlane((int)idx); if (item >= 2048) break;
                sb_item(C, item & 7, item >> 3, C.out); } }
        if (mode & 64) conv_dynamic<JOBS_P7>(C, (unsigned*)(C.ws + WS_CTL) + CW_CONVCTR + 64 * args.li);
        return;
    }
#endif
    float* Yout = C.out;
    float* X = wsf(C, WS_X); bf16* XB = wsb(C, WS_XB); bf16* Hb = wsb(C, WS_BIG);

    if (IN(0)) { p0_prologue(C, args.invf, args.li == 0); } SEAM(0);
    if (IN(1)) {
        { pg8::Gemm gm{XB, wsb(C, WS_WGU1), D, D, D}; pg8::StaticOrder S; S.init(T, NGU, C.G, C.bid); pg8::EpiSwiGLU E{Hb, FF};
          pg8::gemm_phase<pg8::EpiSwiGLU, pg8::StaticOrder, true, true>(ring, gm, S, E); }
        { pg8::Gemm gm{wsb(C, WS_MEMB), wsb(C, WS_WK), D, D, D}; pg8::ListOrder S; S.init(1, 1, 8, C.G, C.bid, 96, 0, 0); pg8::EpiBf16S E{wsb(C, WS_KMEM), D, 1.f, 0, 0};
          pg8::gemm_phase<pg8::EpiBf16S, pg8::ListOrder, true, true>(ring, gm, S, E); }
        { pg8::Gemm gm{wsb(C, WS_MEMB), wsb(C, WS_WV), D, D, D}; pg8::ListOrder S; S.init(1, 1, 8, C.G, C.bid, 104, 0, 0); pg8::EpiBf16S E{wsb(C, WS_VT), D, 1.f, 0, 0};
          pg8::gemm_phase<pg8::EpiBf16S, pg8::ListOrder, true, true>(ring, gm, S, E); }
        if (C.G == 256 && C.bid >= 112) conv_static<JOBS_P1>(C, (C.bid - 112) * NWAVES + C.wave, 144 * NWAVES);
        else if (C.G != 256) conv_static<JOBS_P1>(C, C.gw, C.NGW);
    } SEAM(1);
    if (IN(2)) { pg8::Gemm gm{Hb, wsb(C, WS_WD1), FF, FF, FF}; pg8::StaticOrder S; S.init(T, D, C.G, C.bid); pg8::EpiF32 E{Yout, D, C.in[0], ALPHA, 0.5f, 0};
        pg8::gemm_phase<pg8::EpiF32, pg8::StaticOrder, true, true>(ring, gm, S, E); } SEAM(2);
    if (IN(3)) { ln_rows(C, Yout, C.in[2], C.in[3], X, XB); } SEAM(3);
    if (IN(4)) { pg8::Gemm gm{XB, wsb(C, WS_WIN), D, D, D}; pg8::StaticOrder S; S.init(T, INP, C.G, C.bid);
        pg8::EpiWin E{wsb(C, WS_BIG + BG_SBQ), wsb(C, WS_BIG + BG_SBK), wsb(C, WS_BIG + BG_SBVT), wsb(C, WS_BIG + BG_NQ), wsb(C, WS_BIG + BG_CMPIN), wsb(C, WS_BIG + BG_KSL), wsb(C, WS_BIG + BG_VSLT),
                      wsb(C, WS_BIG + BG_KWN), wsb(C, WS_BIG + BG_VWNT), wsf(C, WS_GATES), wsf(C, WS_ROPE), T, QSCALE};
        pg8::gemm_phase<pg8::EpiWin, pg8::StaticOrder, true, true>(ring, gm, S, E); } SEAM(4);
    if (IN(5)) {
        { pg8::Gemm gm{wsb(C, WS_BIG + BG_CMPIN), wsb(C, WS_W1T), 16 * 128, 4096, 512}; pg8::CmpOrder S{C.G, C.bid, (size_t)T * 128 * 2, (size_t)256 * 4096 * 2};
          pg8::EpiF32 E{wsf(C, WS_PC), 256, nullptr, 0.f, 1.f, (size_t)512 * 256};
          pg8::gemm_phase<pg8::EpiF32, pg8::CmpOrder, true, true>(ring, gm, S, E); }
        { pg8::Gemm gm{wsb(C, WS_KMEM), wsb(C, WS_WQ), D, D, MEMD}; pg8::ListOrder S; S.init(MEMH, 1, 8, C.G, C.bid, 64, (size_t)MEMD * 2, (size_t)MEMD * 2);
          pg8::EpiBf16S E{wsb(C, WS_WQK), D, MEMQSCALE, 0, MEMT};
          pg8::gemm_phase<pg8::EpiBf16S, pg8::ListOrder, true, true>(ring, gm, S, E); }
        { pg8::Gemm gm{wsb(C, WS_WO), wsb(C, WS_VT), D, D, MEMD}; pg8::ListOrder S; S.init(MEMH, 8, 1, C.G, C.bid, 96, (size_t)MEMD * 2, (size_t)MEMD * 2);
          pg8::EpiBf16S E{wsb(C, WS_VOT), MEMH * MEMT, 1.f, MEMT, 0};
          pg8::gemm_phase<pg8::EpiBf16S, pg8::ListOrder, true, true>(ring, gm, S, E); }
    } SEAM(5);
    if (IN(6)) { compress_l2(C); } SEAM(6);
    if (IN(7)) {
        if (C.G == 256) {
            nsa_unit(C, C.bid & 1, C.bid >> 1, Yout);
            unsigned* sbctr = (unsigned*)(C.ws + WS_CTL) + CW_SBCTR + 64 * args.li;
            for (;;) { unsigned idx = 0; if (C.lane == 0) idx = __hip_atomic_fetch_add(sbctr, 1u, __ATOMIC_RELAXED, __HIP_MEMORY_SCOPE_AGENT);
                const int item = __builtin_amdgcn_readfirstlane((int)idx); if (item >= 2048) break;
                sb_item(C, item & 7, item >> 3, Yout); }
        }
        conv_dynamic<JOBS_P7>(C, (unsigned*)(C.ws + WS_CTL) + CW_CONVCTR + 64 * args.li);
    } SEAM(7);
    if (IN(8)) { rms_rows(C, Yout, C.in[14], XB); } SEAM(8);
    if (IN(9)) { pg8::Gemm gm{XB, wsb(C, WS_WOUT), D, D, D}; pg8::StaticOrder S; S.init(T, D, C.G, C.bid); pg8::EpiF32 E{Yout, D, X, ALPHA, 1.f, 0};
        pg8::gemm_phase<pg8::EpiF32, pg8::StaticOrder, true, true>(ring, gm, S, E); } SEAM(9);
    if (IN(10)) { ln_rows(C, Yout, C.in[16], C.in[17], X, XB); } SEAM(10);
    if (IN(11)) { pg8::Gemm gm{XB, wsb(C, WS_WQK), D, D, D}; pg8::StaticOrder S; S.init(T, MEMH * MEMT, C.G, C.bid); pg8::EpiSoftmaxP E{wsb(C, WS_BIG + BG_P), MEMH * MEMT};
        pg8::gemm_phase<pg8::EpiSoftmaxP, pg8::StaticOrder, false, true>(ring, gm, S, E); } SEAM(11);
    if (IN(12)) { pg8::Gemm gm{wsb(C, WS_BIG + BG_P), wsb(C, WS_VOT), MEMH * MEMT, MEMH * MEMT, MEMH * MEMT}; pg8::StaticOrder S; S.init(T, D, C.G, C.bid); pg8::EpiF32 E{Yout, D, X, ALPHA, 1.f, 0};
        pg8::gemm_phase<pg8::EpiF32, pg8::StaticOrder, true, true>(ring, gm, S, E); } SEAM(12);
    if (IN(13)) { ln_rows(C, Yout, C.in[22], C.in[23], X, XB); } SEAM(13);
    if (IN(14)) { pg8::Gemm gm{XB, wsb(C, WS_WGU2), D, D, D}; pg8::StaticOrder S; S.init(T, NGU, C.G, C.bid); pg8::EpiSwiGLU E{Hb, FF};
        pg8::gemm_phase<pg8::EpiSwiGLU, pg8::StaticOrder, true, true>(ring, gm, S, E); } SEAM(14);
    if (IN(15)) { pg8::Gemm gm{Hb, wsb(C, WS_WD2), FF, FF, FF}; pg8::StaticOrder S; S.init(T, D, C.G, C.bid); pg8::EpiF32 E{Yout, D, X, ALPHA, 0.5f, 0};
        pg8::gemm_phase<pg8::EpiF32, pg8::StaticOrder, true, true>(ring, gm, S, E); } SEAM(15);
    if (IN(16)) { ln_rows(C, Yout, C.in[27], C.in[28], Yout, nullptr); }
#undef IN
#undef SEAM
}

extern "C" void kernel_launch(void* const* d_in, const int* in_sizes, int n_in, void* d_out, int out_size, void* d_ws, size_t ws_size, hipStream_t stream) {
    static int grid = 0;
    if (grid == 0) {
        if (n_in != 29 || in_sizes[0] != T * D || out_size != T * D || ws_size < WS_END) { fprintf(stderr, "kernel_launch: unexpected shapes (n_in %d, in0 %d, out %d, ws %zu < %zu); nothing launched\n", n_in, n_in > 0 ? in_sizes[0] : -1, out_size, ws_size, (size_t)WS_END); grid = -1; return; }
        int dev = 0, cus = 0, per_cu = 0;
        if (hipGetDevice(&dev) != hipSuccess || hipDeviceGetAttribute(&cus, hipDeviceAttributeMultiprocessorCount, dev) != hipSuccess) { grid = -1; return; }
        if (hipFuncSetAttribute((const void*)fwd_kernel, hipFuncAttributeMaxDynamicSharedMemorySize, LDS_BYTES) != hipSuccess) { fprintf(stderr, "kernel_launch: hipFuncSetAttribute failed\n"); grid = -1; return; }
        if (hipOccupancyMaxActiveBlocksPerMultiprocessor(&per_cu, (const void*)fwd_kernel, NTHREADS, LDS_BYTES) != hipSuccess || per_cu < 1) { fprintf(stderr, "kernel_launch: occupancy query says %d blocks per CU\n", per_cu); per_cu = 1; }
        (void)hipGetLastError();
        grid = cus;
        if (grid != 256) fprintf(stderr, "kernel_launch: %d CUs; the attention phase is laid out for 256\n", grid);
    }
    if (grid < 0) return;
    (void)hipMemsetAsync((char*)d_ws + WS_CTL, 0, CTL_ZERO_BYTES, stream);
    Args a{};
    for (int i = 0; i < 29; ++i) a.in[i] = (const float*)d_in[i];
    a.out = (float*)d_out; a.ws = (unsigned char*)d_ws;
    for (int i = 0; i < 64; ++i) a.invf[i] = std::pow(10000.0, -(double)i / 64.0);
#if defined(MK_PROBE_ATT)
    a.ph_lo = 0; a.ph_hi = 8; a.li = 0; hipLaunchKernelGGL(fwd_kernel, dim3(grid), dim3(NTHREADS), LDS_BYTES, stream, a);
    a.ph_lo = 100 + MK_PROBE_ATT; a.ph_hi = 100 + MK_PROBE_ATT + 1; a.li = 1; hipLaunchKernelGGL(fwd_kernel, dim3(grid), dim3(NTHREADS), LDS_BYTES, stream, a);
    a.ph_lo = 8; a.ph_hi = N_PHASES; a.li = 2; hipLaunchKernelGGL(fwd_kernel, dim3(grid), dim3(NTHREADS), LDS_BYTES, stream, a);
#elif defined(MK_PROBE_PHASE)
    a.ph_lo = 0; a.ph_hi = MK_PROBE_PHASE + 1; a.li = 0; hipLaunchKernelGGL(fwd_kernel, dim3(grid), dim3(NTHREADS), LDS_BYTES, stream, a);
    a.ph_lo = MK_PROBE_PHASE; a.ph_hi = MK_PROBE_PHASE + 1; a.li = 1; hipLaunchKernelGGL(fwd_kernel, dim3(grid), dim3(NTHREADS), LDS_BYTES, stream, a);
    a.ph_lo = MK_PROBE_PHASE + 1; a.ph_hi = N_PHASES; a.li = 2; hipLaunchKernelGGL(fwd_kernel, dim3(grid), dim3(NTHREADS), LDS_BYTES, stream, a);
#elif MK_ONE_LAUNCH
    a.ph_lo = 0; a.ph_hi = N_PHASES; a.li = 0;
    hipLaunchKernelGGL(fwd_kernel, dim3(grid), dim3(NTHREADS), LDS_BYTES, stream, a);
#else
    for (int p = 0; p < N_PHASES; ++p) { a.ph_lo = p; a.ph_hi = p + 1; a.li = 0; hipLaunchKernelGGL(fwd_kernel, dim3(grid), dim3(NTHREADS), LDS_BYTES, stream, a); }
#endif
}
```
